# Optimizing an MI355X kernel written in HIP

```python
import math
import jax, jax.numpy as jnp
from jax import lax
import numpy as np

D_MODEL = 2048
BATCH = 2
SEQ = 4096
DEPTH = 2

N_META = 16
POOL_WINDOWS = (2, 4, 8, 16)
POOL_GROUPS = len(POOL_WINDOWS)
POOL_GROUP_DIM = D_MODEL // 16
POOL_WIDTH = POOL_GROUPS * POOL_GROUP_DIM
HGRN_WIDTH = 3 * D_MODEL // 8
HGRN_HEAD_DIM = 128
HGRN_HEADS = HGRN_WIDTH // HGRN_HEAD_DIM
CHUNK = 16
DIFF_WIDTH = 3 * D_MODEL // 8
DIFF_HEAD_DIM = 64
DIFF_HEADS = DIFF_WIDTH // (2 * DIFF_HEAD_DIM)
Q_BLOCK = 128
MASK_VALUE = -1e30
D_FF = 11 * D_MODEL // 4
GATE_WIDTH = 3 * D_MODEL
IN_COLS = POOL_WIDTH + 4 * HGRN_WIDTH + 3 * DIFF_WIDTH + GATE_WIDTH
DEEPNORM_ALPHA = (2.0 * DEPTH) ** 0.25
DEEPNORM_BETA = (8.0 * DEPTH) ** -0.25
LN_EPS = 1e-5
RMS_EPS = 1e-6

kernel_name = 'hybrid_pool_hgrn2_diffattn_macaron_deepnorm'


def layer_norm(x, g, b):
    xf = x.astype(jnp.float32)
    mu = jnp.mean(xf, axis=-1, keepdims=True)
    var = jnp.mean(jnp.square(xf - mu), axis=-1, keepdims=True)
    return ((xf - mu) * lax.rsqrt(var + LN_EPS) * g + b).astype(x.dtype)


def rms_norm(x, g):
    xf = x.astype(jnp.float32)
    return xf * lax.rsqrt(jnp.mean(jnp.square(xf), axis=-1, keepdims=True) + RMS_EPS) * g


def swiglu_ffn(h, w_in, w_out):
    a, u = jnp.split(h @ w_in, 2, axis=-1)
    return (jax.nn.silu(a) * u) @ w_out


def pool_mixer(u, w_group, scale):
    B, L, _ = u.shape
    uf = u.astype(jnp.float32)
    cs = jnp.pad(jnp.cumsum(uf, axis=1), ((0, 0), (1, 0), (0, 0)))
    pos = jnp.arange(L)
    outs = []
    for gi, w in enumerate(POOL_WINDOWS):
        sl = slice(gi * POOL_GROUP_DIM, (gi + 1) * POOL_GROUP_DIM)
        c = cs[:, :, sl]
        start = jnp.maximum(pos + 1 - w, 0)
        win_sum = c[:, 1:] - c[:, start]
        cnt = (pos + 1 - start).astype(jnp.float32)
        outs.append(win_sum / cnt[None, :, None] - uf[:, :, sl])
    p = jnp.stack(outs, axis=2)
    y = jnp.einsum('blgc,gcd->blgd', p, w_group.astype(jnp.float32)).reshape(B, L, POOL_WIDTH)
    return (y * scale).astype(u.dtype)


def hgrn2_mixer(q, fz, v, og, lb, norm_g):
    B, L, _ = q.shape
    H, K = HGRN_HEADS, HGRN_HEAD_DIM
    f32 = jnp.float32
    lb = lb.astype(f32)
    f = lb + (1.0 - lb) * jax.nn.sigmoid(fz.astype(f32))
    logf = jnp.log(f)
    k = 1.0 - f
    qs = q.astype(f32) * (K ** -0.5)
    nC = L // CHUNK

    def to_chunks(t):
        return t.astype(f32).reshape(B, nC, CHUNK, H, K).transpose(1, 0, 3, 2, 4)

    tri = jnp.tril(jnp.ones((CHUNK, CHUNK), dtype=bool))[:, :, None]

    def step(S, xs):
        qc, kc, vc, gc = xs
        b = jnp.cumsum(gc, axis=2)
        diff = b[:, :, :, None, :] - b[:, :, None, :, :]
        decay = jnp.where(tri, jnp.exp(jnp.where(tri, diff, 0.0)), 0.0)
        attn = jnp.einsum('bhtk,bhsk,bhtsk->bhts', qc, kc, decay)
        o = (jnp.einsum('bhts,bhsv->bhtv', attn, vc)
             + jnp.einsum('bhtk,bhkv->bhtv', qc * jnp.exp(b), S))
        b_last = b[:, :, -1]
        S = (jnp.exp(b_last)[..., None] * S
             + jnp.einsum('bhsk,bhsv->bhkv', kc * jnp.exp(b_last[:, :, None] - b), vc))
        return S, o

    S0 = jnp.zeros((B, H, K, K), f32)
    _, o = lax.scan(step, S0, (to_chunks(qs), to_chunks(k), to_chunks(v), to_chunks(logf)))
    o = o.transpose(1, 0, 3, 2, 4).reshape(B, L, H, K)
    o = rms_norm(o, norm_g) * jax.nn.silu(og.astype(f32).reshape(B, L, H, K))
    return o.reshape(B, L, HGRN_WIDTH).astype(q.dtype)


def diff_attention(q, k, v, lam, norm_g, lambda_init):
    B, L, _ = q.shape
    H, d = DIFF_HEADS, DIFF_HEAD_DIM
    scale = d ** -0.5
    q = q.reshape(B, L, H, 2, d)
    k = k.reshape(B, L, H, 2, d)
    vt = v.reshape(B, L, H, 2 * d).transpose(0, 2, 1, 3)
    nQ = -(-L // Q_BLOCK)
    Lp = nQ * Q_BLOCK
    qp = jnp.pad(q, ((0, 0), (0, Lp - L), (0, 0), (0, 0), (0, 0)))
    qb = qp.reshape(B, nQ, Q_BLOCK, H, 2, d).transpose(1, 0, 3, 4, 2, 5)
    kt = k.transpose(0, 2, 3, 1, 4)
    kpos = jnp.arange(L)

    def block(args):
        qblk, start = args
        s = jnp.einsum('bhmqd,bhmkd->bhmqk', qblk, kt).astype(jnp.float32) * scale
        qpos = start + jnp.arange(Q_BLOCK)
        mask = kpos[None, :] <= qpos[:, None]
        p = jax.nn.softmax(jnp.where(mask, s, MASK_VALUE), axis=-1)
        a = p[:, :, 0] - lam * p[:, :, 1]
        return jnp.einsum('bhqk,bhkv->bhqv', a.astype(vt.dtype), vt)

    o = lax.map(block, (qb, jnp.arange(nQ) * Q_BLOCK))
    o = o.transpose(1, 0, 3, 2, 4).reshape(B, Lp, H, 2 * d)[:, :L]
    o = rms_norm(o, norm_g) * (1.0 - lambda_init)
    return o.reshape(B, L, H * 2 * d).astype(v.dtype)


def setup_inputs(seed: int = 0) -> dict:
    key = jax.random.key(seed)
    ks = jax.random.split(key, 17)
    f32 = jnp.float32

    def nrm(k, shape, s):
        return jax.random.normal(k, shape, f32) * s

    return {
        'x': nrm(ks[0], (BATCH, SEQ, D_MODEL), 1.0),
        'meta_tokens': nrm(ks[1], (N_META, D_MODEL), 1.0),
        'ln_g': 1.0 + nrm(ks[2], (DEPTH, 3, D_MODEL), 0.02),
        'ln_b': nrm(ks[3], (DEPTH, 3, D_MODEL), 0.02),
        'ffn_w_in': nrm(ks[4], (DEPTH, 2, D_MODEL, 2 * D_FF), D_MODEL ** -0.5),
        'ffn_w_out': nrm(ks[5], (DEPTH, 2, D_FF, D_MODEL), D_FF ** -0.5 * DEEPNORM_BETA),
        'w_in': nrm(ks[6], (DEPTH, D_MODEL, IN_COLS), D_MODEL ** -0.5),
        'pool_w': nrm(ks[7], (DEPTH, POOL_GROUPS, POOL_GROUP_DIM, POOL_GROUP_DIM), POOL_GROUP_DIM ** -0.5),
        'pool_scale': 1.0 + nrm(ks[8], (DEPTH, POOL_WIDTH), 0.1),
        'hgrn_lower_bounds': nrm(ks[9], (DEPTH, HGRN_WIDTH), 0.1),
        'hgrn_norm_g': 1.0 + nrm(ks[10], (DEPTH, HGRN_HEAD_DIM), 0.02),
        'diff_lambda': nrm(ks[11], (DEPTH, 4, DIFF_HEAD_DIM), 0.1),
        'diff_norm_g': 1.0 + nrm(ks[12], (DEPTH, 2 * DIFF_HEAD_DIM), 0.02),
        'w_branch_pool': nrm(ks[13], (DEPTH, POOL_WIDTH, D_MODEL), POOL_WIDTH ** -0.5),
        'w_branch_hgrn': nrm(ks[14], (DEPTH, HGRN_WIDTH, D_MODEL), HGRN_WIDTH ** -0.5),
        'w_branch_diff': nrm(ks[15], (DEPTH, DIFF_WIDTH, D_MODEL), DIFF_WIDTH ** -0.5),
        'w_out': nrm(ks[16], (DEPTH, D_MODEL, D_MODEL), D_MODEL ** -0.5 * DEEPNORM_BETA),
    }


def reference(x, meta_tokens, ln_g, ln_b, ffn_w_in, ffn_w_out, w_in, pool_w, pool_scale,
              hgrn_lower_bounds, hgrn_norm_g, diff_lambda, diff_norm_g,
              w_branch_pool, w_branch_hgrn, w_branch_diff, w_out):
    B = x.shape[0]
    meta = jnp.broadcast_to(meta_tokens[None].astype(x.dtype), (B, N_META, D_MODEL))
    h = jnp.concatenate([meta, x], axis=1)

    lb_sm = jax.nn.softmax(hgrn_lower_bounds.astype(jnp.float32), axis=0)
    lower_bounds = jnp.cumsum(lb_sm, axis=0) - lb_sm[0]

    o_pool = POOL_WIDTH
    o_hgrn = o_pool + 4 * HGRN_WIDTH
    o_diff = o_hgrn + 3 * DIFF_WIDTH

    for l in range(DEPTH):
        h = layer_norm(DEEPNORM_ALPHA * h + 0.5 * swiglu_ffn(h, ffn_w_in[l, 0], ffn_w_out[l, 0]),
                       ln_g[l, 0], ln_b[l, 0])

        z = h @ w_in[l]
        z_pool = z[..., :o_pool]
        hq, hf, hv, hg = jnp.split(z[..., o_pool:o_hgrn], 4, axis=-1)
        dq, dk, dv = jnp.split(z[..., o_hgrn:o_diff], 3, axis=-1)
        gates = jax.nn.sigmoid(z[..., o_diff:].astype(jnp.float32))
        g_pool, g_hgrn, g_diff = jnp.split(gates, 3, axis=-1)

        y_pool = pool_mixer(z_pool, pool_w[l], pool_scale[l])
        y_hgrn = hgrn2_mixer(hq, hf, hv, hg, lower_bounds[l], hgrn_norm_g[l])
        lambda_init = 0.8 - 0.6 * math.exp(-0.3 * l)
        lam_p = diff_lambda[l].astype(jnp.float32)
        lam = (jnp.exp(jnp.sum(lam_p[0] * lam_p[1])) - jnp.exp(jnp.sum(lam_p[2] * lam_p[3]))
               + lambda_init)
        y_diff = diff_attention(dq, dk, dv, lam, diff_norm_g[l], lambda_init)

        merged = (g_pool * (y_pool @ w_branch_pool[l])
                  + g_hgrn * (y_hgrn @ w_branch_hgrn[l])
                  + g_diff * (y_diff @ w_branch_diff[l])).astype(h.dtype)
        h = layer_norm(DEEPNORM_ALPHA * h + merged @ w_out[l], ln_g[l, 1], ln_b[l, 1])

        h = layer_norm(DEEPNORM_ALPHA * h + 0.5 * swiglu_ffn(h, ffn_w_in[l, 1], ffn_w_out[l, 1]),
                       ln_g[l, 2], ln_b[l, 2])

    return h[:, N_META:]
```

```cpp
#include <hip/hip_runtime.h>
#include <hip/hip_cooperative_groups.h>
#include <cstdio>
#include <cstdint>
namespace cg = cooperative_groups;

#define LAS __attribute__((address_space(3)))
typedef unsigned short bf16_t;
typedef short bf16x8 __attribute__((ext_vector_type(8)));
typedef float f32x4 __attribute__((ext_vector_type(4)));
typedef float f32x2 __attribute__((ext_vector_type(2)));
typedef unsigned u32x4 __attribute__((ext_vector_type(4)));
typedef unsigned u32x2 __attribute__((ext_vector_type(2)));
typedef short s16x4 __attribute__((ext_vector_type(4)));
typedef float f32x16_t __attribute__((ext_vector_type(16)));

constexpr int D = 2048, NB = 2, SEQ = 4096, NMETA = 16, L = SEQ + NMETA  , T = NB * L  , MP = 8448  ;
constexpr int DFF = 5632, INCOLS = 12032, LP = 4352  ;
constexpr int PW = 512, HW = 768, DW = 768;
constexpr float ALPHA = 1.4142135623730951f;
constexpr float LN_EPS = 1e-5f, RMS_EPS = 1e-6f;
constexpr float C2 = 0.125f * 1.4426950408889634f;

constexpr size_t al(size_t x) { return (x + 4095) & ~(size_t)4095; }
constexpr size_t WS_CTL = 0, CTL_BYTES = 1 << 20;
constexpr size_t SZ_WUP = (size_t)2 * DFF * D * 2, SZ_WDN = (size_t)D * DFF * 2, SZ_WIN = (size_t)INCOLS * D * 2;
constexpr size_t WS_WUP = WS_CTL + CTL_BYTES;
constexpr size_t WS_WDN = WS_WUP + 4 * SZ_WUP;
constexpr size_t WS_WIN = WS_WDN + 4 * SZ_WDN;
constexpr size_t WS_WBP = WS_WIN + 2 * SZ_WIN;
constexpr size_t WS_WBH = WS_WBP + 2 * (size_t)D * PW * 2;
constexpr size_t WS_WBD = WS_WBH + 2 * (size_t)D * HW * 2;
constexpr size_t WS_WO = WS_WBD + 2 * (size_t)D * DW * 2;
constexpr size_t WS_H = al(WS_WO + 2 * (size_t)D * D * 2);
constexpr size_t WS_HB = al(WS_H + (size_t)MP * D * 4);
constexpr size_t WS_PRE = al(WS_HB + (size_t)MP * D * 2);
constexpr size_t WS_ACT = al(WS_PRE + (size_t)MP * D * 4);
constexpr size_t WS_ZP = al(WS_ACT + (size_t)MP * DFF * 2);
constexpr size_t WS_ZH = al(WS_ZP + (size_t)MP * PW * 4);
constexpr size_t WS_QA = al(WS_ZH + (size_t)MP * 3072 * 4);
constexpr size_t WS_KA = al(WS_QA + (size_t)NB * LP * 768 * 2);
constexpr size_t WS_VA = al(WS_KA + (size_t)NB * LP * 768 * 2);
constexpr size_t WS_G = al(WS_VA + (size_t)NB * LP * 768 * 2);
constexpr size_t WS_YP = al(WS_G + (size_t)MP * 6144 * 2);
constexpr size_t WS_YH = al(WS_YP + (size_t)MP * PW * 2);
constexpr size_t WS_YD = al(WS_YH + (size_t)MP * HW * 2);
constexpr size_t WS_OH = al(WS_YD + (size_t)MP * DW * 2);
constexpr size_t WS_OD = al(WS_OH + (size_t)T * HW * 4);
constexpr size_t WS_MF = al(WS_OD + (size_t)NB * LP * 1536 * 4);
constexpr size_t WS_MB = al(WS_MF + (size_t)MP * D * 4);
constexpr size_t WS_END = al(WS_MB + (size_t)MP * D * 2);
static_assert(WS_KA - WS_QA == WS_VA - WS_KA, "Q/K/V attention buffers equally spaced");
constexpr size_t WS_HG = WS_END, WS_END_HG = al(WS_HG + (size_t)MP * HW * 2);

constexpr int LDS_BYTES = 147456;

typedef float f32x2_t __attribute__((ext_vector_type(2))); typedef __bf16 bf16x2_t __attribute__((ext_vector_type(2)));
__device__ __forceinline__ unsigned pk2(float lo, float hi) { f32x2_t v = {lo, hi}; bf16x2_t b = __builtin_convertvector(v, bf16x2_t); return __builtin_bit_cast(unsigned, b); }
__device__ __forceinline__ unsigned f2bf(float f) { return pk2(f, 0.f) & 0xffffu; }
__device__ __forceinline__ float bf2f(unsigned short v) { return __builtin_bit_cast(float, (unsigned)v << 16); }
__device__ __forceinline__ float bflo(unsigned w) { return __builtin_bit_cast(float, w << 16); }
__device__ __forceinline__ float bfhi(unsigned w) { return __builtin_bit_cast(float, w & 0xffff0000u); }
__device__ __forceinline__ float wave_sum(float v) {
#pragma unroll
    for (int o = 1; o < 64; o <<= 1) v += __shfl_xor(v, o);
    return v;
}
__device__ __forceinline__ float sigmoidf_(float x) { return __builtin_amdgcn_rcpf(1.0f + __builtin_amdgcn_exp2f(-1.4426950408889634f * x)); }

__device__ __forceinline__ int opq_v(int x) { asm volatile("" : "+v"(x)); return x; }
__device__ __forceinline__ int opq_s(int x) { asm volatile("" : "+s"(x)); return x; }


#define XB_TMO      128
#define XB_XCNT(j)  (256  + 64 * (j))
#define XB_XSUB(j)  (1280 + 64 * (j))
#define XB_XGEN(j)  (2304 + 64 * (j))
#define XB_TOP      3328
#define XB_TOPGEN   3392
#define XCD_BAR_WORDS 3456
#define XB_SPIN_CAP (1u << 22)
__device__ __forceinline__ unsigned xb_ld(unsigned* p)              { return __hip_atomic_load(p, __ATOMIC_RELAXED, __HIP_MEMORY_SCOPE_AGENT); }
__device__ __forceinline__ unsigned xb_add(unsigned* p, unsigned v) { return __hip_atomic_fetch_add(p, v, __ATOMIC_RELAXED, __HIP_MEMORY_SCOPE_AGENT); }
__device__ __forceinline__ unsigned xb_xcc_id() { return (unsigned)__builtin_amdgcn_s_getreg((3 << 11) | 20) & 0xFu; }
#define XB_SPIN(cond, bar) do { unsigned _sp = 0; while (cond) { __builtin_amdgcn_s_sleep(1); \
    if ((++_sp & 255u) == 0u) { if (xb_ld(&(bar)[XB_TMO])) break; if (_sp > XB_SPIN_CAP) { atomicAdd(&(bar)[XB_TMO], 1u); break; } } } } while (0)
struct XcdBarrier { unsigned* bar; unsigned x; volatile LAS unsigned* st; };
__device__ __forceinline__ XcdBarrier xcd_barrier_post(unsigned* bar, volatile LAS unsigned* st) {
    XcdBarrier b; b.bar = bar; b.x = xb_xcc_id(); b.st = st;
    if (threadIdx.x == 0) (void)xb_add(&bar[XB_XCNT(b.x)], 1u);
    return b;
}
__device__ __forceinline__ void xcd_barrier_complete(unsigned* bar, unsigned x, unsigned& nloc, unsigned& nx) {
    const unsigned G = gridDim.x * gridDim.y * gridDim.z;
    unsigned sum, cnt, mine, sp = 0u;
    for (;;) {
        sum = 0u; cnt = 0u; mine = 0u;
#pragma unroll
        for (unsigned j = 0; j < 16; ++j) { const unsigned c = xb_ld(&bar[XB_XCNT(j)]); sum += c; cnt += (c > 0u) ? 1u : 0u; mine = (j == x) ? c : mine; }
        if (sum == G) break;
        __builtin_amdgcn_s_sleep(1);
        if ((++sp & 255u) == 0u) { if (xb_ld(&bar[XB_TMO])) break; if (sp > XB_SPIN_CAP) { atomicAdd(&bar[XB_TMO], 1u); break; } }
    }
    nloc = mine > 0u ? mine : 1u; nx = cnt > 0u ? cnt : 1u;
}
__device__ __forceinline__ void xcd_barrier(unsigned* bar, volatile LAS unsigned* st) {
    asm volatile("s_waitcnt vmcnt(0)" ::: "memory");
    __syncthreads();
    if (threadIdx.x == 0) {
        const unsigned x = xb_xcc_id();
        __builtin_amdgcn_s_waitcnt(0);
        unsigned nloc = st[0], nx = st[1];
        if (nloc == 0u) { xcd_barrier_complete(bar, x, nloc, nx); st[0] = nloc; st[1] = nx; }
        const unsigned old = xb_add(&bar[XB_XSUB(x)], 1u);
        const unsigned gen = old / nloc;
        if (old + 1u == (gen + 1u) * nloc) {
            __builtin_amdgcn_fence(__ATOMIC_RELEASE, "agent");
            asm volatile("s_waitcnt vmcnt(0)" ::: "memory");
            const unsigned og = xb_add(&bar[XB_TOP], 1u);
            const unsigned tg = og / nx;
            if (og + 1u == (tg + 1u) * nx) xb_add(&bar[XB_TOPGEN], 1u);
            else XB_SPIN(xb_ld(&bar[XB_TOPGEN]) == tg, bar);
            __builtin_amdgcn_fence(__ATOMIC_ACQUIRE, "agent");
            xb_add(&bar[XB_XGEN(x)], 1u);
            asm volatile("s_waitcnt vmcnt(0)" ::: "memory");
        } else {
            XB_SPIN(xb_ld(&bar[XB_XGEN(x)]) == gen, bar);
            __builtin_amdgcn_fence(__ATOMIC_ACQUIRE, "agent");
            asm volatile("s_waitcnt vmcnt(0)" ::: "memory");
        }
    }
    __syncthreads();
}

namespace pg8 {
constexpr int BM = 256, BK = 64, HALF = 128, HTB = HALF * BK * 2, STAGE_BYTES = 8 * HTB, NXCD = 8, WGM = 8;
__host__ __device__ __forceinline__ int lds_byte(int r, int c) { const int st = (r >> 4) * 2 + (c >> 5), rr = r & 15, cc = c & 31, ob = rr * 64 + cc * 2; return st * 1024 + (ob ^ (((ob >> 9) & 1) << 5)); }
__host__ __device__ __forceinline__ void stage_rc(int b, int& R, int& C) { const int st = b / 1024, sb = b % 1024, swz = sb ^ (((sb >> 9) & 1) << 5); R = (st >> 1) * 16 + swz / 64; C = (st & 1) * 32 + (swz % 64) / 2; }
__host__ __device__ __forceinline__ int perm32(int rho) { const int n = rho >> 4, i = rho & 15; return 8 * (i >> 2) + 4 * n + (i & 3); }
struct Unit { int pm, pn; };
struct Gemm { const bf16_t* A; const bf16_t* Bt; int M, N, K; };
struct StaticOrder {
    int nM, nN, nwg, G, c;
    __host__ __device__ void init(int M, int N, int G_, int c_) { nM = M / BM; nN = N / BM; nwg = nM * nN; G = G_; c = c_; }
    __host__ __device__ bool next(int i, Unit& u) const {
        const long Lx = (long)i * G + c; if (Lx >= nwg) return false;
        int wgid = (int)Lx; { const int q = nwg / NXCD, r = nwg % NXCD, xcd = wgid % NXCD, off = wgid / NXCD; wgid = (xcd < r ? xcd * (q + 1) : r * (q + 1) + (xcd - r) * q) + off; }
        const int nig = WGM * nN, gid = wgid / nig, fm = gid * WGM, gsz = (nM - fm) < WGM ? (nM - fm) : WGM;
        u.pm = fm + ((wgid % nig) % gsz); u.pn = (wgid % nig) / gsz; return true;
    }
    __device__ __forceinline__ void a_ready(const Unit&) const {}
    __device__ __forceinline__ void done(const Unit&) const {}
};
__device__ __forceinline__ unsigned cvt_pk_bf16(float lo, float hi) { f32x2_t v = {lo, hi}; bf16x2_t b = __builtin_convertvector(v, bf16x2_t); return __builtin_bit_cast(unsigned, b); }

template <class Epi, class Sched, bool ALIGN_EPI = false, bool SP2 = false>
__device__ __forceinline__ void gemm_phase(LAS unsigned char* lds, const Gemm g, const Sched& S, const Epi& E) {
    const int tid = opq_v((int)threadIdx.x), wid = __builtin_amdgcn_readfirstlane(tid >> 6), lane = tid & 63, wr = wid >> 2, wc = wid & 3, fr = lane & 15, fq = lane >> 4;
    const int K = g.K, nt = K / BK;
    unsigned voffA[2], voffB[2];
#pragma unroll
    for (int i = 0; i < 2; ++i) { int R, C; stage_rc(tid * 16 + i * 8192, R, C); const int Rb = Epi::PERM ? ((R & ~31) + perm32(R & 31)) : R;
        voffA[i] = (unsigned)(R * K + C) * 2u; voffB[i] = (unsigned)(Rb * K + C) * 2u; }
    const size_t kstep = (size_t)(BK * 2);
    const size_t hstep = (size_t)HALF * K * 2;
    const size_t tstep = 2 * hstep;
    const unsigned ldsw = (unsigned)wid * 1024u;
    const int aoff = lds_byte(wr * 64 + fr, fq * 8), boff = lds_byte(wc * 32 + fr, fq * 8);
#define PG8_SA(b, h) (((b) * 2 + (h)) * HTB)
#define PG8_SB(b, h) ((4 + (b) * 2 + (h)) * HTB)
#define PG8_STAGE(bufoff, gbase, voff) do { _Pragma("unroll") for (int _i = 0; _i < 2; ++_i) \
        __builtin_amdgcn_global_load_lds((const unsigned*)((const char*)(gbase) + (voff)[_i]), (LAS unsigned*)(lds + (bufoff) + ldsw + _i * 8192), 16, 0, 0); } while (0)
#define PG8_LDA(dst, b, h) do { _Pragma("unroll") for (int m = 0; m < 4; ++m) _Pragma("unroll") for (int k = 0; k < 2; ++k) dst[m][k] = *(const LAS bf16x8*)(lds + PG8_SA(b, h) + aoff + m * 2048 + k * 1024); } while (0)
#define PG8_LDB(dst, b, h) do { _Pragma("unroll") for (int n = 0; n < 2; ++n) _Pragma("unroll") for (int k = 0; k < 2; ++k) dst[n][k] = *(const LAS bf16x8*)(lds + PG8_SB(b, h) + boff + n * 2048 + k * 1024); } while (0)
#define PG8_MMA(ai, bj, At, Bt) do { __builtin_amdgcn_s_setprio(1); _Pragma("unroll") for (int m = 0; m < 4; ++m) _Pragma("unroll") for (int n = 0; n < 2; ++n) _Pragma("unroll") for (int k = 0; k < 2; ++k) \
        acc[ai][bj][m][n] = __builtin_amdgcn_mfma_f32_16x16x32_bf16(Bt[n][k], At[m][k], acc[ai][bj][m][n], 0, 0, 0); __builtin_amdgcn_s_setprio(0); } while (0)
#define PG8_WAIT_V(n) asm volatile("s_waitcnt vmcnt(" #n ")" ::: "memory")
#define PG8_WAIT_L(n) asm volatile("s_waitcnt lgkmcnt(" #n ")" ::: "memory")
#define PG8_BAR __builtin_amdgcn_s_barrier()
#define PG8_SCHED __builtin_amdgcn_sched_barrier(0)
    Unit cur, nxt; int ui = 0;
    if (!S.next(0, cur)) return;
    f32x4 acc[2][2][4][2];
#pragma unroll
    for (int a = 0; a < 2; ++a)
#pragma unroll
        for (int b = 0; b < 2; ++b)
#pragma unroll
            for (int m = 0; m < 4; ++m)
#pragma unroll
                for (int n = 0; n < 2; ++n) acc[a][b][m][n] = (f32x4){0.f, 0.f, 0.f, 0.f};
    bf16x8 At[4][2], B0[2][2], B1[2][2];
    const char* cA = (const char*)g.A + (size_t)cur.pm * tstep; const char* cB = (const char*)g.Bt + (size_t)cur.pn * tstep;
    S.a_ready(cur);
    if constexpr (SP2) {
        PG8_STAGE(PG8_SB(0, 0), cB, voffB); PG8_STAGE(PG8_SB(0, 1), cB + hstep, voffB); PG8_STAGE(PG8_SA(0, 0), cA, voffA); PG8_STAGE(PG8_SA(0, 1), cA + hstep, voffA);
        if (wr == 1) PG8_BAR;
        PG8_WAIT_V(2); PG8_BAR;
        PG8_STAGE(PG8_SB(1, 0), cB + kstep, voffB); PG8_STAGE(PG8_SA(1, 0), cA + kstep, voffA); PG8_STAGE(PG8_SB(1, 1), cB + hstep + kstep, voffB);
        PG8_WAIT_V(6); PG8_BAR;
    } else {
        PG8_STAGE(PG8_SB(0, 0), cB, voffB); PG8_STAGE(PG8_SA(0, 0), cA, voffA); PG8_STAGE(PG8_SB(0, 1), cB + hstep, voffB); PG8_STAGE(PG8_SA(0, 1), cA + hstep, voffA);
        if (wr == 1) PG8_BAR;
        PG8_WAIT_V(4); PG8_BAR;
        PG8_STAGE(PG8_SB(1, 0), cB + kstep, voffB); PG8_STAGE(PG8_SA(1, 0), cA + kstep, voffA); PG8_STAGE(PG8_SB(1, 1), cB + hstep + kstep, voffB);
        PG8_WAIT_V(6); PG8_BAR;
    }
    for (;;) {
        const bool has_next = S.next(ui + 1, nxt);
        const char* nA = has_next ? (const char*)g.A + (size_t)nxt.pm * tstep : cA; const char* nB = has_next ? (const char*)g.Bt + (size_t)nxt.pn * tstep : cB;
        for (int t = 0; t < nt; t += 2) {
            const bool last = (t == nt - 2);
            const char* a1 = cA + (size_t)(t + 1) * kstep;
            const char* a2 = last ? nA : cA + (size_t)(t + 2) * kstep; const char* b2 = last ? nB : cB + (size_t)(t + 2) * kstep;
            const char* a3 = a2 + kstep; const char* b3 = b2 + kstep;
            if (last && has_next) S.a_ready(nxt);
            if constexpr (SP2) {
            PG8_LDB(B0, 0, 0); PG8_LDB(B1, 0, 1); PG8_SCHED; PG8_LDA(At, 0, 0); PG8_STAGE(PG8_SA(1, 1), a1 + hstep, voffA);
            PG8_WAIT_V(8); PG8_WAIT_L(0); PG8_BAR; PG8_MMA(0, 0, At, B0); PG8_MMA(0, 1, At, B1); PG8_BAR; PG8_SCHED;
            PG8_LDA(At, 0, 1); PG8_STAGE(PG8_SB(0, 0), b2, voffB); PG8_STAGE(PG8_SB(0, 1), b2 + hstep, voffB); PG8_STAGE(PG8_SA(0, 0), a2, voffA);
            PG8_WAIT_V(8); PG8_WAIT_L(0); PG8_BAR; PG8_MMA(1, 0, At, B0); PG8_MMA(1, 1, At, B1); PG8_BAR; PG8_SCHED;
            PG8_LDB(B0, 1, 0); PG8_LDB(B1, 1, 1); PG8_SCHED; PG8_LDA(At, 1, 0); PG8_STAGE(PG8_SA(0, 1), a2 + hstep, voffA);
            PG8_WAIT_V(8); PG8_WAIT_L(0); PG8_BAR; PG8_MMA(0, 0, At, B0); PG8_MMA(0, 1, At, B1); PG8_BAR; PG8_SCHED;
            PG8_LDA(At, 1, 1); PG8_STAGE(PG8_SB(1, 0), b3, voffB); PG8_STAGE(PG8_SB(1, 1), b3 + hstep, voffB); PG8_STAGE(PG8_SA(1, 0), a3, voffA);
            PG8_WAIT_V(8); PG8_WAIT_L(0); PG8_BAR; PG8_MMA(1, 0, At, B0); PG8_MMA(1, 1, At, B1); PG8_BAR; PG8_SCHED;
            } else {
            PG8_LDB(B0, 0, 0); PG8_SCHED; PG8_LDA(At, 0, 0); PG8_STAGE(PG8_SA(1, 1), a1 + hstep, voffA);
            PG8_WAIT_L(8); PG8_BAR; PG8_WAIT_L(0); PG8_MMA(0, 0, At, B0); PG8_BAR; PG8_SCHED;
            PG8_LDB(B1, 0, 1); PG8_STAGE(PG8_SB(0, 0), b2, voffB);
            PG8_BAR; PG8_WAIT_L(0); PG8_MMA(0, 1, At, B1); PG8_BAR;
            PG8_LDA(At, 0, 1); PG8_STAGE(PG8_SA(0, 0), a2, voffA);
            PG8_BAR; PG8_WAIT_L(0); PG8_MMA(1, 0, At, B0); PG8_BAR; PG8_SCHED;
            PG8_STAGE(PG8_SB(0, 1), b2 + hstep, voffB);
            PG8_WAIT_V(6); PG8_BAR; PG8_MMA(1, 1, At, B1); PG8_BAR;
            PG8_LDB(B0, 1, 0); PG8_SCHED; PG8_LDA(At, 1, 0); PG8_STAGE(PG8_SA(0, 1), a2 + hstep, voffA);
            PG8_WAIT_L(8); PG8_BAR; PG8_WAIT_L(0); PG8_MMA(0, 0, At, B0); PG8_BAR; PG8_SCHED;
            PG8_LDB(B1, 1, 1); PG8_STAGE(PG8_SB(1, 0), b3, voffB);
            PG8_BAR; PG8_WAIT_L(0); PG8_MMA(0, 1, At, B1); PG8_BAR;
            PG8_LDA(At, 1, 1); PG8_STAGE(PG8_SA(1, 0), a3, voffA);
            PG8_BAR; PG8_WAIT_L(0); PG8_MMA(1, 0, At, B0); PG8_BAR; PG8_SCHED;
            PG8_STAGE(PG8_SB(1, 1), b3 + hstep, voffB);
            PG8_WAIT_V(6); PG8_BAR; PG8_MMA(1, 1, At, B1); PG8_BAR;
            }
        }
        if constexpr (ALIGN_EPI) { if (wr == 0) PG8_BAR; }
        if constexpr (!Epi::AFTER_DRAIN) { E(acc, cur, wr, wc, fr, fq); S.done(cur); }
        if (!has_next) break;
#pragma unroll
        for (int a = 0; a < 2; ++a)
#pragma unroll
            for (int b = 0; b < 2; ++b)
#pragma unroll
                for (int m = 0; m < 4; ++m)
#pragma unroll
                    for (int n = 0; n < 2; ++n) acc[a][b][m][n] = (f32x4){0.f, 0.f, 0.f, 0.f};
        cur = nxt; cA = nA; cB = nB; ++ui;
        if constexpr (ALIGN_EPI) { if (wr == 1) PG8_BAR; }
    }
    PG8_WAIT_V(0);
    if constexpr (!ALIGN_EPI) { if (wr == 0) PG8_BAR; }
    PG8_BAR;
    if constexpr (Epi::AFTER_DRAIN) { E.fused(acc, cur, wr, wc, fr, fq, lds, wid, lane); S.done(cur); }
#undef PG8_SA
#undef PG8_SB
#undef PG8_STAGE
#undef PG8_LDA
#undef PG8_LDB
#undef PG8_MMA
#undef PG8_WAIT_V
#undef PG8_WAIT_L
#undef PG8_BAR
#undef PG8_SCHED
}

struct EpiSwiglu {
    static constexpr bool PERM = true, AFTER_DRAIN = false;
    bf16_t* O;
    __device__ __forceinline__ void tail(int row, int col, float a_, float u_) const { O[(size_t)row * DFF + col] = (bf16_t)f2bf(a_ * sigmoidf_(a_) * u_); }
    __device__ __forceinline__ void operator()(const f32x4 (&acc)[2][2][4][2], const Unit& u, int wr, int wc, int fr, int fq) const {
        const int row0 = u.pm * BM + wr * 64 + fr, col0 = u.pn * 128 + wc * 32 + 8 * fq;
#pragma unroll
        for (int ai = 0; ai < 2; ++ai)
#pragma unroll
            for (int m = 0; m < 4; ++m) {
                bf16_t* p = O + (size_t)(row0 + ai * HALF + m * 16) * DFF + col0;
                float v[8];
#pragma unroll
                for (int n = 0; n < 2; ++n)
#pragma unroll
                    for (int j = 0; j < 4; ++j) { const float a = acc[ai][0][m][n][j], g = acc[ai][1][m][n][j]; v[n * 4 + j] = a * sigmoidf_(a) * g; }
                u32x4 w; w.x = cvt_pk_bf16(v[0], v[1]); w.y = cvt_pk_bf16(v[2], v[3]); w.z = cvt_pk_bf16(v[4], v[5]); w.w = cvt_pk_bf16(v[6], v[7]);
                *(u32x4*)p = w;
            }
    }
};
struct EpiResid {
    static constexpr bool PERM = false, AFTER_DRAIN = false;
    const float* H; float* PRE; float s;
    __device__ __forceinline__ void tail(int row, int col, float v, float) const { const size_t o = (size_t)row * D + col; PRE[o] = H[o] * ALPHA + v * s; }
    __device__ __forceinline__ void operator()(const f32x4 (&acc)[2][2][4][2], const Unit& u, int wr, int wc, int fr, int fq) const {
        const int row0 = u.pm * BM + wr * 64 + fr, col0 = u.pn * BM + wc * 32 + 4 * fq;
#pragma unroll
        for (int ai = 0; ai < 2; ++ai)
#pragma unroll
            for (int m = 0; m < 4; ++m) {
                const size_t off = (size_t)(row0 + ai * HALF + m * 16) * D + col0;
#pragma unroll
                for (int bj = 0; bj < 2; ++bj)
#pragma unroll
                    for (int n = 0; n < 2; ++n) { const f32x4 h = *(const f32x4*)(H + off + bj * HALF + n * 16); *(f32x4*)(PRE + off + bj * HALF + n * 16) = h * ALPHA + acc[ai][bj][m][n] * s; }
            }
    }
};
struct EpiInproj {
    static constexpr bool PERM = true, AFTER_DRAIN = false;
    float* ZP; float* ZH; bf16_t* QA; bf16_t* KA; bf16_t* VA; bf16_t* G;
    __device__ __forceinline__ void tail(int row, int c, float v, float) const {
        if (c < 512) ZP[(size_t)row * PW + c] = v;
        else if (c < 2816) ZH[(size_t)row * 3072 + (c - 512)] = v;
        else if (c < 3584) (G + (WS_HG - WS_G) / 2)[(size_t)row * HW + (c - 2816)] = (bf16_t)f2bf(v);
        else if (c < 5888) { const int seg = (c - 3584) / 768, cc = c - 3584 - seg * 768; const int b_ = row >= L ? 1 : 0, t_ = row - b_ * L;
            if (seg == 2) VA[((size_t)b_ * 768 + cc) * LP + t_] = (bf16_t)f2bf(v);
            else (QA + (size_t)seg * ((WS_KA - WS_QA) / 2))[(size_t)(b_ * LP + t_) * 768 + cc] = (bf16_t)f2bf(seg == 0 ? v * C2 : v); }
        else G[(size_t)row * 6144 + (c - 5888)] = (bf16_t)f2bf(sigmoidf_(v));
    }
    __device__ __forceinline__ void operator()(const f32x4 (&acc)[2][2][4][2], const Unit& u, int wr, int wc, int fr, int fq) const {
        const int row0 = u.pm * BM + wr * 64 + fr, pn = u.pn;
#pragma unroll
        for (int ai = 0; ai < 2; ++ai)
#pragma unroll
            for (int m = 0; m < 4; ++m) {
                const int row = row0 + ai * HALF + m * 16;
#pragma unroll
                for (int bj = 0; bj < 2; ++bj) {
                    const int c = pn * BM + bj * HALF + wc * 32 + 8 * fq;
                    const f32x4 v0 = acc[ai][bj][m][0], v1 = acc[ai][bj][m][1];
                    if (pn < 2) { float* p = ZP + (size_t)row * PW + c; *(f32x4*)p = v0; *(f32x4*)(p + 4) = v1; }
                    else if (pn < 11) { float* p = ZH + (size_t)row * 3072 + (c - 512); *(f32x4*)p = v0; *(f32x4*)(p + 4) = v1; }
                    else if (pn < 14) { u32x4 w; w.x = cvt_pk_bf16(v0[0], v0[1]); w.y = cvt_pk_bf16(v0[2], v0[3]); w.z = cvt_pk_bf16(v1[0], v1[1]); w.w = cvt_pk_bf16(v1[2], v1[3]);
                        *(u32x4*)(G + (WS_HG - WS_G) / 2 + (size_t)row * HW + (c - 2816)) = w; }
                    else if (pn < 23) {
                        const int seg = (pn - 14) / 3, cc = c - 3584 - seg * 768;
                        if (row < T && seg == 2) {
                            const int b_ = row >= L ? 1 : 0, t_ = row - b_ * L;
                            bf16_t* vt = VA + ((size_t)b_ * 768 + cc) * LP + t_;
                            vt[0] = (bf16_t)f2bf(v0[0]); vt[LP] = (bf16_t)f2bf(v0[1]); vt[2 * LP] = (bf16_t)f2bf(v0[2]); vt[3 * LP] = (bf16_t)f2bf(v0[3]);
                            vt[4 * LP] = (bf16_t)f2bf(v1[0]); vt[5 * LP] = (bf16_t)f2bf(v1[1]); vt[6 * LP] = (bf16_t)f2bf(v1[2]); vt[7 * LP] = (bf16_t)f2bf(v1[3]);
                        } else if (row < T) {
                            const int arow = row >= L ? row - L + LP : row;
                            bf16_t* base = QA + (size_t)seg * ((WS_KA - WS_QA) / 2); const float sc = seg == 0 ? C2 : 1.f;
                            u32x4 w; w.x = cvt_pk_bf16(v0[0] * sc, v0[1] * sc); w.y = cvt_pk_bf16(v0[2] * sc, v0[3] * sc); w.z = cvt_pk_bf16(v1[0] * sc, v1[1] * sc); w.w = cvt_pk_bf16(v1[2] * sc, v1[3] * sc);
                            *(u32x4*)(base + (size_t)arow * 768 + cc) = w;
                        }
                    } else {
                        u32x4 w; w.x = cvt_pk_bf16(sigmoidf_(v0[0]), sigmoidf_(v0[1])); w.y = cvt_pk_bf16(sigmoidf_(v0[2]), sigmoidf_(v0[3]));
                        w.z = cvt_pk_bf16(sigmoidf_(v1[0]), sigmoidf_(v1[1])); w.w = cvt_pk_bf16(sigmoidf_(v1[2]), sigmoidf_(v1[3]));
                        *(u32x4*)(G + (size_t)row * 6144 + (c - 5888)) = w;
                    }
                }
            }
    }
};
struct EpiBranch {
    static constexpr bool PERM = true, AFTER_DRAIN = false;
    const bf16_t* G; int goff; float* MF; bf16_t* MB; int mode;
    __device__ __forceinline__ void tail(int row, int c, float v, float) const {
        v *= bf2f(G[(size_t)row * 6144 + goff + c]); bf16_t* mb = MB + (size_t)row * D + c;
        if (mode != 0) v += bf2f(__hip_atomic_load(mb, __ATOMIC_RELAXED, __HIP_MEMORY_SCOPE_AGENT));
        *mb = (bf16_t)f2bf(v);
    }
    __device__ __forceinline__ void operator()(const f32x4 (&acc)[2][2][4][2], const Unit& u, int wr, int wc, int fr, int fq) const {
        const int row0 = u.pm * BM + wr * 64 + fr;
#pragma unroll
        for (int ai = 0; ai < 2; ++ai)
#pragma unroll
            for (int m = 0; m < 4; ++m) {
                const int row = row0 + ai * HALF + m * 16;
#pragma unroll
                for (int bj = 0; bj < 2; ++bj) {
                    const int c = u.pn * BM + bj * HALF + wc * 32 + 8 * fq;
                    const u32x4 gw = *(const u32x4*)(G + (size_t)row * 6144 + goff + c);
                    f32x4 v0 = acc[ai][bj][m][0], v1 = acc[ai][bj][m][1];
                    v0[0] *= bflo(gw.x); v0[1] *= bfhi(gw.x); v0[2] *= bflo(gw.y); v0[3] *= bfhi(gw.y);
                    v1[0] *= bflo(gw.z); v1[1] *= bfhi(gw.z); v1[2] *= bflo(gw.w); v1[3] *= bfhi(gw.w);
                    bf16_t* mb = MB + (size_t)row * D + c;
                    if (mode != 0) { const u32x4 pw = __builtin_nontemporal_load((const u32x4*)mb);
                        v0[0] += bflo(pw.x); v0[1] += bfhi(pw.x); v0[2] += bflo(pw.y); v0[3] += bfhi(pw.y); v1[0] += bflo(pw.z); v1[1] += bfhi(pw.z); v1[2] += bflo(pw.w); v1[3] += bfhi(pw.w); }
                    u32x4 w; w.x = cvt_pk_bf16(v0[0], v0[1]); w.y = cvt_pk_bf16(v0[2], v0[3]); w.z = cvt_pk_bf16(v1[0], v1[1]); w.w = cvt_pk_bf16(v1[2], v1[3]);
                    *(u32x4*)mb = w;
                }
            }
    }
};

struct PanelStats {
    unsigned* xbuf;
    unsigned* cnt;
    float eps;
    __device__ __forceinline__ void run(const f32x4 (&v)[2][2][4][2], const Unit& u, int wr, int wc, int fr, int fq, LAS unsigned char* lds, int wid, int lane) const {
        LAS f32x2* P = (LAS f32x2*)lds;
        LAS f32x2* S = (LAS f32x2*)(lds + 8192);
#pragma unroll
        for (int ai = 0; ai < 2; ++ai)
#pragma unroll
            for (int m = 0; m < 4; ++m) {
                float s = 0.f;
#pragma unroll
                for (int bj = 0; bj < 2; ++bj)
#pragma unroll
                    for (int n = 0; n < 2; ++n) { const f32x4 x = v[ai][bj][m][n]; s += (x[0] + x[1]) + (x[2] + x[3]); }
                s += __shfl_xor(s, 16); s += __shfl_xor(s, 32);
                const float mw = s * (1.0f / 64.0f); float q = 0.f;
#pragma unroll
                for (int bj = 0; bj < 2; ++bj)
#pragma unroll
                    for (int n = 0; n < 2; ++n) { const f32x4 d = v[ai][bj][m][n] - mw; q += (d[0] * d[0] + d[1] * d[1]) + (d[2] * d[2] + d[3] * d[3]); }
                q += __shfl_xor(q, 16); q += __shfl_xor(q, 32);
                if (fq == 0) P[(ai * HALF + wr * 64 + m * 16 + fr) * 4 + wc] = (f32x2){mw, q};
            }
        asm volatile("s_waitcnt lgkmcnt(0)" ::: "memory"); __builtin_amdgcn_s_barrier(); asm volatile("" ::: "memory");
        const int row = wid * 32 + (lane & 31);
        if (lane < 32) {
            const f32x2 a = P[row * 4 + 0], b = P[row * 4 + 1], c = P[row * 4 + 2], d = P[row * 4 + 3];
            const float mt = (a.x + b.x + c.x + d.x) * 0.25f;
            const float da = a.x - mt, db = b.x - mt, dc = c.x - mt, dd = d.x - mt;
            const float m2 = (a.y + b.y) + (c.y + d.y) + 64.0f * ((da * da + db * db) + (dc * dc + dd * dd));
            unsigned long long* slot = (unsigned long long*)xbuf + ((size_t)(u.pm * BM + row) * 8 + u.pn);
            __hip_atomic_store(slot, ((unsigned long long)__float_as_uint(m2) << 32) | __float_as_uint(mt), __ATOMIC_RELAXED, __HIP_MEMORY_SCOPE_AGENT);
        }
        asm volatile("s_waitcnt vmcnt(0)" ::: "memory");
        if (lane == 0) __hip_atomic_fetch_add(cnt + 64 * u.pm, 1u, __ATOMIC_RELAXED, __HIP_MEMORY_SCOPE_AGENT);
        if (wid == 0) {
            unsigned sp = 0;
            while ((unsigned)__builtin_amdgcn_readfirstlane(__hip_atomic_load(cnt + 64 * u.pm, __ATOMIC_RELAXED, __HIP_MEMORY_SCOPE_AGENT)) < 64u) { __builtin_amdgcn_s_sleep(2); if (++sp > (1u << 24)) break; }
            __builtin_amdgcn_fence(__ATOMIC_ACQUIRE, "agent");
        }
        asm volatile("s_waitcnt vmcnt(0) lgkmcnt(0)" ::: "memory"); __builtin_amdgcn_s_barrier(); asm volatile("" ::: "memory");
        if (lane < 32) {
            const unsigned long long* slot = (const unsigned long long*)xbuf + (size_t)(u.pm * BM + row) * 8; float mt[8], m2[8]; float ms = 0.f;
#pragma unroll
            for (int t = 0; t < 8; ++t) { const unsigned long long w = __hip_atomic_load(slot + t, __ATOMIC_RELAXED, __HIP_MEMORY_SCOPE_AGENT); mt[t] = __uint_as_float((unsigned)w); m2[t] = __uint_as_float((unsigned)(w >> 32)); ms += mt[t]; }
            const float mean = ms * 0.125f; float q = 0.f;
#pragma unroll
            for (int t = 0; t < 8; ++t) { const float dm = mt[t] - mean; q += m2[t] + 256.0f * dm * dm; }
            S[row] = (f32x2){mean, 1.0f / sqrtf(q * (1.0f / 2048.0f) + eps)};
        }
        asm volatile("s_waitcnt lgkmcnt(0)" ::: "memory"); __builtin_amdgcn_s_barrier(); asm volatile("" ::: "memory");
    }
};
struct EpiLn {
    static constexpr bool PERM = false, AFTER_DRAIN = true;
    float* H; bf16_t* HB; const float* g; const float* bta; float s; PanelStats st; float* out;
    __device__ __forceinline__ void fused(f32x4 (&acc)[2][2][4][2], const Unit& u, int wr, int wc, int fr, int fq, LAS unsigned char* lds, int wid, int lane) const {
        const LAS f32x2* S = (const LAS f32x2*)(lds + 8192);
        const int col0 = u.pn * BM + wc * 32 + 4 * fq;
#pragma unroll
        for (int ai = 0; ai < 2; ++ai)
#pragma unroll
            for (int m = 0; m < 4; ++m) { const size_t off = (size_t)(u.pm * BM + ai * HALF + wr * 64 + m * 16 + fr) * D + col0;
#pragma unroll
                for (int bj = 0; bj < 2; ++bj)
#pragma unroll
                    for (int n = 0; n < 2; ++n) { const f32x4 h = *(const f32x4*)(H + off + bj * HALF + n * 16); acc[ai][bj][m][n] = h * ALPHA + acc[ai][bj][m][n] * s; }
                asm volatile("" : "+v"(acc[ai][0][m][0]), "+v"(acc[ai][0][m][1]), "+v"(acc[ai][1][m][0]), "+v"(acc[ai][1][m][1]));
                if (m & 1) asm volatile("" ::: "memory"); }
        st.run(acc, u, wr, wc, fr, fq, lds, wid, lane);
#pragma unroll
        for (int ai = 0; ai < 2; ++ai)
#pragma unroll
            for (int m = 0; m < 4; ++m) { const int r = ai * HALF + wr * 64 + m * 16 + fr, row = u.pm * BM + r; const f32x2 sr = S[r];
#pragma unroll
                for (int bj = 0; bj < 2; ++bj)
#pragma unroll
                    for (int n = 0; n < 2; ++n) { const int c = col0 + bj * HALF + n * 16; const f32x4 o = (acc[ai][bj][m][n] - sr.x) * sr.y * *(const f32x4*)(g + c) + *(const f32x4*)(bta + c);
                        if (out) { const int b_ = row >= L ? 1 : 0, t_ = row - b_ * L; if (t_ >= NMETA) *(f32x4*)(out + ((size_t)b_ * SEQ + (t_ - NMETA)) * D + c) = o; }
                        else { *(f32x4*)(H + (size_t)row * D + c) = o; u32x2 w; w.x = cvt_pk_bf16(o[0], o[1]); w.y = cvt_pk_bf16(o[2], o[3]); *(u32x2*)(HB + (size_t)row * D + c) = w; } } }
    }
};
}


constexpr int MT = 8192;
template <class Epi, bool PAIR>
__device__ __forceinline__ void tail_gemm(const bf16_t* A, const bf16_t* Bt, int K, int ncols, const Epi& E, unsigned char* lds_g, int blk, int nblk) {
    const int tid = opq_v((int)threadIdx.x), lane = tid & 63, wid = __builtin_amdgcn_readfirstlane(tid >> 6), m = lane & 31, hi = lane >> 5;
    float* P = (float*)lds_g;
    const int kslice = K / 8, k0 = wid * kslice;
    for (int tu = blk; tu < ncols / 32; tu += nblk) {
        const int n0 = tu * 32, brow = PAIR ? ((n0 / 128) * 256 + (n0 % 128)) : n0;
        const bf16_t* ap = A + (size_t)(MT + m) * K + k0 + 8 * hi; const bf16_t* bp = Bt + (size_t)(brow + m) * K + k0 + 8 * hi;
        f32x16_t acc0 = (f32x16_t){0.f, 0.f, 0.f, 0.f, 0.f, 0.f, 0.f, 0.f, 0.f, 0.f, 0.f, 0.f, 0.f, 0.f, 0.f, 0.f}, acc1 = acc0;
#pragma unroll 8
        for (int ks = 0; ks < kslice; ks += 16) {
            const bf16x8 av = *(const bf16x8*)(ap + ks), bv = *(const bf16x8*)(bp + ks);
            acc0 = __builtin_amdgcn_mfma_f32_32x32x16_bf16(av, bv, acc0, 0, 0, 0);
            if (PAIR) { const bf16x8 bu = *(const bf16x8*)(bp + (size_t)128 * K + ks); acc1 = __builtin_amdgcn_mfma_f32_32x32x16_bf16(av, bu, acc1, 0, 0, 0); }
        }
        __syncthreads();
#pragma unroll
        for (int r = 0; r < 16; ++r) { const int rm = (r & 3) + 8 * (r >> 2) + 4 * hi; P[wid * 1024 + rm * 32 + m] = acc0[r]; if (PAIR) P[8192 + wid * 1024 + rm * 32 + m] = acc1[r]; }
        __syncthreads();
#pragma unroll
        for (int e = 0; e < 2; ++e) { const int idx = tid * 2 + e; float v0 = 0.f, v1 = 0.f;
#pragma unroll
            for (int w = 0; w < 8; ++w) { v0 += P[w * 1024 + idx]; if (PAIR) v1 += P[8192 + w * 1024 + idx]; }
            E.tail(MT + (idx >> 5), n0 + (idx & 31), v0, v1); }
    }
    __syncthreads();
}

struct Args {
    const float* x; const float* meta; const float* ln_g; const float* ln_b; const float* ffn_w_in; const float* ffn_w_out; const float* w_in;
    const float* pool_w; const float* pool_scale; const float* hgrn_lb; const float* hgrn_ng; const float* diff_lambda; const float* diff_ng;
    const float* w_bp; const float* w_bh; const float* w_bd; const float* w_out;
    float* out; unsigned char* ws;
};

typedef const Args* ArgP;
__device__ __forceinline__ ArgP argp() { unsigned z; asm volatile("s_mov_b32 %0, 0" : "=s"(z)); return (ArgP)(const void*)((const __attribute__((address_space(4))) char*)__builtin_amdgcn_kernarg_segment_ptr() + z); }

__device__ __forceinline__ void transpose_item(const float* W, int K, int N, bf16_t* WT, int swiglu, float* scr, int item, int lane) {
    const int nblk = N / 64, kb = item / nblk, nb = item % nblk, k0 = 64 * kb, n0 = 64 * nb;
    int drow0 = n0;
    if (swiglu) { const int half = n0 / DFF, rem = n0 % DFF; drow0 = (rem / 128) * 256 + half * 128 + (rem % 128); }
    f32x4 v[16];
#pragma unroll
    for (int i = 0; i < 16; ++i) v[i] = *(const f32x4*)(W + (size_t)(k0 + 4 * i + (lane >> 4)) * N + n0 + 4 * (lane & 15));
#pragma unroll
    for (int i = 0; i < 16; ++i) { float* s = scr + (4 * i + (lane >> 4)) * 65 + 4 * (lane & 15); s[0] = v[i][0]; s[1] = v[i][1]; s[2] = v[i][2]; s[3] = v[i][3]; }
    asm volatile("s_waitcnt lgkmcnt(0)" ::: "memory");
    const int c = lane & 7;
#pragma unroll
    for (int j = 0; j < 8; ++j) { const int n = (lane >> 3) + 8 * j; const float* s = scr + (8 * c) * 65 + n;
        u32x4 o; o.x = pk2(s[0 * 65], s[1 * 65]); o.y = pk2(s[2 * 65], s[3 * 65]); o.z = pk2(s[4 * 65], s[5 * 65]); o.w = pk2(s[6 * 65], s[7 * 65]);
        *(u32x4*)(WT + (size_t)(drow0 + n) * K + k0 + 8 * c) = o; }
    asm volatile("s_waitcnt lgkmcnt(0)" ::: "memory");
}

__device__ __forceinline__ void prologue(unsigned char* lds_g, int gw, int NGW, int lane) {
    const Args a = *argp();
    float* scr = (float*)lds_g + (opq_v((int)threadIdx.x) >> 6) * (64 * 65);
    unsigned char* ws = a.ws;
    constexpr int I_UP = (D / 64) * (2 * DFF / 64), I_DN = (DFF / 64) * (D / 64), I_IN = (D / 64) * (INCOLS / 64);
    constexpr int I_BP = (PW / 64) * (D / 64), I_BH = (HW / 64) * (D / 64), I_WO = (D / 64) * (D / 64);
    constexpr int PER_L = 2 * I_UP + 2 * I_DN + I_IN + I_BP + 2 * I_BH + I_WO;
    for (int it = gw; it < 2 * PER_L; it += NGW) {
        const int l = it / PER_L; int r = it % PER_L;
        if (r < 2 * I_UP) { const int j = r / I_UP; r %= I_UP; transpose_item(a.ffn_w_in + (size_t)(l * 2 + j) * D * 2 * DFF, D, 2 * DFF, (bf16_t*)(ws + WS_WUP + (size_t)(l * 2 + j) * SZ_WUP), 1, scr, r, lane); continue; } r -= 2 * I_UP;
        if (r < 2 * I_DN) { const int j = r / I_DN; r %= I_DN; transpose_item(a.ffn_w_out + (size_t)(l * 2 + j) * DFF * D, DFF, D, (bf16_t*)(ws + WS_WDN + (size_t)(l * 2 + j) * SZ_WDN), 0, scr, r, lane); continue; } r -= 2 * I_DN;
        if (r < I_IN) { transpose_item(a.w_in + (size_t)l * D * INCOLS, D, INCOLS, (bf16_t*)(ws + WS_WIN + (size_t)l * SZ_WIN), 0, scr, r, lane); continue; } r -= I_IN;
        if (r < I_BP) { transpose_item(a.w_bp + (size_t)l * PW * D, PW, D, (bf16_t*)(ws + WS_WBP + (size_t)l * D * PW * 2), 0, scr, r, lane); continue; } r -= I_BP;
        if (r < I_BH) { transpose_item(a.w_bh + (size_t)l * HW * D, HW, D, (bf16_t*)(ws + WS_WBH + (size_t)l * D * HW * 2), 0, scr, r, lane); continue; } r -= I_BH;
        if (r < I_BH) { transpose_item(a.w_bd + (size_t)l * DW * D, DW, D, (bf16_t*)(ws + WS_WBD + (size_t)l * D * DW * 2), 0, scr, r, lane); continue; } r -= I_BH;
        transpose_item(a.w_out + (size_t)l * D * D, D, D, (bf16_t*)(ws + WS_WO + (size_t)l * D * D * 2), 0, scr, r, lane);
    }
    float* H = (float*)(ws + WS_H); bf16_t* HB = (bf16_t*)(ws + WS_HB);
    for (int r = gw; r < MP; r += NGW) {
        const float* src = nullptr;
        if (r < T) { const int b = r / L, t = r % L; src = t < NMETA ? a.meta + (size_t)t * D : a.x + ((size_t)b * SEQ + (t - NMETA)) * D; }
#pragma unroll
        for (int j = 0; j < 8; ++j) {
            f32x4 v = src ? *(const f32x4*)(src + 4 * lane + 256 * j) : (f32x4){0.f, 0.f, 0.f, 0.f};
            *(f32x4*)(H + (size_t)r * D + 4 * lane + 256 * j) = v;
            u32x2 w; w.x = pk2(v[0], v[1]); w.y = pk2(v[2], v[3]);
            *(u32x2*)(HB + (size_t)r * D + 4 * lane + 256 * j) = w;
        }
    }
    for (int i = gw; i < NB * (LP - L) * 2; i += NGW) {
        const int seg = i / (NB * (LP - L)), rr = i % (NB * (LP - L)), b = rr / (LP - L), t = L + rr % (LP - L);
        bf16_t* base = (bf16_t*)(ws + WS_QA + (size_t)seg * (WS_KA - WS_QA)) + (size_t)(b * LP + t) * 768;
        for (int c = lane; c < 768 / 8; c += 64) *(u32x4*)(base + 8 * c) = (u32x4){0u, 0u, 0u, 0u};
    }
    for (int i = gw; i < NB * 768; i += NGW) {
        bf16_t* base = (bf16_t*)(ws + WS_VA) + (size_t)i * LP + L;
        for (int c = lane; c < (LP - L) / 8; c += 64) *(u32x4*)(base + 8 * c) = (u32x4){0u, 0u, 0u, 0u};
    }
}

__device__ __forceinline__ void ln_rows(int lnidx, bool final_, int r_begin, int r_end, int gw, int NGW, int lane) {
    const Args a = *argp(); const float* g = a.ln_g + (size_t)lnidx * D; const float* bvec = a.ln_b + (size_t)lnidx * D;
    const float* PRE = (const float*)(a.ws + WS_PRE); float* H = (float*)(a.ws + WS_H); bf16_t* HB = (bf16_t*)(a.ws + WS_HB);
    for (int r = r_begin + gw; r < r_end; r += NGW) {
        f32x4 v[8]; float s = 0.f;
#pragma unroll
        for (int j = 0; j < 8; ++j) { v[j] = *(const f32x4*)(PRE + (size_t)r * D + 4 * lane + 256 * j); s += (v[j][0] + v[j][1]) + (v[j][2] + v[j][3]); }
        const float mean = wave_sum(s) * (1.f / D); float s2 = 0.f;
#pragma unroll
        for (int j = 0; j < 8; ++j) { v[j] = v[j] - mean; s2 += (v[j][0] * v[j][0] + v[j][1] * v[j][1]) + (v[j][2] * v[j][2] + v[j][3] * v[j][3]); }
        const float rstd = 1.f / sqrtf(wave_sum(s2) * (1.f / D) + LN_EPS);
        if (final_) {
            const int b = r / L, t = r % L;
            if (t >= NMETA) {
                float* o = a.out + ((size_t)b * SEQ + (t - NMETA)) * D;
#pragma unroll
                for (int j = 0; j < 8; ++j) { const f32x4 gg = *(const f32x4*)(g + 4 * lane + 256 * j), bb = *(const f32x4*)(bvec + 4 * lane + 256 * j); *(f32x4*)(o + 4 * lane + 256 * j) = v[j] * rstd * gg + bb; }
            }
        } else {
#pragma unroll
            for (int j = 0; j < 8; ++j) { const f32x4 gg = *(const f32x4*)(g + 4 * lane + 256 * j), bb = *(const f32x4*)(bvec + 4 * lane + 256 * j); const f32x4 o = v[j] * rstd * gg + bb;
                *(f32x4*)(H + (size_t)r * D + 4 * lane + 256 * j) = o; u32x2 w; w.x = pk2(o[0], o[1]); w.y = pk2(o[2], o[3]); *(u32x2*)(HB + (size_t)r * D + 4 * lane + 256 * j) = w; }
        }
    }
}

__device__ __forceinline__ void pool_phase(int l, unsigned char* lds_g, int blk, int nblk) {
    const Args a = *argp();
    const float* ZP = (const float*)(a.ws + WS_ZP); bf16_t* YP = (bf16_t*)(a.ws + WS_YP);
    constexpr int WP = 136;
    bf16_t* WT = (bf16_t*)lds_g;
    bf16_t* Pb = WT + 128 * WP;
    float* U = (float*)(lds_g + 53248);
    const int tid = opq_v((int)threadIdx.x), lane = tid & 63, wid = tid >> 6, r32 = lane & 31, hi = lane >> 5;
    const int g = blk & 3, bi = blk >> 2, nb = nblk >> 2, w = 2 << g;
    const float* Wg = a.pool_w + ((size_t)l * 4 + g) * 128 * 128;
    for (int i = tid; i < 128 * 32; i += 512) { const int c = i >> 5, d4 = i & 31; const f32x4 v = *(const f32x4*)(Wg + c * 128 + 4 * d4);
        WT[(4 * d4 + 0) * WP + c] = (bf16_t)f2bf(v[0]); WT[(4 * d4 + 1) * WP + c] = (bf16_t)f2bf(v[1]); WT[(4 * d4 + 2) * WP + c] = (bf16_t)f2bf(v[2]); WT[(4 * d4 + 3) * WP + c] = (bf16_t)f2bf(v[3]); }
    const int dt = wid & 3, tt = wid >> 2;
    const float scv = a.pool_scale[l * PW + g * 128 + 32 * dt + r32];
    constexpr int TPB = (L + 63) / 64;
    for (int tile = bi; tile < NB * TPB; tile += nb) {
        const int b = tile / TPB, t0 = (tile % TPB) * 64;
        __syncthreads();
        for (int i = tid; i < 79 * 32; i += 512) { const int rr = i >> 5, c4 = i & 31, t = t0 - 15 + rr;
            ((f32x4*)U)[i] = (t >= 0 && t < L) ? *(const f32x4*)(ZP + (size_t)(b * L + t) * PW + g * 128 + 4 * c4) : (f32x4){0.f, 0.f, 0.f, 0.f}; }
        __syncthreads();
        { const int c = tid & 127, ts = (tid >> 7) * 16;
            float s_ = 0.f;
            for (int q = 1; q < w; ++q) { const int t = t0 + ts - q; if (t >= 0) s_ += U[(ts - q + 15) * 128 + c]; }
            for (int k = 0; k < 16; ++k) { const int ti = ts + k, t = t0 + ti; const float ut = U[(ti + 15) * 128 + c]; s_ += ut;
                const int cnt = (t + 1) < w ? (t + 1) : w;
                Pb[ti * WP + c] = (bf16_t)f2bf(s_ / (float)cnt - ut);
                if (t + 1 - w >= 0) s_ -= U[(ti + 15 - w + 1) * 128 + c]; } }
        __syncthreads();
        f32x16_t acc = (f32x16_t){0.f, 0.f, 0.f, 0.f, 0.f, 0.f, 0.f, 0.f, 0.f, 0.f, 0.f, 0.f, 0.f, 0.f, 0.f, 0.f};
#pragma unroll
        for (int i = 0; i < 8; ++i) { const bf16x8 av = *(const bf16x8*)(Pb + (32 * tt + r32) * WP + 16 * i + 8 * hi), bv = *(const bf16x8*)(WT + (32 * dt + r32) * WP + 16 * i + 8 * hi);
            acc = __builtin_amdgcn_mfma_f32_32x32x16_bf16(av, bv, acc, 0, 0, 0); }
#pragma unroll
        for (int r = 0; r < 16; ++r) { const int t = t0 + 32 * tt + (r & 3) + 8 * (r >> 2) + 4 * hi;
            if (t < L) YP[(size_t)(b * L + t) * PW + g * 128 + 32 * dt + r32] = (bf16_t)f2bf(acc[r] * scv); }
    }
    __syncthreads();
}

__device__ __forceinline__ void hgrn_naive(int l, unsigned char* lds_g, int blk) {
    const Args a = *argp();
    const float* ZH = (const float*)(a.ws + WS_ZH); float* OH = (float*)(a.ws + WS_OH);
    const int tid = opq_v((int)threadIdx.x), ch = tid >> 8, j = tid & 127, kh = (tid >> 7) & 1, chain = blk * 2 + ch, b = chain / 6, h = chain % 6;
    float* sh = (float*)lds_g + ch * 640;
    float lb = 0.f;
    if (l == 1) { const float x0 = a.hgrn_lb[h * 128 + j], x1 = a.hgrn_lb[HW + h * 128 + j]; const float e0 = __expf(x0), e1 = __expf(x1); lb = e1 / (e0 + e1); }
    float S[64];
#pragma unroll
    for (int k = 0; k < 64; ++k) S[k] = 0.f;
    for (int t = 0; t < L; ++t) {
        const float* z = ZH + (size_t)(b * L + t) * 3072 + h * 128;
        if (kh == 0) { const float fz = z[768 + j], f = lb + (1.f - lb) * (1.f / (1.f + __expf(-fz))); sh[j] = f; sh[128 + j] = 1.f - f; sh[256 + j] = z[j]; }
        const float vj = z[1536 + j];
        __syncthreads();
        float o = 0.f;
#pragma unroll
        for (int k4 = 0; k4 < 16; ++k4) {
            const f32x4 f4 = *(const f32x4*)(sh + kh * 64 + 4 * k4), k4v = *(const f32x4*)(sh + 128 + kh * 64 + 4 * k4), q4 = *(const f32x4*)(sh + 256 + kh * 64 + 4 * k4);
#pragma unroll
            for (int e = 0; e < 4; ++e) { S[4 * k4 + e] = f4[e] * S[4 * k4 + e] + k4v[e] * vj; o += q4[e] * S[4 * k4 + e]; }
        }
        sh[384 + kh * 128 + j] = o;
        __syncthreads();
        if (kh == 0) OH[(size_t)(b * L + t) * HW + h * 128 + j] = (sh[384 + j] + sh[512 + j]) * 0.08838834764831845f;
    }
}

__device__ __forceinline__ void attn_naive(int blk, int nblk) {
    const Args a = *argp();
    const bf16_t* QA = (const bf16_t*)(a.ws + WS_QA); const bf16_t* KA = (const bf16_t*)(a.ws + WS_KA); const bf16_t* VA = (const bf16_t*)(a.ws + WS_VA);
    float* OD = (float*)(a.ws + WS_OD);
    const int tid = opq_v((int)threadIdx.x), wid = tid >> 6;
    for (int unit = blk; unit < NB * 12 * 4 * 9; unit += nblk) {
        const int qc = unit % 9, vq = (unit / 9) & 3, vh = (unit / 36) % 12, b = unit / 432, h = vh >> 1;
        const int q = qc * 512 + tid; const int qq = q < L ? q : L - 1;
        float qf[64];
        { const bf16_t* qp = QA + (size_t)(b * LP + qq) * 768 + vh * 64;
#pragma unroll
            for (int i = 0; i < 8; ++i) { const u32x4 w = *(const u32x4*)(qp + 8 * i); qf[8 * i] = bflo(w.x); qf[8 * i + 1] = bfhi(w.x); qf[8 * i + 2] = bflo(w.y); qf[8 * i + 3] = bfhi(w.y); qf[8 * i + 4] = bflo(w.z); qf[8 * i + 5] = bfhi(w.z); qf[8 * i + 6] = bflo(w.w); qf[8 * i + 7] = bfhi(w.w); } }
        int kmax = qc * 512 + wid * 64 + 63; if (kmax > L - 1) kmax = L - 1;
        kmax = __builtin_amdgcn_readfirstlane(kmax);
        float mx = -INFINITY, lsum = 0.f, o[32];
#pragma unroll
        for (int i = 0; i < 32; ++i) o[i] = 0.f;
        for (int key = 0; key <= kmax; ++key) {
            const bf16_t* kp = KA + (size_t)(b * LP + key) * 768 + vh * 64;
            float s = 0.f;
#pragma unroll
            for (int i = 0; i < 8; ++i) { const u32x4 w = *(const u32x4*)(kp + 8 * i);
                s += qf[8 * i] * bflo(w.x) + qf[8 * i + 1] * bfhi(w.x) + qf[8 * i + 2] * bflo(w.y) + qf[8 * i + 3] * bfhi(w.y) + qf[8 * i + 4] * bflo(w.z) + qf[8 * i + 5] * bfhi(w.z) + qf[8 * i + 6] * bflo(w.w) + qf[8 * i + 7] * bfhi(w.w); }
            if (key <= qq) {
                const float mn = fmaxf(mx, s), al_ = __builtin_amdgcn_exp2f(mx - mn), p = __builtin_amdgcn_exp2f(s - mn);
                lsum = lsum * al_ + p; mx = mn;
                const bf16_t* vp = VA + (size_t)(b * LP + key) * 768 + h * 128 + vq * 32;
#pragma unroll
                for (int i = 0; i < 4; ++i) { const u32x4 w = *(const u32x4*)(vp + 8 * i);
                    o[8 * i] = o[8 * i] * al_ + p * bflo(w.x); o[8 * i + 1] = o[8 * i + 1] * al_ + p * bfhi(w.x); o[8 * i + 2] = o[8 * i + 2] * al_ + p * bflo(w.y); o[8 * i + 3] = o[8 * i + 3] * al_ + p * bfhi(w.y);
                    o[8 * i + 4] = o[8 * i + 4] * al_ + p * bflo(w.z); o[8 * i + 5] = o[8 * i + 5] * al_ + p * bfhi(w.z); o[8 * i + 6] = o[8 * i + 6] * al_ + p * bflo(w.w); o[8 * i + 7] = o[8 * i + 7] * al_ + p * bfhi(w.w); }
            }
        }
        if (q < L) { const float rl = 1.f / lsum; float* op = OD + ((size_t)(b * LP + q) * 12 + vh) * 128 + vq * 32;
#pragma unroll
            for (int i = 0; i < 8; ++i) *(f32x4*)(op + 4 * i) = (f32x4){o[4 * i] * rl, o[4 * i + 1] * rl, o[4 * i + 2] * rl, o[4 * i + 3] * rl}; }
    }
}


constexpr int HC = 32, HNC = (L + HC - 1) / HC;
constexpr int HR_QP = 136  , HR_Q = 0, HR_K = HC * HR_QP * 2  , HR_A = HR_K + 128 * HC * 2  , HR_D = HR_A + HC * HC * 2  , HR_SH = HR_D + 512  ;
constexpr int HR_V = HR_SH, HR_VH = 64 * HC * 2  , HR_BYTES = HR_SH + 2 * HR_VH  , HS_BYTES = HR_SH + HR_VH  ;
constexpr int HG_NS = 4;
constexpr size_t WS_REC = WS_END_HG;
constexpr size_t WS_END2 = WS_REC + (size_t)12 * 257 * 14336;
constexpr size_t WS_XB = WS_END2, WS_END3 = WS_XB + (size_t)8192 * 8 * 8;
static_assert(12 * HNC * HR_BYTES <= 12 * 257 * 14336 && HG_NS * HS_BYTES + 16384 <= 131072 && HR_SH % 1024 == 0, "hgrn record / ring / output staging");

__device__ __forceinline__ void hgrn_pre(int l, unsigned char* lds_g, int blk, int nblk) {
    const Args a = *argp();
    const float* ZH = (const float*)(a.ws + WS_ZH); unsigned char* REC = a.ws + WS_REC;
    const int tid = opq_v((int)threadIdx.x);
    constexpr int HP = 132;
    float* lf = (float*)lds_g; float* kk = lf + HC * HP; float* qs = kk + HC * HP; float* bc = qs + HC * HP; float* vv = bc + HC * HP;
    for (int rec = blk; rec < 12 * HNC; rec += nblk) {
        const int bh = rec / HNC, c = rec % HNC, b = bh / 6, h = bh % 6;
        const size_t r0 = (size_t)b * L + HC * c;
        float lb = 0.f;
        if (l == 1) { const int k = tid & 127; const float x0 = a.hgrn_lb[h * 128 + k], x1 = a.hgrn_lb[HW + h * 128 + k]; const float e0 = __expf(x0), e1 = __expf(x1); lb = e1 / (e0 + e1); }
        for (int idx = tid; idx < HC * 128; idx += 512) {
            const int t = idx >> 7, k = idx & 127;
            float lfv = 0.f, kv = 0.f, qv = 0.f, vvv = 0.f;
            if (HC * c + t < L) {
                const float* z = ZH + (r0 + t) * 3072 + h * 128 + k;
                const float f = lb + (1.f - lb) * (1.f / (1.f + __expf(-z[768])));
                lfv = __logf(f); kv = 1.f - f; qv = z[0] * 0.08838834764831845f; vvv = z[1536];
            }
            lf[t * HP + k] = lfv; kk[t * HP + k] = kv; qs[t * HP + k] = qv; vv[t * HP + k] = vvv;
        }
        __syncthreads();
        if (tid < 128) { float cv[HC];
#pragma unroll
            for (int t = 0; t < HC; ++t) cv[t] = lf[t * HP + tid];
            float run = 0.f;
#pragma unroll
            for (int t = 0; t < HC; ++t) { run += cv[t]; bc[t * HP + tid] = run; } }
        __syncthreads();
        unsigned char* R = REC + (size_t)rec * HR_BYTES;
        for (int idx = tid; idx < HC * 128; idx += 512) {
            { const int t = idx >> 7, k = idx & 127; ((bf16_t*)(R + HR_Q))[t * HR_QP + k] = (bf16_t)f2bf(qs[t * HP + k] * __expf(bc[t * HP + k])); }
            { const int k = idx >> 5, s_ = idx & 31; ((bf16_t*)(R + HR_K))[idx] = (bf16_t)f2bf(kk[s_ * HP + k] * __expf(bc[(HC - 1) * HP + k] - bc[s_ * HP + k]));
              ((bf16_t*)(R + HR_V))[idx] = (bf16_t)f2bf(vv[s_ * HP + k]); }
        }
        if (tid < 128) ((float*)(R + HR_D))[tid] = __expf(bc[(HC - 1) * HP + tid]);
#pragma unroll
        for (int e = 0; e < 2; ++e) { const int p = tid + 512 * e, t = p >> 5, s_ = p & 31; float acc = 0.f;
            if (s_ <= t) {
#pragma unroll 2
                for (int k = 0; k < 128; k += 4) { const f32x4 q4 = *(const f32x4*)(qs + t * HP + k), k4 = *(const f32x4*)(kk + s_ * HP + k), bt = *(const f32x4*)(bc + t * HP + k), bs = *(const f32x4*)(bc + s_ * HP + k);
                    acc += q4[0] * k4[0] * __expf(bt[0] - bs[0]) + q4[1] * k4[1] * __expf(bt[1] - bs[1]) + q4[2] * k4[2] * __expf(bt[2] - bs[2]) + q4[3] * k4[3] * __expf(bt[3] - bs[3]); } }
            ((bf16_t*)(R + HR_A))[p] = (bf16_t)f2bf(acc); }
        __syncthreads();
    }
}

__device__ __forceinline__ void hgrn_scan(int bh, int vhalf, LAS unsigned char* ldsl) {
    const Args a = *argp();
    const unsigned char* REC = a.ws + WS_REC + (size_t)bh * HNC * HR_BYTES; float* OH = (float*)(a.ws + WS_OH);
    const int tid = opq_v((int)threadIdx.x), lane = tid & 63, wid = __builtin_amdgcn_readfirstlane(tid >> 6), n = lane & 15, g = lane >> 4;
    const int b = bh / 6, h = bh % 6;
    const bool loader = wid < 4 || wid >= 6; const int li = wid < 4 ? wid : wid - 2; const bool four = loader && li < 5;
    LAS unsigned char* OST = ldsl + HG_NS * HS_BYTES;
#define HG_PIECE(q_) do { const int pb_ = 384 * (q_) + 64 * li;   \
        const unsigned char* s_ = (pb_ < 1216 ? rsrc_ + (size_t)pb_ * 16 : rsrc_ + HR_SH + HR_VH * vhalf + (size_t)(pb_ - 1216) * 16) + lane * 16; \
        __builtin_amdgcn_global_load_lds((const unsigned*)s_, (LAS unsigned*)(rdst_ + pb_ * 16), 16, 0, 0); } while (0)
#define HG_DMA(cc) do { if (loader) { const int c_ = (cc) < HNC ? (cc) : HNC - 1; const unsigned char* rsrc_ = REC + (size_t)c_ * HR_BYTES; LAS unsigned char* rdst_ = ldsl + ((cc) % HG_NS) * HS_BYTES; \
        HG_PIECE(0); HG_PIECE(1); HG_PIECE(2); if (four) HG_PIECE(3); } } while (0)
#define HG_OUT(ss) do { const LAS float* src_ = (const LAS float*)(OST + ((ss) & 1) * 8192); const int e_ = (wid - 4) * 64 + lane; \
        _Pragma("unroll") for (int q_ = 0; q_ < 4; ++q_) { const int idx_ = e_ + 128 * q_, t_ = idx_ >> 4, c4_ = idx_ & 15;    \
            if (HC * (ss) + t_ < L) { const f32x4 v_ = *(const LAS f32x4*)(src_ + (c4_ >> 2) * 512 + t_ * 16 + (c4_ & 3) * 4); \
                u32x2 w_; w_.x = pg8::cvt_pk_bf16(v_[0], v_[1]); w_.y = pg8::cvt_pk_bf16(v_[2], v_[3]);                    \
                *(u32x2*)((bf16_t*)OH + ((size_t)b * L + HC * (ss) + t_) * HW + h * 128 + 64 * vhalf + 4 * c4_) = w_; } } } while (0)
    f32x4 S[8];
#pragma unroll
    for (int i = 0; i < 8; ++i) S[i] = (f32x4){0.f, 0.f, 0.f, 0.f};
    for (int c = 0; c < HG_NS - 1; ++c) HG_DMA(c);
    for (int s_ = 0; s_ < HNC; ++s_) {
        if (four) asm volatile("s_waitcnt vmcnt(8)" ::: "memory"); else if (loader) asm volatile("s_waitcnt vmcnt(6)" ::: "memory");
        asm volatile("s_waitcnt lgkmcnt(0)" ::: "memory");
        __builtin_amdgcn_s_barrier();
        asm volatile("" ::: "memory");
        const LAS unsigned char* R = ldsl + (s_ % HG_NS) * HS_BYTES;
        if ((wid == 4 || wid == 5) && s_ > 0) HG_OUT(s_ - 1);
        if (wid < 4) {
            s16x4 qa0[2][4], qa1[2][4]; bf16x8 at[2], ka[8], vb; f32x4 dv[8];
#pragma unroll
            for (int mt = 0; mt < 2; ++mt)
#pragma unroll
                for (int kb = 0; kb < 4; ++kb) { qa0[mt][kb] = *(const LAS s16x4*)(R + HR_Q + ((16 * mt + n) * HR_QP + 32 * kb + 4 * g) * 2); qa1[mt][kb] = *(const LAS s16x4*)(R + HR_Q + ((16 * mt + n) * HR_QP + 32 * kb + 16 + 4 * g) * 2); }
            vb = *(const LAS bf16x8*)(R + HR_SH + ((16 * wid + n) * HC + 8 * g) * 2);
#pragma unroll
            for (int mt = 0; mt < 2; ++mt) at[mt] = *(const LAS bf16x8*)(R + HR_A + ((16 * mt + n) * HC + 8 * g) * 2);
#pragma unroll
            for (int kt = 0; kt < 8; ++kt) { ka[kt] = *(const LAS bf16x8*)(R + HR_K + ((16 * kt + n) * HC + 8 * g) * 2); dv[kt] = *(const LAS f32x4*)(R + HR_D + (16 * kt + 4 * g) * 4); }
            asm volatile("s_waitcnt lgkmcnt(0)" ::: "memory");
            __builtin_amdgcn_sched_barrier(0);
            f32x4 o0 = (f32x4){0.f, 0.f, 0.f, 0.f}, o1 = o0;
            o0 = __builtin_amdgcn_mfma_f32_16x16x32_bf16(at[0], vb, o0, 0, 0, 0);
            o1 = __builtin_amdgcn_mfma_f32_16x16x32_bf16(at[1], vb, o1, 0, 0, 0);
#pragma unroll
            for (int kb = 0; kb < 4; ++kb) {
                u32x4 w; w.x = pg8::cvt_pk_bf16(S[2 * kb][0], S[2 * kb][1]); w.y = pg8::cvt_pk_bf16(S[2 * kb][2], S[2 * kb][3]); w.z = pg8::cvt_pk_bf16(S[2 * kb + 1][0], S[2 * kb + 1][1]); w.w = pg8::cvt_pk_bf16(S[2 * kb + 1][2], S[2 * kb + 1][3]);
                const bf16x8 sb = __builtin_bit_cast(bf16x8, w);
                const bf16x8 q0 = (bf16x8){qa0[0][kb][0], qa0[0][kb][1], qa0[0][kb][2], qa0[0][kb][3], qa1[0][kb][0], qa1[0][kb][1], qa1[0][kb][2], qa1[0][kb][3]};
                const bf16x8 q1 = (bf16x8){qa0[1][kb][0], qa0[1][kb][1], qa0[1][kb][2], qa0[1][kb][3], qa1[1][kb][0], qa1[1][kb][1], qa1[1][kb][2], qa1[1][kb][3]};
                o0 = __builtin_amdgcn_mfma_f32_16x16x32_bf16(q0, sb, o0, 0, 0, 0);
                o1 = __builtin_amdgcn_mfma_f32_16x16x32_bf16(q1, sb, o1, 0, 0, 0);
            }
#pragma unroll
            for (int kt = 0; kt < 8; ++kt) S[kt] = __builtin_amdgcn_mfma_f32_16x16x32_bf16(ka[kt], vb, S[kt] * dv[kt], 0, 0, 0);
            { LAS float* st = (LAS float*)(OST + (s_ & 1) * 8192) + wid * 512 + (4 * g) * 16 + n;
#pragma unroll
                for (int jj = 0; jj < 4; ++jj) { st[jj * 16] = o0[jj]; st[256 + jj * 16] = o1[jj]; } }
        }
        HG_DMA(s_ + HG_NS - 1);
    }
    asm volatile("s_waitcnt vmcnt(0) lgkmcnt(0)" ::: "memory");
    __builtin_amdgcn_s_barrier();
    asm volatile("" ::: "memory");
    if (wid == 4 || wid == 5) HG_OUT(HNC - 1);
    asm volatile("s_waitcnt vmcnt(0) lgkmcnt(0)" ::: "memory");
    __builtin_amdgcn_s_barrier();
#undef HG_PIECE
#undef HG_DMA
#undef HG_OUT
}

typedef float f32x16 __attribute__((ext_vector_type(16)));
constexpr int AT_KP = 72, AT_VP = 68;
constexpr int AT_KB = 64 * AT_KP * 2, AT_VB = 128 * AT_VP * 2, AT_BUF = AT_KB + AT_VB;
__device__ __forceinline__ int crow(int r, int hi) { return (r & 3) + 8 * (r >> 2) + 4 * hi; }
__device__ __forceinline__ void attn_phase(int l, unsigned char* lds_g, LAS unsigned char* ldsl, unsigned* qctr, int nunits_hg) {
    const Args a = *argp();
    const bf16_t* QA = (const bf16_t*)(a.ws + WS_QA); const bf16_t* KA = (const bf16_t*)(a.ws + WS_KA); const bf16_t* VA = (const bf16_t*)(a.ws + WS_VA);
    float* OD = (float*)(a.ws + WS_OD);
    const int tid = opq_v((int)threadIdx.x), lane = tid & 63, wid = __builtin_amdgcn_readfirstlane(tid >> 6), r32 = lane & 31, hi = lane >> 5;
    int* sh_u = (int*)(lds_g + 131072 + 64);
    unsigned* xq = qctr + 4096 + 256 * l;
    const int myx = (int)(xb_xcc_id() & 7u);
    bool scans_left = true;
    for (;;) {
        __syncthreads();
        if (tid == 0) {
            int uu = -1000;
            if (scans_left) { const int s0 = (int)atomicAdd(qctr, 1u); if (s0 < nunits_hg) uu = s0 - nunits_hg; }
            if (uu == -1000) { uu = NB * 12 * 17;
                for (int k = 0; k < 8; ++k) { const int x = (myx + k) & 7; const int i = (int)atomicAdd(xq + 16 * x, 1u);
                    if (i < 51) { uu = (i / 3) * 24 + 3 * x + i % 3; break; } } }
            *sh_u = uu + nunits_hg;
        }
        __syncthreads();
        const int u = *sh_u - nunits_hg;
        if (u >= 0) scans_left = false;
        if (u >= NB * 12 * 17) break;
        if (u < 0) { const int hu = u + nunits_hg; hgrn_scan(hu >> 1, hu & 1, ldsl); continue; }
        const int qb = 16 - u / 24, bv = u % 24, b = bv / 12, vh = bv % 12, h = vh >> 1;
        const int q0 = qb * 256, NT = (q0 + 256) / 64;
        const int qw = q0 + wid * 32;
        const bf16_t* Kb = KA + (size_t)b * LP * 768 + vh * 64; const bf16_t* Vb = VA + ((size_t)b * 768 + h * 128) * LP;
        bf16x8 qr[4];
#pragma unroll
        for (int i = 0; i < 4; ++i) qr[i] = *(const bf16x8*)(QA + (size_t)(b * LP + qw + r32) * 768 + vh * 64 + 16 * i + 8 * hi);
        f32x16 o[4];
#pragma unroll
        for (int d = 0; d < 4; ++d) o[d] = (f32x16){0.f, 0.f, 0.f, 0.f, 0.f, 0.f, 0.f, 0.f, 0.f, 0.f, 0.f, 0.f, 0.f, 0.f, 0.f, 0.f};
        float mrun = -INFINITY, lrun = 0.f;
        const int kr = tid >> 3, kc = tid & 7;
        u32x4 kreg0, vreg00, vreg01, kreg1, vreg10, vreg11, kreg2, vreg20, vreg21, kreg3, vreg30, vreg31;
#define AT_LOAD(t, KR, V0, V1) do { KR = *(const u32x4*)(Kb + (size_t)((t) * 64 + kr) * 768 + kc * 8); \
            V0 = *(const u32x4*)(Vb + (size_t)kr * LP + (t) * 64 + kc * 8); V1 = *(const u32x4*)(Vb + (size_t)(64 + kr) * LP + (t) * 64 + kc * 8); } while (0)
#define AT_STORE(buf, KR, V0, V1) do { unsigned char* B_ = lds_g + (buf) * AT_BUF; *(u32x4*)(B_ + (kr * AT_KP + kc * 8) * 2) = KR; \
            *(u32x2*)(B_ + AT_KB + (kr * AT_VP + kc * 8) * 2) = (u32x2){V0.x, V0.y}; *(u32x2*)(B_ + AT_KB + (kr * AT_VP + kc * 8 + 4) * 2) = (u32x2){V0.z, V0.w}; \
            *(u32x2*)(B_ + AT_KB + ((64 + kr) * AT_VP + kc * 8) * 2) = (u32x2){V1.x, V1.y}; *(u32x2*)(B_ + AT_KB + ((64 + kr) * AT_VP + kc * 8 + 4) * 2) = (u32x2){V1.z, V1.w}; } while (0)
#define AT_TILE(t) do { \
            if ((t) * 64 <= qw + 31 && qw < L) {                 \
                const unsigned char* Bc = lds_g + ((t) & 1) * AT_BUF; \
                const float nm_ = mrun == -INFINITY ? 0.f : -mrun;     \
                f32x16 p0 = (f32x16){nm_, nm_, nm_, nm_, nm_, nm_, nm_, nm_, nm_, nm_, nm_, nm_, nm_, nm_, nm_, nm_}, p1 = p0; \
                _Pragma("unroll") for (int i2 = 0; i2 < 2; ++i2) { bf16x8 kf0[2], kf1[2];     \
                  _Pragma("unroll") for (int i = 0; i < 2; ++i) { kf0[i] = *(const bf16x8*)(Bc + (r32 * AT_KP + 16 * (2 * i2 + i) + 8 * hi) * 2); kf1[i] = *(const bf16x8*)(Bc + ((32 + r32) * AT_KP + 16 * (2 * i2 + i) + 8 * hi) * 2); } \
                  asm volatile("s_waitcnt lgkmcnt(0)" ::: "memory"); __builtin_amdgcn_sched_barrier(0); \
                  _Pragma("unroll") for (int i = 0; i < 2; ++i) { p0 = __builtin_amdgcn_mfma_f32_32x32x16_bf16(kf0[i], qr[2 * i2 + i], p0, 0, 0, 0); p1 = __builtin_amdgcn_mfma_f32_32x32x16_bf16(kf1[i], qr[2 * i2 + i], p1, 0, 0, 0); } } \
                if ((t) * 64 + 63 > qw) {                        \
                    const int qa = qw + r32, kb0 = (t) * 64 + 4 * hi; \
                    _Pragma("unroll") for (int r = 0; r < 16; ++r) { const int kv = kb0 + (r & 3) + 8 * (r >> 2); if (kv > qa) p0[r] = -INFINITY; if (kv + 32 > qa) p1[r] = -INFINITY; } } \
                float rm = fmaxf(p0[0], p1[0]); \
                _Pragma("unroll") for (int r = 1; r < 16; ++r) rm = fmaxf(rm, fmaxf(p0[r], p1[r])); \
                rm = fmaxf(rm, __shfl_xor(rm, 32)); \
                if (__any(rm > 8.0f || mrun == -INFINITY)) {   \
                    const float dl_ = mrun == -INFINITY ? rm : fmaxf(rm, 0.f), al_ = mrun == -INFINITY ? 0.f : __builtin_amdgcn_exp2f(-dl_); \
                    mrun = (mrun == -INFINITY ? 0.f : mrun) + dl_; lrun *= al_; \
                    _Pragma("unroll") for (int r = 0; r < 16; ++r) { p0[r] -= dl_; p1[r] -= dl_; } \
                    _Pragma("unroll") for (int d = 0; d < 4; ++d) _Pragma("unroll") for (int r = 0; r < 16; ++r) o[d][r] *= al_; } \
                _Pragma("unroll") for (int r = 0; r < 16; ++r) { p0[r] = __builtin_amdgcn_exp2f(p0[r]); p1[r] = __builtin_amdgcn_exp2f(p1[r]); } \
                { const f32x16 sm_ = p0 + p1; const f32x4 s4_ = (f32x4){sm_[0], sm_[1], sm_[2], sm_[3]} + (f32x4){sm_[4], sm_[5], sm_[6], sm_[7]} + (f32x4){sm_[8], sm_[9], sm_[10], sm_[11]} + (f32x4){sm_[12], sm_[13], sm_[14], sm_[15]}; \
                  lrun += (s4_[0] + s4_[1]) + (s4_[2] + s4_[3]); } \
                bf16x8 pb[4]; \
                _Pragma("unroll") for (int jj = 0; jj < 4; ++jj) { u32x4 w; \
                    if (jj < 2) { w.x = pg8::cvt_pk_bf16(p0[8 * jj], p0[8 * jj + 1]); w.y = pg8::cvt_pk_bf16(p0[8 * jj + 2], p0[8 * jj + 3]); w.z = pg8::cvt_pk_bf16(p0[8 * jj + 4], p0[8 * jj + 5]); w.w = pg8::cvt_pk_bf16(p0[8 * jj + 6], p0[8 * jj + 7]); } \
                    else { const int j2 = jj - 2; w.x = pg8::cvt_pk_bf16(p1[8 * j2], p1[8 * j2 + 1]); w.y = pg8::cvt_pk_bf16(p1[8 * j2 + 2], p1[8 * j2 + 3]); w.z = pg8::cvt_pk_bf16(p1[8 * j2 + 4], p1[8 * j2 + 5]); w.w = pg8::cvt_pk_bf16(p1[8 * j2 + 6], p1[8 * j2 + 7]); } \
                    pb[jj] = __builtin_bit_cast(bf16x8, w); } \
                const unsigned char* Vc = Bc + AT_KB; \
                _Pragma("unroll") for (int d = 0; d < 4; ++d) { s16x4 vl[4], vh[4];     \
                      _Pragma("unroll") for (int jj = 0; jj < 4; ++jj) { vl[jj] = *(const s16x4*)(Vc + ((d * 32 + r32) * AT_VP + 16 * jj + 4 * hi) * 2); vh[jj] = *(const s16x4*)(Vc + ((d * 32 + r32) * AT_VP + 16 * jj + 8 + 4 * hi) * 2); } \
                      asm volatile("s_waitcnt lgkmcnt(0)" ::: "memory"); __builtin_amdgcn_sched_barrier(0); \
                      _Pragma("unroll") for (int jj = 0; jj < 4; ++jj) { const bf16x8 va = (bf16x8){vl[jj][0], vl[jj][1], vl[jj][2], vl[jj][3], vh[jj][0], vh[jj][1], vh[jj][2], vh[jj][3]}; \
                          o[d] = __builtin_amdgcn_mfma_f32_32x32x16_bf16(va, pb[jj], o[d], 0, 0, 0); } } \
            } } while (0)
        AT_LOAD(0, kreg0, vreg00, vreg01); AT_STORE(0, kreg0, vreg00, vreg01);
        AT_LOAD(1, kreg1, vreg10, vreg11); AT_LOAD(2, kreg2, vreg20, vreg21); AT_LOAD(3, kreg3, vreg30, vreg31);
        __syncthreads();
        for (int t = 0; t < NT; t += 4) {
            if (t + 4 < NT) AT_LOAD(t + 4, kreg0, vreg00, vreg01);
            AT_TILE(t);
            AT_STORE(1, kreg1, vreg10, vreg11);
            __syncthreads();
            if (t + 5 < NT) AT_LOAD(t + 5, kreg1, vreg10, vreg11);
            AT_TILE(t + 1);
            AT_STORE(0, kreg2, vreg20, vreg21);
            __syncthreads();
            if (t + 6 < NT) AT_LOAD(t + 6, kreg2, vreg20, vreg21);
            AT_TILE(t + 2);
            AT_STORE(1, kreg3, vreg30, vreg31);
            __syncthreads();
            if (t + 7 < NT) AT_LOAD(t + 7, kreg3, vreg30, vreg31);
            AT_TILE(t + 3);
            if (t + 4 < NT) AT_STORE(0, kreg0, vreg00, vreg01);
            __syncthreads();
        }
#undef AT_TILE
#undef AT_LOAD
#undef AT_STORE
        const float lt = lrun + __shfl_xor(lrun, 32), rl = 1.0f / lt;
        const int qa = qw + r32;
        if (qa < L) {
            bf16_t* op = (bf16_t*)OD + ((size_t)(b * LP + qa) * 12 + vh) * 128;
#pragma unroll
            for (int d = 0; d < 4; ++d)
#pragma unroll
                for (int g = 0; g < 4; ++g) { u32x2 w; w.x = pg8::cvt_pk_bf16(o[d][4 * g] * rl, o[d][4 * g + 1] * rl); w.y = pg8::cvt_pk_bf16(o[d][4 * g + 2] * rl, o[d][4 * g + 3] * rl); *(u32x2*)(op + 32 * d + 8 * g + 4 * hi) = w; }
        }
    }
}

__device__ __forceinline__ float red16(float v) {
    v += __builtin_bit_cast(float, __builtin_amdgcn_mov_dpp(__builtin_bit_cast(int, v), 0xB1, 0xF, 0xF, true));
    v += __builtin_bit_cast(float, __builtin_amdgcn_mov_dpp(__builtin_bit_cast(int, v), 0x4E, 0xF, 0xF, true));
    v += __builtin_bit_cast(float, __builtin_amdgcn_mov_dpp(__builtin_bit_cast(int, v), 0x141, 0xF, 0xF, true));
    v += __builtin_bit_cast(float, __builtin_amdgcn_mov_dpp(__builtin_bit_cast(int, v), 0x140, 0xF, 0xF, true));
    return v;
}
__device__ __forceinline__ void finalize_phase(int l_in, int gw_in, int NGW, int lane_in) {
    const int l = opq_s(l_in), gw = opq_v(gw_in), lane = opq_v(lane_in);
    const Args a = *argp();
    const float* OD = (const float*)(a.ws + WS_OD); const float* OH = (const float*)(a.ws + WS_OH); const float* ZH = (const float*)(a.ws + WS_ZH);
    bf16_t* YD = (bf16_t*)(a.ws + WS_YD); bf16_t* YH = (bf16_t*)(a.ws + WS_YH);
    const float* lp = a.diff_lambda + (size_t)l * 4 * 64;
    const float lam_init = l == 0 ? 0.2f : 0.8f - 0.6f * 0.7408182206817179f;
    const float lam = __expf(wave_sum(lp[lane] * lp[64 + lane])) - __expf(wave_sum(lp[128 + lane] * lp[192 + lane])) + lam_init;
    const int q = lane >> 4, li = lane & 15;
    f32x4 gD[2], gH[2];
#pragma unroll
    for (int e = 0; e < 2; ++e) { gD[e] = *(const f32x4*)(a.diff_ng + l * 128 + 8 * li + 4 * e) * (1.f - lam_init); gH[e] = *(const f32x4*)(a.hgrn_ng + l * 128 + 8 * li + 4 * e); }
    for (int r = gw; r < T; r += NGW) {
        const int b = r / L, t = r % L; const size_t ar = (size_t)(b * LP + t);
        f32x4 A_[3][2], B_[3][2];
#pragma unroll
        for (int p = 0; p < 3; ++p) { const int sg = p * 4 + q; const bool isd = sg < 6; const int h = isd ? sg : sg - 6;
            if (isd) { const bf16_t* pd = (const bf16_t*)OD + (ar * 12 + 2 * h) * 128 + 8 * li; const u32x4 wa = *(const u32x4*)pd, wb = *(const u32x4*)(pd + 128);
                A_[p][0] = (f32x4){bflo(wa.x), bfhi(wa.x), bflo(wa.y), bfhi(wa.y)}; A_[p][1] = (f32x4){bflo(wa.z), bfhi(wa.z), bflo(wa.w), bfhi(wa.w)};
                B_[p][0] = (f32x4){bflo(wb.x), bfhi(wb.x), bflo(wb.y), bfhi(wb.y)}; B_[p][1] = (f32x4){bflo(wb.z), bfhi(wb.z), bflo(wb.w), bfhi(wb.w)}; }
            else { const u32x4 wa = *(const u32x4*)((const bf16_t*)OH + (size_t)r * HW + h * 128 + 8 * li); const u32x4 wb = *(const u32x4*)((const bf16_t*)(a.ws + WS_HG) + (size_t)r * HW + h * 128 + 8 * li);
                A_[p][0] = (f32x4){bflo(wa.x), bfhi(wa.x), bflo(wa.y), bfhi(wa.y)}; A_[p][1] = (f32x4){bflo(wa.z), bfhi(wa.z), bflo(wa.w), bfhi(wa.w)};
                B_[p][0] = (f32x4){bflo(wb.x), bfhi(wb.x), bflo(wb.y), bfhi(wb.y)}; B_[p][1] = (f32x4){bflo(wb.z), bfhi(wb.z), bflo(wb.w), bfhi(wb.w)}; } }
#pragma unroll
        for (int p = 0; p < 3; ++p) { const int sg = p * 4 + q; const bool isd = sg < 6; const int h = isd ? sg : sg - 6;
            const float ls = isd ? lam : 0.f;
            f32x4 d0 = A_[p][0] - B_[p][0] * ls, d1 = A_[p][1] - B_[p][1] * ls;
            const f32x4 sq = d0 * d0 + d1 * d1;
            const float ms = red16((sq[0] + sq[1]) + (sq[2] + sq[3])) * (1.f / 128.f); const float rs = 1.f / sqrtf(ms + RMS_EPS);
            f32x4 w0, w1;
            if (isd) { w0 = gD[0]; w1 = gD[1]; }
            else { const f32x4 g0 = B_[p][0], g1 = B_[p][1];
                w0 = gH[0] * (f32x4){g0[0] * sigmoidf_(g0[0]), g0[1] * sigmoidf_(g0[1]), g0[2] * sigmoidf_(g0[2]), g0[3] * sigmoidf_(g0[3])};
                w1 = gH[1] * (f32x4){g1[0] * sigmoidf_(g1[0]), g1[1] * sigmoidf_(g1[1]), g1[2] * sigmoidf_(g1[2]), g1[3] * sigmoidf_(g1[3])}; }
            d0 = d0 * rs * w0; d1 = d1 * rs * w1;
            u32x4 o; o.x = pk2(d0[0], d0[1]); o.y = pk2(d0[2], d0[3]); o.z = pk2(d1[0], d1[1]); o.w = pk2(d1[2], d1[3]);
            bf16_t* po = (isd ? YD + (size_t)r * DW : YH + (size_t)r * HW) + h * 128 + 8 * li;
            *(u32x4*)po = o; }
    }
}


#ifndef DBG_STAGE
#define DBG_STAGE 0
#endif
template <int stage> __device__ __forceinline__ void dbg_out(int gw, int NGW, int lane) {
    const Args a = *argp(); unsigned char* ws = a.ws;
    const float* ZP = (const float*)(ws + WS_ZP); const float* ZH = (const float*)(ws + WS_ZH); const bf16_t* G = (const bf16_t*)(ws + WS_G);
    const bf16_t* QA = (const bf16_t*)(ws + WS_QA); const bf16_t* YP = (const bf16_t*)(ws + WS_YP); const bf16_t* YH = (const bf16_t*)(ws + WS_YH); const bf16_t* YD = (const bf16_t*)(ws + WS_YD);
    const bf16_t* MB = (const bf16_t*)(ws + WS_MB);
    for (int r = gw; r < T; r += NGW) {
        const int b = r / L, t = r % L; if (t < NMETA) continue;
        const size_t ar = (size_t)(b * LP + t);
        float* o = a.out + ((size_t)b * SEQ + (t - NMETA)) * D;
        for (int c = lane; c < D; c += 64) {
            float v = 0.f;
            if (stage == 1) v = ZH[(size_t)r * 3072 + c] + ZH[(size_t)r * 3072 + 1024 + c] + ZP[(size_t)r * PW + (c & 511)] + bf2f(G[(size_t)r * 6144 + c]) + bf2f(G[(size_t)r * 6144 + 2048 + c]) + bf2f(G[(size_t)r * 6144 + 4096 + c])
                              + bf2f(QA[ar * 768 + (c % 768)]) + bf2f(QA[(WS_KA - WS_QA) / 2 + ar * 768 + (c % 768)]) + bf2f(QA[(WS_KA - WS_QA) + ar * 768 + (c % 768)]);
            else if (stage == 2) v = bf2f(YP[(size_t)r * PW + (c & 511)]) + 2.f * bf2f(YH[(size_t)r * HW + (c % 768)]) + 3.f * bf2f(YD[(size_t)r * DW + ((c + 100) % 768)]);
            else if (stage == 3) v = bf2f(MB[(size_t)r * D + c]);
            o[c] = v;
        }
    }
}

__device__ __forceinline__ void tail_ln(int lnidx, bool final_, unsigned* cntp, unsigned char* lds_g, int rb) {
    if (rb >= 64) return;
    const int tid = opq_v((int)threadIdx.x);
    int* sh = (int*)(lds_g + 131072 + 128);
    asm volatile("s_waitcnt vmcnt(0)" ::: "memory");
    __syncthreads();
    if (tid == 0) { __builtin_amdgcn_fence(__ATOMIC_RELEASE, "agent"); asm volatile("s_waitcnt vmcnt(0)" ::: "memory");
        *sh = (int)__hip_atomic_fetch_add(cntp, 1u, __ATOMIC_RELAXED, __HIP_MEMORY_SCOPE_AGENT); }
    __syncthreads();
    if (*sh == 63) {
        if (tid == 0) { __builtin_amdgcn_fence(__ATOMIC_ACQUIRE, "agent"); asm volatile("s_waitcnt vmcnt(0)" ::: "memory"); }
        __syncthreads();
        ln_rows(lnidx, final_, MT, T, tid >> 6, 8, tid & 63);
    }
}
#ifndef STOP_L
#define STOP_L 1
#endif
#ifndef STOP_J
#define STOP_J 1
#endif
#ifndef STOP_MIX
#define STOP_MIX 0
#endif
__global__ void __launch_bounds__(512, 2) fwd_kernel(Args a_unused) {
    extern __shared__ __attribute__((aligned(16))) unsigned char lds[];
    cg::grid_group grid = cg::this_grid();
    LAS unsigned char* ldsl = (LAS unsigned char*)lds;
    volatile LAS unsigned* MISC = (volatile LAS unsigned*)(ldsl + 147456 - 512);
    if (threadIdx.x < 64) MISC[threadIdx.x] = 0u;
    __syncthreads();
    (void)xcd_barrier_post((unsigned*)(argp()->ws + WS_CTL), MISC);
#define SYNC() xcd_barrier((unsigned*)(argp()->ws + WS_CTL), (volatile LAS unsigned*)(ldsl + 147456 - 512))
#define TIDV opq_v((int)threadIdx.x)
#define BLK opq_s((int)blockIdx.x)
#define GRD opq_s((int)gridDim.x)
#define WSP (argp()->ws)
#define GEMM(EPI, Aptr, Bptr, Mv, Nv, Kv, Eobj) do { pg8::Gemm g_{Aptr, Bptr, MT, Nv, Kv}; pg8::StaticOrder S_; S_.init(MT, Nv, GRD, BLK); pg8::gemm_phase<EPI, pg8::StaticOrder, true, true>(ldsl, g_, S_, Eobj); \
        {   \
          const int rb_ = GRD - 1 - BLK, nt_ = __is_same(EPI, pg8::EpiSwiglu) ? 128 : GRD; \
          tail_gemm<EPI, __is_same(EPI, pg8::EpiSwiglu)>(Aptr, Bptr, Kv, __is_same(EPI, pg8::EpiSwiglu) ? (Nv) / 2 : (Nv), Eobj, lds, rb_ < nt_ ? rb_ : (1 << 28), nt_); } } while (0)

#define GEMM_LN(Aoff, Boff, Kv, sval, lnidx_, final__) do { const Args a_ = *argp(); unsigned char* ws = a_.ws; const int li_ = (lnidx_); \
        pg8::PanelStats st_{(unsigned*)(ws + WS_XB), (unsigned*)(ws + WS_CTL + 65536 + (size_t)li_ * 8192), LN_EPS}; \
        pg8::EpiLn E_{(float*)(ws + WS_H), (bf16_t*)(ws + WS_HB), a_.ln_g + (size_t)li_ * D, a_.ln_b + (size_t)li_ * D, (sval), st_, (final__) ? a_.out : nullptr}; \
        pg8::Gemm g_{(const bf16_t*)(ws + (Aoff)), (const bf16_t*)(ws + (Boff)), MT, D, (Kv)}; pg8::StaticOrder S_; S_.init(MT, D, GRD, BLK); \
        pg8::gemm_phase<pg8::EpiLn, pg8::StaticOrder, false, true>(ldsl, g_, S_, E_); \
        pg8::EpiResid Et_{(const float*)(ws + WS_H), (float*)(ws + WS_PRE), (sval)}; const int rb_ = GRD - 1 - BLK; \
        tail_gemm<pg8::EpiResid, false>((const bf16_t*)(ws + (Aoff)), (const bf16_t*)(ws + (Boff)), (Kv), D, Et_, lds, rb_, GRD); \
        tail_ln(li_, (final__), (unsigned*)(ws + WS_CTL + 20480 + 256 * li_), lds, rb_); } while (0)

    { const int tid = TIDV; prologue(lds, BLK * 8 + (tid >> 6), GRD * 8, tid & 63); }
    asm volatile("s_waitcnt vmcnt(0)" ::: "memory");
    grid.sync();
    for (int l = 0; l < 2; ++l) {
        for (int j = 0; j < 2; ++j) {
            if (j == 1) {
                { unsigned char* ws = WSP; pg8::EpiInproj E{(float*)(ws + WS_ZP), (float*)(ws + WS_ZH), (bf16_t*)(ws + WS_QA), (bf16_t*)(ws + WS_KA), (bf16_t*)(ws + WS_VA), (bf16_t*)(ws + WS_G)};
                  GEMM(pg8::EpiInproj, (const bf16_t*)(ws + WS_HB), (const bf16_t*)(ws + WS_WIN + (size_t)l * SZ_WIN), MP, INCOLS, D, E); }
                SYNC();
                if constexpr (DBG_STAGE == 1) { const int tid = TIDV; dbg_out<1>(BLK * 8 + (tid >> 6), GRD * 8, tid & 63); return; }
                { const int blk = BLK, G = GRD; pool_phase(l, lds, blk, G); hgrn_pre(l, lds, blk, G); }
                SYNC();
                attn_phase(l, lds, ldsl, (unsigned*)(argp()->ws + WS_CTL + 16384 + 256 * l), 24);
                SYNC();
                { const int tid = TIDV; finalize_phase(l, BLK * 8 + (tid >> 6), GRD * 8, tid & 63); }
                SYNC();
                if constexpr (DBG_STAGE == 2) { const int tid = TIDV; dbg_out<2>(BLK * 8 + (tid >> 6), GRD * 8, tid & 63); return; }
                { unsigned char* ws = WSP;
                  pg8::EpiBranch E0{(const bf16_t*)(ws + WS_G), 0, (float*)(ws + WS_MF), (bf16_t*)(ws + WS_MB), 0};
                  GEMM(pg8::EpiBranch, (const bf16_t*)(ws + WS_YP), (const bf16_t*)(ws + WS_WBP + (size_t)l * D * PW * 2), MP, D, PW, E0); }
                { unsigned char* ws = WSP;
                  pg8::EpiBranch E1{(const bf16_t*)(ws + WS_G), 2048, (float*)(ws + WS_MF), (bf16_t*)(ws + WS_MB), 1};
                  GEMM(pg8::EpiBranch, (const bf16_t*)(ws + WS_YH), (const bf16_t*)(ws + WS_WBH + (size_t)l * D * HW * 2), MP, D, HW, E1); }
                { unsigned char* ws = WSP;
                  pg8::EpiBranch E2{(const bf16_t*)(ws + WS_G), 4096, (float*)(ws + WS_MF), (bf16_t*)(ws + WS_MB), 2};
                  GEMM(pg8::EpiBranch, (const bf16_t*)(ws + WS_YD), (const bf16_t*)(ws + WS_WBD + (size_t)l * D * DW * 2), MP, D, DW, E2); }
                SYNC();
                if constexpr (DBG_STAGE == 3) { const int tid = TIDV; dbg_out<3>(BLK * 8 + (tid >> 6), GRD * 8, tid & 63); return; }
                GEMM_LN(WS_MB, WS_WO + (size_t)l * D * D * 2, D, 1.0f, l * 3 + 1, false);
                SYNC();
            }
            { unsigned char* ws = WSP; pg8::EpiSwiglu E{(bf16_t*)(ws + WS_ACT)};
              GEMM(pg8::EpiSwiglu, (const bf16_t*)(ws + WS_HB), (const bf16_t*)(ws + WS_WUP + (size_t)(l * 2 + j) * SZ_WUP), MP, 2 * DFF, D, E); }
            SYNC();
            GEMM_LN(WS_ACT, WS_WDN + (size_t)(l * 2 + j) * SZ_WDN, DFF, 0.5f, l * 3 + 2 * j, (l == 1 && j == 1));
            if (l == 1 && j == 1) return;
            SYNC();
        }
    }
#undef GEMM
}

extern "C" void kernel_launch(void* const* d_in, const int* in_sizes, int n_in, void* d_out, int out_size, void* d_ws, size_t ws_size, hipStream_t stream) {
    static int grid = 0;
    if (grid == 0) {
        int dev = 0, cus = 0, per_cu = 0;
        (void)hipGetDevice(&dev);
        (void)hipDeviceGetAttribute(&cus, hipDeviceAttributeMultiprocessorCount, dev);
        (void)hipFuncSetAttribute((const void*)fwd_kernel, hipFuncAttributeMaxDynamicSharedMemorySize, LDS_BYTES);
        (void)hipOccupancyMaxActiveBlocksPerMultiprocessor(&per_cu, (const void*)fwd_kernel, 512, LDS_BYTES);
        if (per_cu < 1) per_cu = 1;
        grid = cus * per_cu;
        if (ws_size < WS_END3 || cus * per_cu != 256) { fprintf(stderr, "kernel_launch: workspace too small: %zu < %zu\n", ws_size, (size_t)WS_END); grid = -1; }
    }
    if (grid < 0) return;
    Args a{};
    a.x = (const float*)d_in[0]; a.meta = (const float*)d_in[1]; a.ln_g = (const float*)d_in[2]; a.ln_b = (const float*)d_in[3];
    a.ffn_w_in = (const float*)d_in[4]; a.ffn_w_out = (const float*)d_in[5]; a.w_in = (const float*)d_in[6]; a.pool_w = (const float*)d_in[7];
    a.pool_scale = (const float*)d_in[8]; a.hgrn_lb = (const float*)d_in[9]; a.hgrn_ng = (const float*)d_in[10]; a.diff_lambda = (const float*)d_in[11];
    a.diff_ng = (const float*)d_in[12]; a.w_bp = (const float*)d_in[13]; a.w_bh = (const float*)d_in[14]; a.w_bd = (const float*)d_in[15]; a.w_out = (const float*)d_in[16];
    a.out = (float*)d_out; a.ws = (unsigned char*)d_ws;
    (void)hipMemsetAsync((char*)d_ws + WS_CTL, 0, 131072, stream);
    void* args[] = {&a};
    hipError_t e = hipLaunchCooperativeKernel((const void*)fwd_kernel, dim3(grid), dim3(512), args, LDS_BYTES, stream);
    if (e != hipSuccess) fprintf(stderr, "cooperative launch failed: %s (grid %d)\n", hipGetErrorString(e), grid);
}
```

```cpp
#include <hip/hip_runtime.h>
#include <hip/hip_cooperative_groups.h>
#include <cstdio>
#include <cstdint>
namespace cg = cooperative_groups;

#define LAS __attribute__((address_space(3)))
typedef unsigned short bf16_t;
typedef short bf16x8 __attribute__((ext_vector_type(8)));
typedef float f32x4 __attribute__((ext_vector_type(4)));
typedef float f32x2 __attribute__((ext_vector_type(2)));
typedef unsigned u32x4 __attribute__((ext_vector_type(4)));
typedef unsigned u32x2 __attribute__((ext_vector_type(2)));
typedef short s16x4 __attribute__((ext_vector_type(4)));
typedef float f32x16_t __attribute__((ext_vector_type(16)));

constexpr int D = 2048, NB = 2, SEQ = 4096, NMETA = 16, L = SEQ + NMETA  , T = NB * L  , MP = 8448  ;
constexpr int DFF = 5632, INCOLS = 12032, LP = 4352  ;
constexpr int PW = 512, HW = 768, DW = 768;
constexpr float ALPHA = 1.4142135623730951f;
constexpr float LN_EPS = 1e-5f, RMS_EPS = 1e-6f;
constexpr float C2 = 0.125f * 1.4426950408889634f;

constexpr size_t al(size_t x) { return (x + 4095) & ~(size_t)4095; }
constexpr size_t WS_CTL = 0, CTL_BYTES = 1 << 20;
constexpr size_t SZ_WUP = (size_t)2 * DFF * D * 2, SZ_WDN = (size_t)D * DFF * 2, SZ_WIN = (size_t)INCOLS * D * 2;
constexpr size_t WS_WUP = WS_CTL + CTL_BYTES;
constexpr size_t WS_WDN = WS_WUP + 4 * SZ_WUP;
constexpr size_t WS_WIN = WS_WDN + 4 * SZ_WDN;
constexpr size_t WS_WBP = WS_WIN + 2 * SZ_WIN;
constexpr size_t WS_WBH = WS_WBP + 2 * (size_t)D * PW * 2;
constexpr size_t WS_WBD = WS_WBH + 2 * (size_t)D * HW * 2;
constexpr size_t WS_WO = WS_WBD + 2 * (size_t)D * DW * 2;
constexpr size_t WS_H = al(WS_WO + 2 * (size_t)D * D * 2);
constexpr size_t WS_HB = al(WS_H + (size_t)MP * D * 4);
constexpr size_t WS_PRE = al(WS_HB + (size_t)MP * D * 2);
constexpr size_t WS_ACT = al(WS_PRE + (size_t)MP * D * 4);
constexpr size_t WS_ZP = al(WS_ACT + (size_t)MP * DFF * 2);
constexpr size_t WS_ZH = al(WS_ZP + (size_t)MP * PW * 4);
constexpr size_t WS_QA = al(WS_ZH + (size_t)MP * 3072 * 4);
constexpr size_t WS_KA = al(WS_QA + (size_t)NB * LP * 768 * 2);
constexpr size_t WS_VA = al(WS_KA + (size_t)NB * LP * 768 * 2);
constexpr size_t WS_G = al(WS_VA + (size_t)NB * LP * 768 * 2);
constexpr size_t WS_YP = al(WS_G + (size_t)MP * 6144 * 2);
constexpr size_t WS_YH = al(WS_YP + (size_t)MP * PW * 2);
constexpr size_t WS_YD = al(WS_YH + (size_t)MP * HW * 2);
constexpr size_t WS_OH = al(WS_YD + (size_t)MP * DW * 2);
constexpr size_t WS_OD = al(WS_OH + (size_t)T * HW * 4);
constexpr size_t WS_MF = al(WS_OD + (size_t)NB * LP * 1536 * 4);
constexpr size_t WS_MB = al(WS_MF + (size_t)MP * D * 4);
constexpr size_t WS_END = al(WS_MB + (size_t)MP * D * 2);
static_assert(WS_KA - WS_QA == WS_VA - WS_KA, "Q/K/V attention buffers equally spaced");
constexpr size_t WS_HG = WS_END, WS_HV = al(WS_HG + (size_t)MP * HW * 2), WS_END_HG = al(WS_HV + (size_t)MP * HW * 2);

constexpr int LDS_BYTES = 147456;

typedef float f32x2_t __attribute__((ext_vector_type(2))); typedef __bf16 bf16x2_t __attribute__((ext_vector_type(2)));
__device__ __forceinline__ unsigned pk2(float lo, float hi) { f32x2_t v = {lo, hi}; bf16x2_t b = __builtin_convertvector(v, bf16x2_t); return __builtin_bit_cast(unsigned, b); }
__device__ __forceinline__ unsigned f2bf(float f) { return pk2(f, 0.f) & 0xffffu; }
__device__ __forceinline__ float bf2f(unsigned short v) { return __builtin_bit_cast(float, (unsigned)v << 16); }
__device__ __forceinline__ float bflo(unsigned w) { return __builtin_bit_cast(float, w << 16); }
__device__ __forceinline__ float bfhi(unsigned w) { return __builtin_bit_cast(float, w & 0xffff0000u); }
__device__ __forceinline__ float wave_sum(float v) {
#pragma unroll
    for (int o = 1; o < 64; o <<= 1) v += __shfl_xor(v, o);
    return v;
}
__device__ __forceinline__ float sigmoidf_(float x) { return __builtin_amdgcn_rcpf(1.0f + __builtin_amdgcn_exp2f(-1.4426950408889634f * x)); }

__device__ __forceinline__ int opq_v(int x) { asm volatile("" : "+v"(x)); return x; }
__device__ __forceinline__ int opq_s(int x) { asm volatile("" : "+s"(x)); return x; }


#define XB_TMO      128
#define XB_XCNT(j)  (256  + 64 * (j))
#define XB_XSUB(j)  (1280 + 64 * (j))
#define XB_XGEN(j)  (2304 + 64 * (j))
#define XB_TOP      3328
#define XB_TOPGEN   3392
#define XCD_BAR_WORDS 3456
#define XB_SPIN_CAP (1u << 22)
__device__ __forceinline__ unsigned xb_ld(unsigned* p)              { return __hip_atomic_load(p, __ATOMIC_RELAXED, __HIP_MEMORY_SCOPE_AGENT); }
__device__ __forceinline__ unsigned xb_add(unsigned* p, unsigned v) { return __hip_atomic_fetch_add(p, v, __ATOMIC_RELAXED, __HIP_MEMORY_SCOPE_AGENT); }
__device__ __forceinline__ unsigned xb_xcc_id() { return (unsigned)__builtin_amdgcn_s_getreg((3 << 11) | 20) & 0xFu; }
#define XB_SPIN(cond, bar) do { unsigned _sp = 0; while (cond) { __builtin_amdgcn_s_sleep(1); \
    if ((++_sp & 255u) == 0u) { if (xb_ld(&(bar)[XB_TMO])) break; if (_sp > XB_SPIN_CAP) { atomicAdd(&(bar)[XB_TMO], 1u); break; } } } } while (0)
struct XcdBarrier { unsigned* bar; unsigned x; volatile LAS unsigned* st; };
__device__ __forceinline__ XcdBarrier xcd_barrier_post(unsigned* bar, volatile LAS unsigned* st) {
    XcdBarrier b; b.bar = bar; b.x = xb_xcc_id(); b.st = st;
    if (threadIdx.x == 0) (void)xb_add(&bar[XB_XCNT(b.x)], 1u);
    return b;
}
__device__ __forceinline__ void xcd_barrier_complete(unsigned* bar, unsigned x, unsigned& nloc, unsigned& nx) {
    const unsigned G = gridDim.x * gridDim.y * gridDim.z;
    unsigned sum, cnt, mine, sp = 0u;
    for (;;) {
        sum = 0u; cnt = 0u; mine = 0u;
#pragma unroll
        for (unsigned j = 0; j < 16; ++j) { const unsigned c = xb_ld(&bar[XB_XCNT(j)]); sum += c; cnt += (c > 0u) ? 1u : 0u; mine = (j == x) ? c : mine; }
        if (sum == G) break;
        __builtin_amdgcn_s_sleep(1);
        if ((++sp & 255u) == 0u) { if (xb_ld(&bar[XB_TMO])) break; if (sp > XB_SPIN_CAP) { atomicAdd(&bar[XB_TMO], 1u); break; } }
    }
    nloc = mine > 0u ? mine : 1u; nx = cnt > 0u ? cnt : 1u;
}
__device__ __forceinline__ void xcd_barrier(unsigned* bar, volatile LAS unsigned* st) {
    asm volatile("s_waitcnt vmcnt(0)" ::: "memory");
    __syncthreads();
    if (threadIdx.x == 0) {
        const unsigned x = xb_xcc_id();
        __builtin_amdgcn_s_waitcnt(0);
        unsigned nloc = st[0], nx = st[1];
        if (nloc == 0u) { xcd_barrier_complete(bar, x, nloc, nx); st[0] = nloc; st[1] = nx; }
        const unsigned old = xb_add(&bar[XB_XSUB(x)], 1u);
        const unsigned gen = old / nloc;
        if (old + 1u == (gen + 1u) * nloc) {
            __builtin_amdgcn_fence(__ATOMIC_RELEASE, "agent");
            asm volatile("s_waitcnt vmcnt(0)" ::: "memory");
            const unsigned og = xb_add(&bar[XB_TOP], 1u);
            const unsigned tg = og / nx;
            if (og + 1u == (tg + 1u) * nx) xb_add(&bar[XB_TOPGEN], 1u);
            else XB_SPIN(xb_ld(&bar[XB_TOPGEN]) == tg, bar);
            __builtin_amdgcn_fence(__ATOMIC_ACQUIRE, "agent");
            xb_add(&bar[XB_XGEN(x)], 1u);
            asm volatile("s_waitcnt vmcnt(0)" ::: "memory");
        } else {
            XB_SPIN(xb_ld(&bar[XB_XGEN(x)]) == gen, bar);
            __builtin_amdgcn_fence(__ATOMIC_ACQUIRE, "agent");
            asm volatile("s_waitcnt vmcnt(0)" ::: "memory");
        }
    }
    __syncthreads();
}

namespace pg8 {
constexpr int BM = 256, BK = 64, HALF = 128, HTB = HALF * BK * 2, STAGE_BYTES = 8 * HTB, NXCD = 8, WGM = 8;
__host__ __device__ __forceinline__ int lds_byte(int r, int c) { const int st = (r >> 4) * 2 + (c >> 5), rr = r & 15, cc = c & 31, ob = rr * 64 + cc * 2; return st * 1024 + (ob ^ (((ob >> 9) & 1) << 5)); }
__host__ __device__ __forceinline__ void stage_rc(int b, int& R, int& C) { const int st = b / 1024, sb = b % 1024, swz = sb ^ (((sb >> 9) & 1) << 5); R = (st >> 1) * 16 + swz / 64; C = (st & 1) * 32 + (swz % 64) / 2; }
__host__ __device__ __forceinline__ int perm32(int rho) { const int n = rho >> 4, i = rho & 15; return 8 * (i >> 2) + 4 * n + (i & 3); }
struct Unit { int pm, pn; };
struct Gemm { const bf16_t* A; const bf16_t* Bt; int M, N, K; };
struct StaticOrder {
    int nM, nN, nwg, G, c;
    __host__ __device__ void init(int M, int N, int G_, int c_) { nM = M / BM; nN = N / BM; nwg = nM * nN; G = G_; c = c_; }
    __host__ __device__ bool next(int i, Unit& u) const {
        const long Lx = (long)i * G + c; if (Lx >= nwg) return false;
        int wgid = (int)Lx; { const int q = nwg / NXCD, r = nwg % NXCD, xcd = wgid % NXCD, off = wgid / NXCD; wgid = (xcd < r ? xcd * (q + 1) : r * (q + 1) + (xcd - r) * q) + off; }
        const int nig = WGM * nN, gid = wgid / nig, fm = gid * WGM, gsz = (nM - fm) < WGM ? (nM - fm) : WGM;
        u.pm = fm + ((wgid % nig) % gsz); u.pn = (wgid % nig) / gsz; return true;
    }
    __device__ __forceinline__ void a_ready(const Unit&) const {}
    __device__ __forceinline__ void done(const Unit&) const {}
};
__device__ __forceinline__ unsigned cvt_pk_bf16(float lo, float hi) { f32x2_t v = {lo, hi}; bf16x2_t b = __builtin_convertvector(v, bf16x2_t); return __builtin_bit_cast(unsigned, b); }

template <class Epi, class Sched, bool ALIGN_EPI = false, bool SP2 = false>
__device__ __forceinline__ void gemm_phase(LAS unsigned char* lds, const Gemm g, const Sched& S, const Epi& E) {
    const int tid = opq_v((int)threadIdx.x), wid = __builtin_amdgcn_readfirstlane(tid >> 6), lane = tid & 63, wr = wid >> 2, wc = wid & 3, fr = lane & 15, fq = lane >> 4;
    const int K = g.K, nt = K / BK;
    unsigned voffA[2], voffB[2];
#pragma unroll
    for (int i = 0; i < 2; ++i) { int R, C; stage_rc(tid * 16 + i * 8192, R, C); const int Rb = Epi::PERM ? ((R & ~31) + perm32(R & 31)) : R;
        voffA[i] = (unsigned)(R * K + C) * 2u; voffB[i] = (unsigned)(Rb * K + C) * 2u; }
    const size_t kstep = (size_t)(BK * 2);
    const size_t hstep = (size_t)HALF * K * 2;
    const size_t tstep = 2 * hstep;
    const unsigned ldsw = (unsigned)wid * 1024u;
    const int aoff = lds_byte(wr * 64 + fr, fq * 8), boff = lds_byte(wc * 32 + fr, fq * 8);
#define PG8_SA(b, h) (((b) * 2 + (h)) * HTB)
#define PG8_SB(b, h) ((4 + (b) * 2 + (h)) * HTB)
#define PG8_STAGE(bufoff, gbase, voff) do { _Pragma("unroll") for (int _i = 0; _i < 2; ++_i) \
        __builtin_amdgcn_global_load_lds((const unsigned*)((const char*)(gbase) + (voff)[_i]), (LAS unsigned*)(lds + (bufoff) + ldsw + _i * 8192), 16, 0, 0); } while (0)
#define PG8_LDA(dst, b, h) do { _Pragma("unroll") for (int m = 0; m < 4; ++m) _Pragma("unroll") for (int k = 0; k < 2; ++k) dst[m][k] = *(const LAS bf16x8*)(lds + PG8_SA(b, h) + aoff + m * 2048 + k * 1024); } while (0)
#define PG8_LDB(dst, b, h) do { _Pragma("unroll") for (int n = 0; n < 2; ++n) _Pragma("unroll") for (int k = 0; k < 2; ++k) dst[n][k] = *(const LAS bf16x8*)(lds + PG8_SB(b, h) + boff + n * 2048 + k * 1024); } while (0)
#define PG8_MMA(ai, bj, At, Bt) do { __builtin_amdgcn_s_setprio(1); _Pragma("unroll") for (int m = 0; m < 4; ++m) _Pragma("unroll") for (int n = 0; n < 2; ++n) _Pragma("unroll") for (int k = 0; k < 2; ++k) \
        acc[ai][bj][m][n] = __builtin_amdgcn_mfma_f32_16x16x32_bf16(Bt[n][k], At[m][k], acc[ai][bj][m][n], 0, 0, 0); __builtin_amdgcn_s_setprio(0); } while (0)
#define PG8_WAIT_V(n) asm volatile("s_waitcnt vmcnt(" #n ")" ::: "memory")
#define PG8_WAIT_L(n) asm volatile("s_waitcnt lgkmcnt(" #n ")" ::: "memory")
#define PG8_BAR __builtin_amdgcn_s_barrier()
#define PG8_SCHED __builtin_amdgcn_sched_barrier(0)
    Unit cur, nxt; int ui = 0;
    if (!S.next(0, cur)) return;
    f32x4 acc[2][2][4][2];
#pragma unroll
    for (int a = 0; a < 2; ++a)
#pragma unroll
        for (int b = 0; b < 2; ++b)
#pragma unroll
            for (int m = 0; m < 4; ++m)
#pragma unroll
                for (int n = 0; n < 2; ++n) acc[a][b][m][n] = (f32x4){0.f, 0.f, 0.f, 0.f};
    bf16x8 At[4][2], B0[2][2], B1[2][2];
    const char* cA = (const char*)g.A + (size_t)cur.pm * tstep; const char* cB = (const char*)g.Bt + (size_t)cur.pn * tstep;
    S.a_ready(cur);
    if constexpr (SP2) {
        PG8_STAGE(PG8_SB(0, 0), cB, voffB); PG8_STAGE(PG8_SB(0, 1), cB + hstep, voffB); PG8_STAGE(PG8_SA(0, 0), cA, voffA); PG8_STAGE(PG8_SA(0, 1), cA + hstep, voffA);
        if (wr == 1) PG8_BAR;
        PG8_WAIT_V(2); PG8_BAR;
        PG8_STAGE(PG8_SB(1, 0), cB + kstep, voffB); PG8_STAGE(PG8_SA(1, 0), cA + kstep, voffA); PG8_STAGE(PG8_SB(1, 1), cB + hstep + kstep, voffB);
        PG8_WAIT_V(6); PG8_BAR;
    } else {
        PG8_STAGE(PG8_SB(0, 0), cB, voffB); PG8_STAGE(PG8_SA(0, 0), cA, voffA); PG8_STAGE(PG8_SB(0, 1), cB + hstep, voffB); PG8_STAGE(PG8_SA(0, 1), cA + hstep, voffA);
        if (wr == 1) PG8_BAR;
        PG8_WAIT_V(4); PG8_BAR;
        PG8_STAGE(PG8_SB(1, 0), cB + kstep, voffB); PG8_STAGE(PG8_SA(1, 0), cA + kstep, voffA); PG8_STAGE(PG8_SB(1, 1), cB + hstep + kstep, voffB);
        PG8_WAIT_V(6); PG8_BAR;
    }
    for (;;) {
        const bool has_next = S.next(ui + 1, nxt);
        const char* nA = has_next ? (const char*)g.A + (size_t)nxt.pm * tstep : cA; const char* nB = has_next ? (const char*)g.Bt + (size_t)nxt.pn * tstep : cB;
        for (int t = 0; t < nt; t += 2) {
            const bool last = (t == nt - 2);
            const char* a1 = cA + (size_t)(t + 1) * kstep;
            const char* a2 = last ? nA : cA + (size_t)(t + 2) * kstep; const char* b2 = last ? nB : cB + (size_t)(t + 2) * kstep;
            const char* a3 = a2 + kstep; const char* b3 = b2 + kstep;
            if (last && has_next) S.a_ready(nxt);
            if constexpr (SP2) {
            PG8_LDB(B0, 0, 0); PG8_LDB(B1, 0, 1); PG8_SCHED; PG8_LDA(At, 0, 0); PG8_STAGE(PG8_SA(1, 1), a1 + hstep, voffA);
            PG8_WAIT_V(8); PG8_WAIT_L(0); PG8_BAR; PG8_MMA(0, 0, At, B0); PG8_MMA(0, 1, At, B1); PG8_BAR; PG8_SCHED;
            PG8_LDA(At, 0, 1); PG8_STAGE(PG8_SB(0, 0), b2, voffB); PG8_STAGE(PG8_SB(0, 1), b2 + hstep, voffB); PG8_STAGE(PG8_SA(0, 0), a2, voffA);
            PG8_WAIT_V(8); PG8_WAIT_L(0); PG8_BAR; PG8_MMA(1, 0, At, B0); PG8_MMA(1, 1, At, B1); PG8_BAR; PG8_SCHED;
            PG8_LDB(B0, 1, 0); PG8_LDB(B1, 1, 1); PG8_SCHED; PG8_LDA(At, 1, 0); PG8_STAGE(PG8_SA(0, 1), a2 + hstep, voffA);
            PG8_WAIT_V(8); PG8_WAIT_L(0); PG8_BAR; PG8_MMA(0, 0, At, B0); PG8_MMA(0, 1, At, B1); PG8_BAR; PG8_SCHED;
            PG8_LDA(At, 1, 1); PG8_STAGE(PG8_SB(1, 0), b3, voffB); PG8_STAGE(PG8_SB(1, 1), b3 + hstep, voffB); PG8_STAGE(PG8_SA(1, 0), a3, voffA);
            PG8_WAIT_V(8); PG8_WAIT_L(0); PG8_BAR; PG8_MMA(1, 0, At, B0); PG8_MMA(1, 1, At, B1); PG8_BAR; PG8_SCHED;
            } else {
            PG8_LDB(B0, 0, 0); PG8_SCHED; PG8_LDA(At, 0, 0); PG8_STAGE(PG8_SA(1, 1), a1 + hstep, voffA);
            PG8_WAIT_L(8); PG8_BAR; PG8_WAIT_L(0); PG8_MMA(0, 0, At, B0); PG8_BAR; PG8_SCHED;
            PG8_LDB(B1, 0, 1); PG8_STAGE(PG8_SB(0, 0), b2, voffB);
            PG8_BAR; PG8_WAIT_L(0); PG8_MMA(0, 1, At, B1); PG8_BAR;
            PG8_LDA(At, 0, 1); PG8_STAGE(PG8_SA(0, 0), a2, voffA);
            PG8_BAR; PG8_WAIT_L(0); PG8_MMA(1, 0, At, B0); PG8_BAR; PG8_SCHED;
            PG8_STAGE(PG8_SB(0, 1), b2 + hstep, voffB);
            PG8_WAIT_V(6); PG8_BAR; PG8_MMA(1, 1, At, B1); PG8_BAR;
            PG8_LDB(B0, 1, 0); PG8_SCHED; PG8_LDA(At, 1, 0); PG8_STAGE(PG8_SA(0, 1), a2 + hstep, voffA);
            PG8_WAIT_L(8); PG8_BAR; PG8_WAIT_L(0); PG8_MMA(0, 0, At, B0); PG8_BAR; PG8_SCHED;
            PG8_LDB(B1, 1, 1); PG8_STAGE(PG8_SB(1, 0), b3, voffB);
            PG8_BAR; PG8_WAIT_L(0); PG8_MMA(0, 1, At, B1); PG8_BAR;
            PG8_LDA(At, 1, 1); PG8_STAGE(PG8_SA(1, 0), a3, voffA);
            PG8_BAR; PG8_WAIT_L(0); PG8_MMA(1, 0, At, B0); PG8_BAR; PG8_SCHED;
            PG8_STAGE(PG8_SB(1, 1), b3 + hstep, voffB);
            PG8_WAIT_V(6); PG8_BAR; PG8_MMA(1, 1, At, B1); PG8_BAR;
            }
        }
        if constexpr (ALIGN_EPI) { if (wr == 0) PG8_BAR; }
        if constexpr (!Epi::AFTER_DRAIN) { E(acc, cur, wr, wc, fr, fq); S.done(cur); }
        if (!has_next) break;
#pragma unroll
        for (int a = 0; a < 2; ++a)
#pragma unroll
            for (int b = 0; b < 2; ++b)
#pragma unroll
                for (int m = 0; m < 4; ++m)
#pragma unroll
                    for (int n = 0; n < 2; ++n) acc[a][b][m][n] = (f32x4){0.f, 0.f, 0.f, 0.f};
        cur = nxt; cA = nA; cB = nB; ++ui;
        if constexpr (ALIGN_EPI) { if (wr == 1) PG8_BAR; }
    }
    PG8_WAIT_V(0);
    if constexpr (!ALIGN_EPI) { if (wr == 0) PG8_BAR; }
    PG8_BAR;
    if constexpr (Epi::AFTER_DRAIN) { E.fused(acc, cur, wr, wc, fr, fq, lds, wid, lane); S.done(cur); }
#undef PG8_SA
#undef PG8_SB
#undef PG8_STAGE
#undef PG8_LDA
#undef PG8_LDB
#undef PG8_MMA
#undef PG8_WAIT_V
#undef PG8_WAIT_L
#undef PG8_BAR
#undef PG8_SCHED
}

struct EpiSwiglu {
    static constexpr bool PERM = true, AFTER_DRAIN = false;
    bf16_t* O;
    __device__ __forceinline__ void tail(int row, int col, float a_, float u_) const { O[(size_t)row * DFF + col] = (bf16_t)f2bf(a_ * sigmoidf_(a_) * u_); }
    __device__ __forceinline__ void operator()(const f32x4 (&acc)[2][2][4][2], const Unit& u, int wr, int wc, int fr, int fq) const {
        const int row0 = u.pm * BM + wr * 64 + fr, col0 = u.pn * 128 + wc * 32 + 8 * fq;
#pragma unroll
        for (int ai = 0; ai < 2; ++ai)
#pragma unroll
            for (int m = 0; m < 4; ++m) {
                bf16_t* p = O + (size_t)(row0 + ai * HALF + m * 16) * DFF + col0;
                float v[8];
#pragma unroll
                for (int n = 0; n < 2; ++n)
#pragma unroll
                    for (int j = 0; j < 4; ++j) { const float a = acc[ai][0][m][n][j], g = acc[ai][1][m][n][j]; v[n * 4 + j] = a * sigmoidf_(a) * g; }
                u32x4 w; w.x = cvt_pk_bf16(v[0], v[1]); w.y = cvt_pk_bf16(v[2], v[3]); w.z = cvt_pk_bf16(v[4], v[5]); w.w = cvt_pk_bf16(v[6], v[7]);
                *(u32x4*)p = w;
            }
    }
};
struct EpiResid {
    static constexpr bool PERM = false, AFTER_DRAIN = false;
    const float* H; float* PRE; float s;
    __device__ __forceinline__ void tail(int row, int col, float v, float) const { const size_t o = (size_t)row * D + col; PRE[o] = H[o] * ALPHA + v * s; }
    __device__ __forceinline__ void operator()(const f32x4 (&acc)[2][2][4][2], const Unit& u, int wr, int wc, int fr, int fq) const {
        const int row0 = u.pm * BM + wr * 64 + fr, col0 = u.pn * BM + wc * 32 + 4 * fq;
#pragma unroll
        for (int ai = 0; ai < 2; ++ai)
#pragma unroll
            for (int m = 0; m < 4; ++m) {
                const size_t off = (size_t)(row0 + ai * HALF + m * 16) * D + col0;
#pragma unroll
                for (int bj = 0; bj < 2; ++bj)
#pragma unroll
                    for (int n = 0; n < 2; ++n) { const f32x4 h = *(const f32x4*)(H + off + bj * HALF + n * 16); *(f32x4*)(PRE + off + bj * HALF + n * 16) = h * ALPHA + acc[ai][bj][m][n] * s; }
            }
    }
};
struct EpiInproj {
    static constexpr bool PERM = true, AFTER_DRAIN = false;
    float* ZP; float* ZH; bf16_t* QA; bf16_t* KA; bf16_t* VA; bf16_t* G;
    __device__ __forceinline__ void tail(int row, int c, float v, float) const {
        if (c < 512) ZP[(size_t)row * PW + c] = v;
        else if (c < 2048) ZH[(size_t)row * 3072 + (c - 512)] = v;
        else if (c < 2816) (G + (WS_HV - WS_G) / 2)[(size_t)row * HW + (c - 2048)] = (bf16_t)f2bf(v);
        else if (c < 3584) (G + (WS_HG - WS_G) / 2)[(size_t)row * HW + (c - 2816)] = (bf16_t)f2bf(v);
        else if (c < 5888) { const int seg = (c - 3584) / 768, cc = c - 3584 - seg * 768; const int b_ = row >= L ? 1 : 0, t_ = row - b_ * L;
            if (seg == 2) VA[((size_t)b_ * 768 + cc) * LP + t_] = (bf16_t)f2bf(v);
            else (QA + (size_t)seg * ((WS_KA - WS_QA) / 2))[(size_t)(b_ * LP + t_) * 768 + cc] = (bf16_t)f2bf(seg == 0 ? v * C2 : v); }
        else G[(size_t)row * 6144 + (c - 5888)] = (bf16_t)f2bf(sigmoidf_(v));
    }
    __device__ __forceinline__ void operator()(const f32x4 (&acc)[2][2][4][2], const Unit& u, int wr, int wc, int fr, int fq) const {
        const int row0 = u.pm * BM + wr * 64 + fr, pn = u.pn;
#pragma unroll
        for (int ai = 0; ai < 2; ++ai)
#pragma unroll
            for (int m = 0; m < 4; ++m) {
                const int row = row0 + ai * HALF + m * 16;
#pragma unroll
                for (int bj = 0; bj < 2; ++bj) {
                    const int c = pn * BM + bj * HALF + wc * 32 + 8 * fq;
                    const f32x4 v0 = acc[ai][bj][m][0], v1 = acc[ai][bj][m][1];
                    if (pn < 2) { float* p = ZP + (size_t)row * PW + c; *(f32x4*)p = v0; *(f32x4*)(p + 4) = v1; }
                    else if (pn < 8) { float* p = ZH + (size_t)row * 3072 + (c - 512); *(f32x4*)p = v0; *(f32x4*)(p + 4) = v1; }
                    else if (pn < 11) { u32x4 w; w.x = cvt_pk_bf16(v0[0], v0[1]); w.y = cvt_pk_bf16(v0[2], v0[3]); w.z = cvt_pk_bf16(v1[0], v1[1]); w.w = cvt_pk_bf16(v1[2], v1[3]);
                        *(u32x4*)(G + (WS_HV - WS_G) / 2 + (size_t)row * HW + (c - 2048)) = w; }
                    else if (pn < 14) { u32x4 w; w.x = cvt_pk_bf16(v0[0], v0[1]); w.y = cvt_pk_bf16(v0[2], v0[3]); w.z = cvt_pk_bf16(v1[0], v1[1]); w.w = cvt_pk_bf16(v1[2], v1[3]);
                        *(u32x4*)(G + (WS_HG - WS_G) / 2 + (size_t)row * HW + (c - 2816)) = w; }
                    else if (pn < 23) {
                        const int seg = (pn - 14) / 3, cc = c - 3584 - seg * 768;
                        if (row < T && seg == 2) {
                            const int b_ = row >= L ? 1 : 0, t_ = row - b_ * L;
                            bf16_t* vt = VA + ((size_t)b_ * 768 + cc) * LP + t_;
                            vt[0] = (bf16_t)f2bf(v0[0]); vt[LP] = (bf16_t)f2bf(v0[1]); vt[2 * LP] = (bf16_t)f2bf(v0[2]); vt[3 * LP] = (bf16_t)f2bf(v0[3]);
                            vt[4 * LP] = (bf16_t)f2bf(v1[0]); vt[5 * LP] = (bf16_t)f2bf(v1[1]); vt[6 * LP] = (bf16_t)f2bf(v1[2]); vt[7 * LP] = (bf16_t)f2bf(v1[3]);
                        } else if (row < T) {
                            const int arow = row >= L ? row - L + LP : row;
                            bf16_t* base = QA + (size_t)seg * ((WS_KA - WS_QA) / 2); const float sc = seg == 0 ? C2 : 1.f;
                            u32x4 w; w.x = cvt_pk_bf16(v0[0] * sc, v0[1] * sc); w.y = cvt_pk_bf16(v0[2] * sc, v0[3] * sc); w.z = cvt_pk_bf16(v1[0] * sc, v1[1] * sc); w.w = cvt_pk_bf16(v1[2] * sc, v1[3] * sc);
                            *(u32x4*)(base + (size_t)arow * 768 + cc) = w;
                        }
                    } else {
                        u32x4 w; w.x = cvt_pk_bf16(sigmoidf_(v0[0]), sigmoidf_(v0[1])); w.y = cvt_pk_bf16(sigmoidf_(v0[2]), sigmoidf_(v0[3]));
                        w.z = cvt_pk_bf16(sigmoidf_(v1[0]), sigmoidf_(v1[1])); w.w = cvt_pk_bf16(sigmoidf_(v1[2]), sigmoidf_(v1[3]));
                        *(u32x4*)(G + (size_t)row * 6144 + (c - 5888)) = w;
                    }
                }
            }
    }
};
struct EpiBranch {
    static constexpr bool PERM = true, AFTER_DRAIN = false;
    const bf16_t* G; int goff; float* MF; bf16_t* MB; int mode;
    __device__ __forceinline__ void tail(int row, int c, float v, float) const {
        v *= bf2f(G[(size_t)row * 6144 + goff + c]); bf16_t* mb = MB + (size_t)row * D + c;
        if (mode != 0) v += bf2f(__hip_atomic_load(mb, __ATOMIC_RELAXED, __HIP_MEMORY_SCOPE_AGENT));
        *mb = (bf16_t)f2bf(v);
    }
    __device__ __forceinline__ void operator()(const f32x4 (&acc)[2][2][4][2], const Unit& u, int wr, int wc, int fr, int fq) const {
        const int row0 = u.pm * BM + wr * 64 + fr;
#pragma unroll
        for (int ai = 0; ai < 2; ++ai)
#pragma unroll
            for (int m = 0; m < 4; ++m) {
                const int row = row0 + ai * HALF + m * 16;
#pragma unroll
                for (int bj = 0; bj < 2; ++bj) {
                    const int c = u.pn * BM + bj * HALF + wc * 32 + 8 * fq;
                    const u32x4 gw = *(const u32x4*)(G + (size_t)row * 6144 + goff + c);
                    f32x4 v0 = acc[ai][bj][m][0], v1 = acc[ai][bj][m][1];
                    v0[0] *= bflo(gw.x); v0[1] *= bfhi(gw.x); v0[2] *= bflo(gw.y); v0[3] *= bfhi(gw.y);
                    v1[0] *= bflo(gw.z); v1[1] *= bfhi(gw.z); v1[2] *= bflo(gw.w); v1[3] *= bfhi(gw.w);
                    bf16_t* mb = MB + (size_t)row * D + c;
                    if (mode != 0) { const u32x4 pw = __builtin_nontemporal_load((const u32x4*)mb);
                        v0[0] += bflo(pw.x); v0[1] += bfhi(pw.x); v0[2] += bflo(pw.y); v0[3] += bfhi(pw.y); v1[0] += bflo(pw.z); v1[1] += bfhi(pw.z); v1[2] += bflo(pw.w); v1[3] += bfhi(pw.w); }
                    u32x4 w; w.x = cvt_pk_bf16(v0[0], v0[1]); w.y = cvt_pk_bf16(v0[2], v0[3]); w.z = cvt_pk_bf16(v1[0], v1[1]); w.w = cvt_pk_bf16(v1[2], v1[3]);
                    *(u32x4*)mb = w;
                }
            }
    }
};

struct PanelStats {
    unsigned* xbuf;
    unsigned* cnt;
    float eps;
    __device__ __forceinline__ void run(const f32x4 (&v)[2][2][4][2], const Unit& u, int wr, int wc, int fr, int fq, LAS unsigned char* lds, int wid, int lane) const {
        LAS f32x2* P = (LAS f32x2*)lds;
        LAS f32x2* S = (LAS f32x2*)(lds + 8192);
#pragma unroll
        for (int ai = 0; ai < 2; ++ai)
#pragma unroll
            for (int m = 0; m < 4; ++m) {
                float s = 0.f;
#pragma unroll
                for (int bj = 0; bj < 2; ++bj)
#pragma unroll
                    for (int n = 0; n < 2; ++n) { const f32x4 x = v[ai][bj][m][n]; s += (x[0] + x[1]) + (x[2] + x[3]); }
                s += __shfl_xor(s, 16); s += __shfl_xor(s, 32);
                const float mw = s * (1.0f / 64.0f); float q = 0.f;
#pragma unroll
                for (int bj = 0; bj < 2; ++bj)
#pragma unroll
                    for (int n = 0; n < 2; ++n) { const f32x4 d = v[ai][bj][m][n] - mw; q += (d[0] * d[0] + d[1] * d[1]) + (d[2] * d[2] + d[3] * d[3]); }
                q += __shfl_xor(q, 16); q += __shfl_xor(q, 32);
                if (fq == 0) P[(ai * HALF + wr * 64 + m * 16 + fr) * 4 + wc] = (f32x2){mw, q};
            }
        asm volatile("s_waitcnt lgkmcnt(0)" ::: "memory"); __builtin_amdgcn_s_barrier(); asm volatile("" ::: "memory");
        const int row = wid * 32 + (lane & 31);
        if (lane < 32) {
            const f32x2 a = P[row * 4 + 0], b = P[row * 4 + 1], c = P[row * 4 + 2], d = P[row * 4 + 3];
            const float mt = (a.x + b.x + c.x + d.x) * 0.25f;
            const float da = a.x - mt, db = b.x - mt, dc = c.x - mt, dd = d.x - mt;
            const float m2 = (a.y + b.y) + (c.y + d.y) + 64.0f * ((da * da + db * db) + (dc * dc + dd * dd));
            unsigned long long* slot = (unsigned long long*)xbuf + ((size_t)(u.pm * BM + row) * 8 + u.pn);
            __hip_atomic_store(slot, ((unsigned long long)__float_as_uint(m2) << 32) | __float_as_uint(mt), __ATOMIC_RELAXED, __HIP_MEMORY_SCOPE_AGENT);
        }
        asm volatile("s_waitcnt vmcnt(0)" ::: "memory");
        if (lane == 0) __hip_atomic_fetch_add(cnt + 64 * u.pm, 1u, __ATOMIC_RELAXED, __HIP_MEMORY_SCOPE_AGENT);
        if (wid == 0) {
            unsigned sp = 0;
            while ((unsigned)__builtin_amdgcn_readfirstlane(__hip_atomic_load(cnt + 64 * u.pm, __ATOMIC_RELAXED, __HIP_MEMORY_SCOPE_AGENT)) < 64u) { __builtin_amdgcn_s_sleep(2); if (++sp > (1u << 24)) break; }
            __builtin_amdgcn_fence(__ATOMIC_ACQUIRE, "agent");
        }
        asm volatile("s_waitcnt vmcnt(0) lgkmcnt(0)" ::: "memory"); __builtin_amdgcn_s_barrier(); asm volatile("" ::: "memory");
        if (lane < 32) {
            const unsigned long long* slot = (const unsigned long long*)xbuf + (size_t)(u.pm * BM + row) * 8; float mt[8], m2[8]; float ms = 0.f;
#pragma unroll
            for (int t = 0; t < 8; ++t) { const unsigned long long w = __hip_atomic_load(slot + t, __ATOMIC_RELAXED, __HIP_MEMORY_SCOPE_AGENT); mt[t] = __uint_as_float((unsigned)w); m2[t] = __uint_as_float((unsigned)(w >> 32)); ms += mt[t]; }
            const float mean = ms * 0.125f; float q = 0.f;
#pragma unroll
            for (int t = 0; t < 8; ++t) { const float dm = mt[t] - mean; q += m2[t] + 256.0f * dm * dm; }
            S[row] = (f32x2){mean, 1.0f / sqrtf(q * (1.0f / 2048.0f) + eps)};
        }
        asm volatile("s_waitcnt lgkmcnt(0)" ::: "memory"); __builtin_amdgcn_s_barrier(); asm volatile("" ::: "memory");
    }
};
struct EpiLn {
    static constexpr bool PERM = false, AFTER_DRAIN = true;
    float* H; bf16_t* HB; const float* g; const float* bta; float s; PanelStats st; float* out;
    __device__ __forceinline__ void fused(f32x4 (&acc)[2][2][4][2], const Unit& u, int wr, int wc, int fr, int fq, LAS unsigned char* lds, int wid, int lane) const {
        const LAS f32x2* S = (const LAS f32x2*)(lds + 8192);
        const int col0 = u.pn * BM + wc * 32 + 4 * fq;
#pragma unroll
        for (int ai = 0; ai < 2; ++ai)
#pragma unroll
            for (int m = 0; m < 4; ++m) { const size_t off = (size_t)(u.pm * BM + ai * HALF + wr * 64 + m * 16 + fr) * D + col0;
#pragma unroll
                for (int bj = 0; bj < 2; ++bj)
#pragma unroll
                    for (int n = 0; n < 2; ++n) { const f32x4 h = *(const f32x4*)(H + off + bj * HALF + n * 16); acc[ai][bj][m][n] = h * ALPHA + acc[ai][bj][m][n] * s; }
                asm volatile("" : "+v"(acc[ai][0][m][0]), "+v"(acc[ai][0][m][1]), "+v"(acc[ai][1][m][0]), "+v"(acc[ai][1][m][1]));
                if (m & 1) asm volatile("" ::: "memory"); }
        st.run(acc, u, wr, wc, fr, fq, lds, wid, lane);
#pragma unroll
        for (int ai = 0; ai < 2; ++ai)
#pragma unroll
            for (int m = 0; m < 4; ++m) { const int r = ai * HALF + wr * 64 + m * 16 + fr, row = u.pm * BM + r; const f32x2 sr = S[r];
#pragma unroll
                for (int bj = 0; bj < 2; ++bj)
#pragma unroll
                    for (int n = 0; n < 2; ++n) { const int c = col0 + bj * HALF + n * 16; const f32x4 o = (acc[ai][bj][m][n] - sr.x) * sr.y * *(const f32x4*)(g + c) + *(const f32x4*)(bta + c);
                        if (out) { const int b_ = row >= L ? 1 : 0, t_ = row - b_ * L; if (t_ >= NMETA) *(f32x4*)(out + ((size_t)b_ * SEQ + (t_ - NMETA)) * D + c) = o; }
                        else { *(f32x4*)(H + (size_t)row * D + c) = o; u32x2 w; w.x = cvt_pk_bf16(o[0], o[1]); w.y = cvt_pk_bf16(o[2], o[3]); *(u32x2*)(HB + (size_t)row * D + c) = w; } } }
    }
};
}


constexpr int MT = 8192;
template <class Epi, bool PAIR>
__device__ __forceinline__ void tail_gemm(const bf16_t* A, const bf16_t* Bt, int K, int ncols, const Epi& E, unsigned char* lds_g, int blk, int nblk) {
    const int tid = opq_v((int)threadIdx.x), lane = tid & 63, wid = __builtin_amdgcn_readfirstlane(tid >> 6), m = lane & 31, hi = lane >> 5;
    float* P = (float*)lds_g;
    const int kslice = K / 8, k0 = wid * kslice;
    for (int tu = blk; tu < ncols / 32; tu += nblk) {
        const int n0 = tu * 32, brow = PAIR ? ((n0 / 128) * 256 + (n0 % 128)) : n0;
        const bf16_t* ap = A + (size_t)(MT + m) * K + k0 + 8 * hi; const bf16_t* bp = Bt + (size_t)(brow + m) * K + k0 + 8 * hi;
        f32x16_t acc0 = (f32x16_t){0.f, 0.f, 0.f, 0.f, 0.f, 0.f, 0.f, 0.f, 0.f, 0.f, 0.f, 0.f, 0.f, 0.f, 0.f, 0.f}, acc1 = acc0;
#pragma unroll 8
        for (int ks = 0; ks < kslice; ks += 16) {
            const bf16x8 av = *(const bf16x8*)(ap + ks), bv = *(const bf16x8*)(bp + ks);
            acc0 = __builtin_amdgcn_mfma_f32_32x32x16_bf16(av, bv, acc0, 0, 0, 0);
            if (PAIR) { const bf16x8 bu = *(const bf16x8*)(bp + (size_t)128 * K + ks); acc1 = __builtin_amdgcn_mfma_f32_32x32x16_bf16(av, bu, acc1, 0, 0, 0); }
        }
        __syncthreads();
#pragma unroll
        for (int r = 0; r < 16; ++r) { const int rm = (r & 3) + 8 * (r >> 2) + 4 * hi; P[wid * 1024 + rm * 32 + m] = acc0[r]; if (PAIR) P[8192 + wid * 1024 + rm * 32 + m] = acc1[r]; }
        __syncthreads();
#pragma unroll
        for (int e = 0; e < 2; ++e) { const int idx = tid * 2 + e; float v0 = 0.f, v1 = 0.f;
#pragma unroll
            for (int w = 0; w < 8; ++w) { v0 += P[w * 1024 + idx]; if (PAIR) v1 += P[8192 + w * 1024 + idx]; }
            E.tail(MT + (idx >> 5), n0 + (idx & 31), v0, v1); }
    }
    __syncthreads();
}

struct Args {
    const float* x; const float* meta; const float* ln_g; const float* ln_b; const float* ffn_w_in; const float* ffn_w_out; const float* w_in;
    const float* pool_w; const float* pool_scale; const float* hgrn_lb; const float* hgrn_ng; const float* diff_lambda; const float* diff_ng;
    const float* w_bp; const float* w_bh; const float* w_bd; const float* w_out;
    float* out; unsigned char* ws;
};

typedef const Args* ArgP;
__device__ __forceinline__ ArgP argp() { unsigned z; asm volatile("s_mov_b32 %0, 0" : "=s"(z)); return (ArgP)(const void*)((const __attribute__((address_space(4))) char*)__builtin_amdgcn_kernarg_segment_ptr() + z); }

__device__ __forceinline__ void transpose_item(const float* W, int K, int N, bf16_t* WT, int swiglu, float* scr, int item, int lane) {
    const int nblk = N / 64, kb = item / nblk, nb = item % nblk, k0 = 64 * kb, n0 = 64 * nb;
    int drow0 = n0;
    if (swiglu) { const int half = n0 / DFF, rem = n0 % DFF; drow0 = (rem / 128) * 256 + half * 128 + (rem % 128); }
    f32x4 v[16];
#pragma unroll
    for (int i = 0; i < 16; ++i) v[i] = *(const f32x4*)(W + (size_t)(k0 + 4 * i + (lane >> 4)) * N + n0 + 4 * (lane & 15));
#pragma unroll
    for (int i = 0; i < 16; ++i) { float* s = scr + (4 * i + (lane >> 4)) * 65 + 4 * (lane & 15); s[0] = v[i][0]; s[1] = v[i][1]; s[2] = v[i][2]; s[3] = v[i][3]; }
    asm volatile("s_waitcnt lgkmcnt(0)" ::: "memory");
    const int c = lane & 7;
#pragma unroll
    for (int j = 0; j < 8; ++j) { const int n = (lane >> 3) + 8 * j; const float* s = scr + (8 * c) * 65 + n;
        u32x4 o; o.x = pk2(s[0 * 65], s[1 * 65]); o.y = pk2(s[2 * 65], s[3 * 65]); o.z = pk2(s[4 * 65], s[5 * 65]); o.w = pk2(s[6 * 65], s[7 * 65]);
        *(u32x4*)(WT + (size_t)(drow0 + n) * K + k0 + 8 * c) = o; }
    asm volatile("s_waitcnt lgkmcnt(0)" ::: "memory");
}

__device__ __forceinline__ void prologue(unsigned char* lds_g, int gw, int NGW, int lane) {
    const Args a = *argp();
    float* scr = (float*)lds_g + (opq_v((int)threadIdx.x) >> 6) * (64 * 65);
    unsigned char* ws = a.ws;
    constexpr int I_UP = (D / 64) * (2 * DFF / 64), I_DN = (DFF / 64) * (D / 64), I_IN = (D / 64) * (INCOLS / 64);
    constexpr int I_BP = (PW / 64) * (D / 64), I_BH = (HW / 64) * (D / 64), I_WO = (D / 64) * (D / 64);
    constexpr int PER_L = 2 * I_UP + 2 * I_DN + I_IN + I_BP + 2 * I_BH + I_WO;
    for (int it = gw; it < 2 * PER_L; it += NGW) {
        const int l = it / PER_L; int r = it % PER_L;
        if (r < 2 * I_UP) { const int j = r / I_UP; r %= I_UP; transpose_item(a.ffn_w_in + (size_t)(l * 2 + j) * D * 2 * DFF, D, 2 * DFF, (bf16_t*)(ws + WS_WUP + (size_t)(l * 2 + j) * SZ_WUP), 1, scr, r, lane); continue; } r -= 2 * I_UP;
        if (r < 2 * I_DN) { const int j = r / I_DN; r %= I_DN; transpose_item(a.ffn_w_out + (size_t)(l * 2 + j) * DFF * D, DFF, D, (bf16_t*)(ws + WS_WDN + (size_t)(l * 2 + j) * SZ_WDN), 0, scr, r, lane); continue; } r -= 2 * I_DN;
        if (r < I_IN) { transpose_item(a.w_in + (size_t)l * D * INCOLS, D, INCOLS, (bf16_t*)(ws + WS_WIN + (size_t)l * SZ_WIN), 0, scr, r, lane); continue; } r -= I_IN;
        if (r < I_BP) { transpose_item(a.w_bp + (size_t)l * PW * D, PW, D, (bf16_t*)(ws + WS_WBP + (size_t)l * D * PW * 2), 0, scr, r, lane); continue; } r -= I_BP;
        if (r < I_BH) { transpose_item(a.w_bh + (size_t)l * HW * D, HW, D, (bf16_t*)(ws + WS_WBH + (size_t)l * D * HW * 2), 0, scr, r, lane); continue; } r -= I_BH;
        if (r < I_BH) { transpose_item(a.w_bd + (size_t)l * DW * D, DW, D, (bf16_t*)(ws + WS_WBD + (size_t)l * D * DW * 2), 0, scr, r, lane); continue; } r -= I_BH;
        transpose_item(a.w_out + (size_t)l * D * D, D, D, (bf16_t*)(ws + WS_WO + (size_t)l * D * D * 2), 0, scr, r, lane);
    }
    float* H = (float*)(ws + WS_H); bf16_t* HB = (bf16_t*)(ws + WS_HB);
    for (int r = gw; r < MP; r += NGW) {
        const float* src = nullptr;
        if (r < T) { const int b = r / L, t = r % L; src = t < NMETA ? a.meta + (size_t)t * D : a.x + ((size_t)b * SEQ + (t - NMETA)) * D; }
#pragma unroll
        for (int j = 0; j < 8; ++j) {
            f32x4 v = src ? *(const f32x4*)(src + 4 * lane + 256 * j) : (f32x4){0.f, 0.f, 0.f, 0.f};
            *(f32x4*)(H + (size_t)r * D + 4 * lane + 256 * j) = v;
            u32x2 w; w.x = pk2(v[0], v[1]); w.y = pk2(v[2], v[3]);
            *(u32x2*)(HB + (size_t)r * D + 4 * lane + 256 * j) = w;
        }
    }
    for (int i = gw; i < NB * (LP - L) * 2; i += NGW) {
        const int seg = i / (NB * (LP - L)), rr = i % (NB * (LP - L)), b = rr / (LP - L), t = L + rr % (LP - L);
        bf16_t* base = (bf16_t*)(ws + WS_QA + (size_t)seg * (WS_KA - WS_QA)) + (size_t)(b * LP + t) * 768;
        for (int c = lane; c < 768 / 8; c += 64) *(u32x4*)(base + 8 * c) = (u32x4){0u, 0u, 0u, 0u};
    }
    for (int i = gw; i < NB * 768; i += NGW) {
        bf16_t* base = (bf16_t*)(ws + WS_VA) + (size_t)i * LP + L;
        for (int c = lane; c < (LP - L) / 8; c += 64) *(u32x4*)(base + 8 * c) = (u32x4){0u, 0u, 0u, 0u};
    }
}

__device__ __forceinline__ void ln_rows(int lnidx, bool final_, int r_begin, int r_end, int gw, int NGW, int lane) {
    const Args a = *argp(); const float* g = a.ln_g + (size_t)lnidx * D; const float* bvec = a.ln_b + (size_t)lnidx * D;
    const float* PRE = (const float*)(a.ws + WS_PRE); float* H = (float*)(a.ws + WS_H); bf16_t* HB = (bf16_t*)(a.ws + WS_HB);
    for (int r = r_begin + gw; r < r_end; r += NGW) {
        f32x4 v[8]; float s = 0.f;
#pragma unroll
        for (int j = 0; j < 8; ++j) { v[j] = *(const f32x4*)(PRE + (size_t)r * D + 4 * lane + 256 * j); s += (v[j][0] + v[j][1]) + (v[j][2] + v[j][3]); }
        const float mean = wave_sum(s) * (1.f / D); float s2 = 0.f;
#pragma unroll
        for (int j = 0; j < 8; ++j) { v[j] = v[j] - mean; s2 += (v[j][0] * v[j][0] + v[j][1] * v[j][1]) + (v[j][2] * v[j][2] + v[j][3] * v[j][3]); }
        const float rstd = 1.f / sqrtf(wave_sum(s2) * (1.f / D) + LN_EPS);
        if (final_) {
            const int b = r / L, t = r % L;
            if (t >= NMETA) {
                float* o = a.out + ((size_t)b * SEQ + (t - NMETA)) * D;
#pragma unroll
                for (int j = 0; j < 8; ++j) { const f32x4 gg = *(const f32x4*)(g + 4 * lane + 256 * j), bb = *(const f32x4*)(bvec + 4 * lane + 256 * j); *(f32x4*)(o + 4 * lane + 256 * j) = v[j] * rstd * gg + bb; }
            }
        } else {
#pragma unroll
            for (int j = 0; j < 8; ++j) { const f32x4 gg = *(const f32x4*)(g + 4 * lane + 256 * j), bb = *(const f32x4*)(bvec + 4 * lane + 256 * j); const f32x4 o = v[j] * rstd * gg + bb;
                *(f32x4*)(H + (size_t)r * D + 4 * lane + 256 * j) = o; u32x2 w; w.x = pk2(o[0], o[1]); w.y = pk2(o[2], o[3]); *(u32x2*)(HB + (size_t)r * D + 4 * lane + 256 * j) = w; }
        }
    }
}

__device__ __forceinline__ void pool_phase(int l, unsigned char* lds_g, int blk, int nblk) {
    const Args a = *argp();
    const float* ZP = (const float*)(a.ws + WS_ZP); bf16_t* YP = (bf16_t*)(a.ws + WS_YP);
    constexpr int WP = 136;
    bf16_t* WT = (bf16_t*)lds_g;
    bf16_t* Pb = WT + 128 * WP;
    float* U = (float*)(lds_g + 53248);
    const int tid = opq_v((int)threadIdx.x), lane = tid & 63, wid = tid >> 6, r32 = lane & 31, hi = lane >> 5;
    const int g = blk & 3, bi = blk >> 2, nb = nblk >> 2, w = 2 << g;
    const float* Wg = a.pool_w + ((size_t)l * 4 + g) * 128 * 128;
    for (int i = tid; i < 128 * 32; i += 512) { const int c = i >> 5, d4 = i & 31; const f32x4 v = *(const f32x4*)(Wg + c * 128 + 4 * d4);
        WT[(4 * d4 + 0) * WP + c] = (bf16_t)f2bf(v[0]); WT[(4 * d4 + 1) * WP + c] = (bf16_t)f2bf(v[1]); WT[(4 * d4 + 2) * WP + c] = (bf16_t)f2bf(v[2]); WT[(4 * d4 + 3) * WP + c] = (bf16_t)f2bf(v[3]); }
    const int dt = wid & 3, tt = wid >> 2;
    const float scv = a.pool_scale[l * PW + g * 128 + 32 * dt + r32];
    constexpr int TPB = (L + 63) / 64;
    for (int tile = bi; tile < NB * TPB; tile += nb) {
        const int b = tile / TPB, t0 = (tile % TPB) * 64;
        __syncthreads();
        for (int i = tid; i < 79 * 32; i += 512) { const int rr = i >> 5, c4 = i & 31, t = t0 - 15 + rr;
            ((f32x4*)U)[i] = (t >= 0 && t < L) ? *(const f32x4*)(ZP + (size_t)(b * L + t) * PW + g * 128 + 4 * c4) : (f32x4){0.f, 0.f, 0.f, 0.f}; }
        __syncthreads();
        { const int c = tid & 127, ts = (tid >> 7) * 16;
            float s_ = 0.f;
            for (int q = 1; q < w; ++q) { const int t = t0 + ts - q; if (t >= 0) s_ += U[(ts - q + 15) * 128 + c]; }
            for (int k = 0; k < 16; ++k) { const int ti = ts + k, t = t0 + ti; const float ut = U[(ti + 15) * 128 + c]; s_ += ut;
                const int cnt = (t + 1) < w ? (t + 1) : w;
                Pb[ti * WP + c] = (bf16_t)f2bf(s_ / (float)cnt - ut);
                if (t + 1 - w >= 0) s_ -= U[(ti + 15 - w + 1) * 128 + c]; } }
        __syncthreads();
        f32x16_t acc = (f32x16_t){0.f, 0.f, 0.f, 0.f, 0.f, 0.f, 0.f, 0.f, 0.f, 0.f, 0.f, 0.f, 0.f, 0.f, 0.f, 0.f};
#pragma unroll
        for (int i = 0; i < 8; ++i) { const bf16x8 av = *(const bf16x8*)(Pb + (32 * tt + r32) * WP + 16 * i + 8 * hi), bv = *(const bf16x8*)(WT + (32 * dt + r32) * WP + 16 * i + 8 * hi);
            acc = __builtin_amdgcn_mfma_f32_32x32x16_bf16(av, bv, acc, 0, 0, 0); }
#pragma unroll
        for (int r = 0; r < 16; ++r) { const int t = t0 + 32 * tt + (r & 3) + 8 * (r >> 2) + 4 * hi;
            if (t < L) YP[(size_t)(b * L + t) * PW + g * 128 + 32 * dt + r32] = (bf16_t)f2bf(acc[r] * scv); }
    }
    __syncthreads();
}

__device__ __forceinline__ void hgrn_naive(int l, unsigned char* lds_g, int blk) {
    const Args a = *argp();
    const float* ZH = (const float*)(a.ws + WS_ZH); float* OH = (float*)(a.ws + WS_OH);
    const int tid = opq_v((int)threadIdx.x), ch = tid >> 8, j = tid & 127, kh = (tid >> 7) & 1, chain = blk * 2 + ch, b = chain / 6, h = chain % 6;
    float* sh = (float*)lds_g + ch * 640;
    float lb = 0.f;
    if (l == 1) { const float x0 = a.hgrn_lb[h * 128 + j], x1 = a.hgrn_lb[HW + h * 128 + j]; const float e0 = __expf(x0), e1 = __expf(x1); lb = e1 / (e0 + e1); }
    float S[64];
#pragma unroll
    for (int k = 0; k < 64; ++k) S[k] = 0.f;
    for (int t = 0; t < L; ++t) {
        const float* z = ZH + (size_t)(b * L + t) * 3072 + h * 128;
        if (kh == 0) { const float fz = z[768 + j], f = lb + (1.f - lb) * (1.f / (1.f + __expf(-fz))); sh[j] = f; sh[128 + j] = 1.f - f; sh[256 + j] = z[j]; }
        const float vj = z[1536 + j];
        __syncthreads();
        float o = 0.f;
#pragma unroll
        for (int k4 = 0; k4 < 16; ++k4) {
            const f32x4 f4 = *(const f32x4*)(sh + kh * 64 + 4 * k4), k4v = *(const f32x4*)(sh + 128 + kh * 64 + 4 * k4), q4 = *(const f32x4*)(sh + 256 + kh * 64 + 4 * k4);
#pragma unroll
            for (int e = 0; e < 4; ++e) { S[4 * k4 + e] = f4[e] * S[4 * k4 + e] + k4v[e] * vj; o += q4[e] * S[4 * k4 + e]; }
        }
        sh[384 + kh * 128 + j] = o;
        __syncthreads();
        if (kh == 0) OH[(size_t)(b * L + t) * HW + h * 128 + j] = (sh[384 + j] + sh[512 + j]) * 0.08838834764831845f;
    }
}

__device__ __forceinline__ void attn_naive(int blk, int nblk) {
    const Args a = *argp();
    const bf16_t* QA = (const bf16_t*)(a.ws + WS_QA); const bf16_t* KA = (const bf16_t*)(a.ws + WS_KA); const bf16_t* VA = (const bf16_t*)(a.ws + WS_VA);
    float* OD = (float*)(a.ws + WS_OD);
    const int tid = opq_v((int)threadIdx.x), wid = tid >> 6;
    for (int unit = blk; unit < NB * 12 * 4 * 9; unit += nblk) {
        const int qc = unit % 9, vq = (unit / 9) & 3, vh = (unit / 36) % 12, b = unit / 432, h = vh >> 1;
        const int q = qc * 512 + tid; const int qq = q < L ? q : L - 1;
        float qf[64];
        { const bf16_t* qp = QA + (size_t)(b * LP + qq) * 768 + vh * 64;
#pragma unroll
            for (int i = 0; i < 8; ++i) { const u32x4 w = *(const u32x4*)(qp + 8 * i); qf[8 * i] = bflo(w.x); qf[8 * i + 1] = bfhi(w.x); qf[8 * i + 2] = bflo(w.y); qf[8 * i + 3] = bfhi(w.y); qf[8 * i + 4] = bflo(w.z); qf[8 * i + 5] = bfhi(w.z); qf[8 * i + 6] = bflo(w.w); qf[8 * i + 7] = bfhi(w.w); } }
        int kmax = qc * 512 + wid * 64 + 63; if (kmax > L - 1) kmax = L - 1;
        kmax = __builtin_amdgcn_readfirstlane(kmax);
        float mx = -INFINITY, lsum = 0.f, o[32];
#pragma unroll
        for (int i = 0; i < 32; ++i) o[i] = 0.f;
        for (int key = 0; key <= kmax; ++key) {
            const bf16_t* kp = KA + (size_t)(b * LP + key) * 768 + vh * 64;
            float s = 0.f;
#pragma unroll
            for (int i = 0; i < 8; ++i) { const u32x4 w = *(const u32x4*)(kp + 8 * i);
                s += qf[8 * i] * bflo(w.x) + qf[8 * i + 1] * bfhi(w.x) + qf[8 * i + 2] * bflo(w.y) + qf[8 * i + 3] * bfhi(w.y) + qf[8 * i + 4] * bflo(w.z) + qf[8 * i + 5] * bfhi(w.z) + qf[8 * i + 6] * bflo(w.w) + qf[8 * i + 7] * bfhi(w.w); }
            if (key <= qq) {
                const float mn = fmaxf(mx, s), al_ = __builtin_amdgcn_exp2f(mx - mn), p = __builtin_amdgcn_exp2f(s - mn);
                lsum = lsum * al_ + p; mx = mn;
                const bf16_t* vp = VA + (size_t)(b * LP + key) * 768 + h * 128 + vq * 32;
#pragma unroll
                for (int i = 0; i < 4; ++i) { const u32x4 w = *(const u32x4*)(vp + 8 * i);
                    o[8 * i] = o[8 * i] * al_ + p * bflo(w.x); o[8 * i + 1] = o[8 * i + 1] * al_ + p * bfhi(w.x); o[8 * i + 2] = o[8 * i + 2] * al_ + p * bflo(w.y); o[8 * i + 3] = o[8 * i + 3] * al_ + p * bfhi(w.y);
                    o[8 * i + 4] = o[8 * i + 4] * al_ + p * bflo(w.z); o[8 * i + 5] = o[8 * i + 5] * al_ + p * bfhi(w.z); o[8 * i + 6] = o[8 * i + 6] * al_ + p * bflo(w.w); o[8 * i + 7] = o[8 * i + 7] * al_ + p * bfhi(w.w); }
            }
        }
        if (q < L) { const float rl = 1.f / lsum; float* op = OD + ((size_t)(b * LP + q) * 12 + vh) * 128 + vq * 32;
#pragma unroll
            for (int i = 0; i < 8; ++i) *(f32x4*)(op + 4 * i) = (f32x4){o[4 * i] * rl, o[4 * i + 1] * rl, o[4 * i + 2] * rl, o[4 * i + 3] * rl}; }
    }
}


constexpr int HC = 32, HNC = (L + HC - 1) / HC;
constexpr int HR_QP = 136  , HR_Q = 0, HR_K = HC * HR_QP * 2  , HR_A = HR_K + 128 * HC * 2  , HR_D = HR_A + HC * HC * 2  , HR_SH = HR_D + 512  ;
constexpr int HR_V = HR_SH, HR_VH = 64 * HC * 2  , HR_BYTES = HR_SH + 2 * HR_VH  , HS_BYTES = HR_SH + HR_VH  ;
constexpr int HG_NS = 4;
constexpr size_t WS_REC = WS_END_HG;
constexpr size_t WS_END2 = WS_REC + (size_t)12 * 257 * 14336;
constexpr size_t WS_XB = WS_END2, WS_END3 = WS_XB + (size_t)8192 * 8 * 8;
static_assert(12 * HNC * HR_BYTES <= 12 * 257 * 14336 && HG_NS * HS_BYTES + 16384 <= 131072 && HR_SH % 1024 == 0, "hgrn record / ring / output staging");

__device__ __forceinline__ void hgrn_pre(int l, unsigned char* lds_g, int blk, int nblk) {
    const Args a = *argp();
    const float* ZH = (const float*)(a.ws + WS_ZH); unsigned char* REC = a.ws + WS_REC;
    const int tid = opq_v((int)threadIdx.x);
    constexpr int HP = 132;
    float* lf = (float*)lds_g; float* kk = lf + HC * HP; float* qs = kk + HC * HP; float* bc = qs + HC * HP; float* vv = bc + HC * HP;
    for (int rec = blk; rec < 12 * HNC; rec += nblk) {
        const int bh = rec / HNC, c = rec % HNC, b = bh / 6, h = bh % 6;
        const size_t r0 = (size_t)b * L + HC * c;
        float lb = 0.f;
        if (l == 1) { const int k = tid & 127; const float x0 = a.hgrn_lb[h * 128 + k], x1 = a.hgrn_lb[HW + h * 128 + k]; const float e0 = __expf(x0), e1 = __expf(x1); lb = e1 / (e0 + e1); }
        for (int idx = tid; idx < HC * 128; idx += 512) {
            const int t = idx >> 7, k = idx & 127;
            float lfv = 0.f, kv = 0.f, qv = 0.f, vvv = 0.f;
            if (HC * c + t < L) {
                const float* z = ZH + (r0 + t) * 3072 + h * 128 + k;
                const float f = lb + (1.f - lb) * (1.f / (1.f + __expf(-z[768])));
                lfv = __logf(f); kv = 1.f - f; qv = z[0] * 0.08838834764831845f; vvv = bf2f(((const bf16_t*)(a.ws + WS_HV))[(r0 + t) * HW + h * 128 + k]);
            }
            lf[t * HP + k] = lfv; kk[t * HP + k] = kv; qs[t * HP + k] = qv; vv[t * HP + k] = vvv;
        }
        __syncthreads();
        if (tid < 128) { float cv[HC];
#pragma unroll
            for (int t = 0; t < HC; ++t) cv[t] = lf[t * HP + tid];
            float run = 0.f;
#pragma unroll
            for (int t = 0; t < HC; ++t) { run += cv[t]; bc[t * HP + tid] = run; } }
        __syncthreads();
        unsigned char* R = REC + (size_t)rec * HR_BYTES;
        for (int idx = tid; idx < HC * 128; idx += 512) {
            { const int t = idx >> 7, k = idx & 127; ((bf16_t*)(R + HR_Q))[t * HR_QP + k] = (bf16_t)f2bf(qs[t * HP + k] * __expf(bc[t * HP + k])); }
            { const int k = idx >> 5, s_ = idx & 31; ((bf16_t*)(R + HR_K))[idx] = (bf16_t)f2bf(kk[s_ * HP + k] * __expf(bc[(HC - 1) * HP + k] - bc[s_ * HP + k]));
              ((bf16_t*)(R + HR_V))[idx] = (bf16_t)f2bf(vv[s_ * HP + k]); }
        }
        if (tid < 128) ((float*)(R + HR_D))[tid] = __expf(bc[(HC - 1) * HP + tid]);
#pragma unroll
        for (int e = 0; e < 2; ++e) { const int p = tid + 512 * e, t = p >> 5, s_ = p & 31; float acc = 0.f;
            if (s_ <= t) {
#pragma unroll 2
                for (int k = 0; k < 128; k += 4) { const f32x4 q4 = *(const f32x4*)(qs + t * HP + k), k4 = *(const f32x4*)(kk + s_ * HP + k), bt = *(const f32x4*)(bc + t * HP + k), bs = *(const f32x4*)(bc + s_ * HP + k);
                    acc += q4[0] * k4[0] * __expf(bt[0] - bs[0]) + q4[1] * k4[1] * __expf(bt[1] - bs[1]) + q4[2] * k4[2] * __expf(bt[2] - bs[2]) + q4[3] * k4[3] * __expf(bt[3] - bs[3]); } }
            ((bf16_t*)(R + HR_A))[p] = (bf16_t)f2bf(acc); }
        __syncthreads();
    }
}

__device__ __forceinline__ void hgrn_scan(int bh, int vhalf, LAS unsigned char* ldsl) {
    const Args a = *argp();
    const unsigned char* REC = a.ws + WS_REC + (size_t)bh * HNC * HR_BYTES; float* OH = (float*)(a.ws + WS_OH);
    const int tid = opq_v((int)threadIdx.x), lane = tid & 63, wid = __builtin_amdgcn_readfirstlane(tid >> 6), n = lane & 15, g = lane >> 4;
    const int b = bh / 6, h = bh % 6;
    const bool loader = wid < 4 || wid >= 6; const int li = wid < 4 ? wid : wid - 2; const bool four = loader && li < 5;
    LAS unsigned char* OST = ldsl + HG_NS * HS_BYTES;
#define HG_PIECE(q_) do { const int pb_ = 384 * (q_) + 64 * li;   \
        const unsigned char* s_ = (pb_ < 1216 ? rsrc_ + (size_t)pb_ * 16 : rsrc_ + HR_SH + HR_VH * vhalf + (size_t)(pb_ - 1216) * 16) + lane * 16; \
        __builtin_amdgcn_global_load_lds((const unsigned*)s_, (LAS unsigned*)(rdst_ + pb_ * 16), 16, 0, 0); } while (0)
#define HG_DMA(cc) do { if (loader) { const int c_ = (cc) < HNC ? (cc) : HNC - 1; const unsigned char* rsrc_ = REC + (size_t)c_ * HR_BYTES; LAS unsigned char* rdst_ = ldsl + ((cc) % HG_NS) * HS_BYTES; \
        HG_PIECE(0); HG_PIECE(1); HG_PIECE(2); if (four) HG_PIECE(3); } } while (0)
#define HG_OUT(ss) do { const LAS float* src_ = (const LAS float*)(OST + ((ss) & 1) * 8192); const int e_ = (wid - 4) * 64 + lane; \
        _Pragma("unroll") for (int q_ = 0; q_ < 4; ++q_) { const int idx_ = e_ + 128 * q_, t_ = idx_ >> 4, c4_ = idx_ & 15;    \
            if (HC * (ss) + t_ < L) { const f32x4 v_ = *(const LAS f32x4*)(src_ + (c4_ >> 2) * 512 + t_ * 16 + (c4_ & 3) * 4); \
                u32x2 w_; w_.x = pg8::cvt_pk_bf16(v_[0], v_[1]); w_.y = pg8::cvt_pk_bf16(v_[2], v_[3]);                    \
                *(u32x2*)((bf16_t*)OH + ((size_t)b * L + HC * (ss) + t_) * HW + h * 128 + 64 * vhalf + 4 * c4_) = w_; } } } while (0)
    f32x4 S[8];
#pragma unroll
    for (int i = 0; i < 8; ++i) S[i] = (f32x4){0.f, 0.f, 0.f, 0.f};
    for (int c = 0; c < HG_NS - 1; ++c) HG_DMA(c);
    for (int s_ = 0; s_ < HNC; ++s_) {
        if (four) asm volatile("s_waitcnt vmcnt(8)" ::: "memory"); else if (loader) asm volatile("s_waitcnt vmcnt(6)" ::: "memory");
        asm volatile("s_waitcnt lgkmcnt(0)" ::: "memory");
        __builtin_amdgcn_s_barrier();
        asm volatile("" ::: "memory");
        const LAS unsigned char* R = ldsl + (s_ % HG_NS) * HS_BYTES;
        if ((wid == 4 || wid == 5) && s_ > 0) HG_OUT(s_ - 1);
        if (wid < 4) {
            s16x4 qa0[2][4], qa1[2][4]; bf16x8 at[2], ka[8], vb; f32x4 dv[8];
#pragma unroll
            for (int mt = 0; mt < 2; ++mt)
#pragma unroll
                for (int kb = 0; kb < 4; ++kb) { qa0[mt][kb] = *(const LAS s16x4*)(R + HR_Q + ((16 * mt + n) * HR_QP + 32 * kb + 4 * g) * 2); qa1[mt][kb] = *(const LAS s16x4*)(R + HR_Q + ((16 * mt + n) * HR_QP + 32 * kb + 16 + 4 * g) * 2); }
            vb = *(const LAS bf16x8*)(R + HR_SH + ((16 * wid + n) * HC + 8 * g) * 2);
#pragma unroll
            for (int mt = 0; mt < 2; ++mt) at[mt] = *(const LAS bf16x8*)(R + HR_A + ((16 * mt + n) * HC + 8 * g) * 2);
#pragma unroll
            for (int kt = 0; kt < 8; ++kt) { ka[kt] = *(const LAS bf16x8*)(R + HR_K + ((16 * kt + n) * HC + 8 * g) * 2); dv[kt] = *(const LAS f32x4*)(R + HR_D + (16 * kt + 4 * g) * 4); }
            asm volatile("s_waitcnt lgkmcnt(0)" ::: "memory");
            __builtin_amdgcn_sched_barrier(0);
            f32x4 o0 = (f32x4){0.f, 0.f, 0.f, 0.f}, o1 = o0;
            o0 = __builtin_amdgcn_mfma_f32_16x16x32_bf16(at[0], vb, o0, 0, 0, 0);
            o1 = __builtin_amdgcn_mfma_f32_16x16x32_bf16(at[1], vb, o1, 0, 0, 0);
#pragma unroll
            for (int kb = 0; kb < 4; ++kb) {
                u32x4 w; w.x = pg8::cvt_pk_bf16(S[2 * kb][0], S[2 * kb][1]); w.y = pg8::cvt_pk_bf16(S[2 * kb][2], S[2 * kb][3]); w.z = pg8::cvt_pk_bf16(S[2 * kb + 1][0], S[2 * kb + 1][1]); w.w = pg8::cvt_pk_bf16(S[2 * kb + 1][2], S[2 * kb + 1][3]);
                const bf16x8 sb = __builtin_bit_cast(bf16x8, w);
                const bf16x8 q0 = (bf16x8){qa0[0][kb][0], qa0[0][kb][1], qa0[0][kb][2], qa0[0][kb][3], qa1[0][kb][0], qa1[0][kb][1], qa1[0][kb][2], qa1[0][kb][3]};
                const bf16x8 q1 = (bf16x8){qa0[1][kb][0], qa0[1][kb][1], qa0[1][kb][2], qa0[1][kb][3], qa1[1][kb][0], qa1[1][kb][1], qa1[1][kb][2], qa1[1][kb][3]};
                o0 = __builtin_amdgcn_mfma_f32_16x16x32_bf16(q0, sb, o0, 0, 0, 0);
                o1 = __builtin_amdgcn_mfma_f32_16x16x32_bf16(q1, sb, o1, 0, 0, 0);
            }
#pragma unroll
            for (int kt = 0; kt < 8; ++kt) S[kt] = __builtin_amdgcn_mfma_f32_16x16x32_bf16(ka[kt], vb, S[kt] * dv[kt], 0, 0, 0);
            { LAS float* st = (LAS float*)(OST + (s_ & 1) * 8192) + wid * 512 + (4 * g) * 16 + n;
#pragma unroll
                for (int jj = 0; jj < 4; ++jj) { st[jj * 16] = o0[jj]; st[256 + jj * 16] = o1[jj]; } }
        }
        HG_DMA(s_ + HG_NS - 1);
    }
    asm volatile("s_waitcnt vmcnt(0) lgkmcnt(0)" ::: "memory");
    __builtin_amdgcn_s_barrier();
    asm volatile("" ::: "memory");
    if (wid == 4 || wid == 5) HG_OUT(HNC - 1);
    asm volatile("s_waitcnt vmcnt(0) lgkmcnt(0)" ::: "memory");
    __builtin_amdgcn_s_barrier();
#undef HG_PIECE
#undef HG_DMA
#undef HG_OUT
}

typedef float f32x16 __attribute__((ext_vector_type(16)));
constexpr int AT_KP = 72, AT_VP = 68;
constexpr int AT_KB = 64 * AT_KP * 2, AT_VB = 128 * AT_VP * 2, AT_BUF = AT_KB + AT_VB;
__device__ __forceinline__ int crow(int r, int hi) { return (r & 3) + 8 * (r >> 2) + 4 * hi; }
__device__ __forceinline__ void attn_phase(int l, unsigned char* lds_g, LAS unsigned char* ldsl, unsigned* qctr, int nunits_hg) {
    const Args a = *argp();
    const bf16_t* QA = (const bf16_t*)(a.ws + WS_QA); const bf16_t* KA = (const bf16_t*)(a.ws + WS_KA); const bf16_t* VA = (const bf16_t*)(a.ws + WS_VA);
    float* OD = (float*)(a.ws + WS_OD);
    const int tid = opq_v((int)threadIdx.x), lane = tid & 63, wid = __builtin_amdgcn_readfirstlane(tid >> 6), r32 = lane & 31, hi = lane >> 5;
    int* sh_u = (int*)(lds_g + 131072 + 64);
    for (;;) {
        __syncthreads();
        if (tid == 0) *sh_u = (int)atomicAdd(qctr, 1u);
        __syncthreads();
        const int u = *sh_u - nunits_hg;
        if (u >= NB * 12 * 17) break;
        if (u < 0) { const int hu = u + nunits_hg; hgrn_scan(hu >> 1, hu & 1, ldsl); continue; }
        const int qb = 16 - u / 24, bv = u % 24, b = bv / 12, vh = bv % 12, h = vh >> 1;
        const int q0 = qb * 256, NT = (q0 + 256) / 64;
        const int qw = q0 + wid * 32;
        const bf16_t* Kb = KA + (size_t)b * LP * 768 + vh * 64; const bf16_t* Vb = VA + ((size_t)b * 768 + h * 128) * LP;
        bf16x8 qr[4];
#pragma unroll
        for (int i = 0; i < 4; ++i) qr[i] = *(const bf16x8*)(QA + (size_t)(b * LP + qw + r32) * 768 + vh * 64 + 16 * i + 8 * hi);
        f32x16 o[4];
#pragma unroll
        for (int d = 0; d < 4; ++d) o[d] = (f32x16){0.f, 0.f, 0.f, 0.f, 0.f, 0.f, 0.f, 0.f, 0.f, 0.f, 0.f, 0.f, 0.f, 0.f, 0.f, 0.f};
        float mrun = -INFINITY, lrun = 0.f;
        const int kr = tid >> 3, kc = tid & 7;
        u32x4 kreg0, vreg00, vreg01, kreg1, vreg10, vreg11, kreg2, vreg20, vreg21, kreg3, vreg30, vreg31;
#define AT_LOAD(t, KR, V0, V1) do { KR = *(const u32x4*)(Kb + (size_t)((t) * 64 + kr) * 768 + kc * 8); \
            V0 = *(const u32x4*)(Vb + (size_t)kr * LP + (t) * 64 + kc * 8); V1 = *(const u32x4*)(Vb + (size_t)(64 + kr) * LP + (t) * 64 + kc * 8); } while (0)
#define AT_STORE(buf, KR, V0, V1) do { unsigned char* B_ = lds_g + (buf) * AT_BUF; *(u32x4*)(B_ + (kr * AT_KP + kc * 8) * 2) = KR; \
            *(u32x2*)(B_ + AT_KB + (kr * AT_VP + kc * 8) * 2) = (u32x2){V0.x, V0.y}; *(u32x2*)(B_ + AT_KB + (kr * AT_VP + kc * 8 + 4) * 2) = (u32x2){V0.z, V0.w}; \
            *(u32x2*)(B_ + AT_KB + ((64 + kr) * AT_VP + kc * 8) * 2) = (u32x2){V1.x, V1.y}; *(u32x2*)(B_ + AT_KB + ((64 + kr) * AT_VP + kc * 8 + 4) * 2) = (u32x2){V1.z, V1.w}; } while (0)
#define AT_TILE(t) do { \
            if ((t) * 64 <= qw + 31 && qw < L) {                 \
                const unsigned char* Bc = lds_g + ((t) & 1) * AT_BUF; \
                const float nm_ = mrun == -INFINITY ? 0.f : -mrun;     \
                f32x16 p0 = (f32x16){nm_, nm_, nm_, nm_, nm_, nm_, nm_, nm_, nm_, nm_, nm_, nm_, nm_, nm_, nm_, nm_}, p1 = p0; \
                _Pragma("unroll") for (int i2 = 0; i2 < 2; ++i2) { bf16x8 kf0[2], kf1[2];     \
                  _Pragma("unroll") for (int i = 0; i < 2; ++i) { kf0[i] = *(const bf16x8*)(Bc + (r32 * AT_KP + 16 * (2 * i2 + i) + 8 * hi) * 2); kf1[i] = *(const bf16x8*)(Bc + ((32 + r32) * AT_KP + 16 * (2 * i2 + i) + 8 * hi) * 2); } \
                  asm volatile("s_waitcnt lgkmcnt(0)" ::: "memory"); __builtin_amdgcn_sched_barrier(0); \
                  _Pragma("unroll") for (int i = 0; i < 2; ++i) { p0 = __builtin_amdgcn_mfma_f32_32x32x16_bf16(kf0[i], qr[2 * i2 + i], p0, 0, 0, 0); p1 = __builtin_amdgcn_mfma_f32_32x32x16_bf16(kf1[i], qr[2 * i2 + i], p1, 0, 0, 0); } } \
                if ((t) * 64 + 63 > qw) {                        \
                    const int qa = qw + r32, kb0 = (t) * 64 + 4 * hi; \
                    _Pragma("unroll") for (int r = 0; r < 16; ++r) { const int kv = kb0 + (r & 3) + 8 * (r >> 2); if (kv > qa) p0[r] = -INFINITY; if (kv + 32 > qa) p1[r] = -INFINITY; } } \
                float rm = fmaxf(p0[0], p1[0]); \
                _Pragma("unroll") for (int r = 1; r < 16; ++r) rm = fmaxf(rm, fmaxf(p0[r], p1[r])); \
                rm = fmaxf(rm, __shfl_xor(rm, 32)); \
                if (__any(rm > 8.0f || mrun == -INFINITY)) {   \
                    const float dl_ = mrun == -INFINITY ? rm : fmaxf(rm, 0.f), al_ = mrun == -INFINITY ? 0.f : __builtin_amdgcn_exp2f(-dl_); \
                    mrun = (mrun == -INFINITY ? 0.f : mrun) + dl_; lrun *= al_; \
                    _Pragma("unroll") for (int r = 0; r < 16; ++r) { p0[r] -= dl_; p1[r] -= dl_; } \
                    _Pragma("unroll") for (int d = 0; d < 4; ++d) _Pragma("unroll") for (int r = 0; r < 16; ++r) o[d][r] *= al_; } \
                _Pragma("unroll") for (int r = 0; r < 16; ++r) { p0[r] = __builtin_amdgcn_exp2f(p0[r]); p1[r] = __builtin_amdgcn_exp2f(p1[r]); } \
                { const f32x16 sm_ = p0 + p1; const f32x4 s4_ = (f32x4){sm_[0], sm_[1], sm_[2], sm_[3]} + (f32x4){sm_[4], sm_[5], sm_[6], sm_[7]} + (f32x4){sm_[8], sm_[9], sm_[10], sm_[11]} + (f32x4){sm_[12], sm_[13], sm_[14], sm_[15]}; \
                  lrun += (s4_[0] + s4_[1]) + (s4_[2] + s4_[3]); } \
                bf16x8 pb[4]; \
                _Pragma("unroll") for (int jj = 0; jj < 4; ++jj) { u32x4 w; \
                    if (jj < 2) { w.x = pg8::cvt_pk_bf16(p0[8 * jj], p0[8 * jj + 1]); w.y = pg8::cvt_pk_bf16(p0[8 * jj + 2], p0[8 * jj + 3]); w.z = pg8::cvt_pk_bf16(p0[8 * jj + 4], p0[8 * jj + 5]); w.w = pg8::cvt_pk_bf16(p0[8 * jj + 6], p0[8 * jj + 7]); } \
                    else { const int j2 = jj - 2; w.x = pg8::cvt_pk_bf16(p1[8 * j2], p1[8 * j2 + 1]); w.y = pg8::cvt_pk_bf16(p1[8 * j2 + 2], p1[8 * j2 + 3]); w.z = pg8::cvt_pk_bf16(p1[8 * j2 + 4], p1[8 * j2 + 5]); w.w = pg8::cvt_pk_bf16(p1[8 * j2 + 6], p1[8 * j2 + 7]); } \
                    pb[jj] = __builtin_bit_cast(bf16x8, w); } \
                const unsigned char* Vc = Bc + AT_KB; \
                _Pragma("unroll") for (int d = 0; d < 4; ++d) { s16x4 vl[4], vh[4];     \
                      _Pragma("unroll") for (int jj = 0; jj < 4; ++jj) { vl[jj] = *(const s16x4*)(Vc + ((d * 32 + r32) * AT_VP + 16 * jj + 4 * hi) * 2); vh[jj] = *(const s16x4*)(Vc + ((d * 32 + r32) * AT_VP + 16 * jj + 8 + 4 * hi) * 2); } \
                      asm volatile("s_waitcnt lgkmcnt(0)" ::: "memory"); __builtin_amdgcn_sched_barrier(0); \
                      _Pragma("unroll") for (int jj = 0; jj < 4; ++jj) { const bf16x8 va = (bf16x8){vl[jj][0], vl[jj][1], vl[jj][2], vl[jj][3], vh[jj][0], vh[jj][1], vh[jj][2], vh[jj][3]}; \
                          o[d] = __builtin_amdgcn_mfma_f32_32x32x16_bf16(va, pb[jj], o[d], 0, 0, 0); } } \
            } } while (0)
        AT_LOAD(0, kreg0, vreg00, vreg01); AT_STORE(0, kreg0, vreg00, vreg01);
        AT_LOAD(1, kreg1, vreg10, vreg11); AT_LOAD(2, kreg2, vreg20, vreg21); AT_LOAD(3, kreg3, vreg30, vreg31);
        __syncthreads();
        for (int t = 0; t < NT; t += 4) {
            if (t + 4 < NT) AT_LOAD(t + 4, kreg0, vreg00, vreg01);
            AT_TILE(t);
            AT_STORE(1, kreg1, vreg10, vreg11);
            __syncthreads();
            if (t + 5 < NT) AT_LOAD(t + 5, kreg1, vreg10, vreg11);
            AT_TILE(t + 1);
            AT_STORE(0, kreg2, vreg20, vreg21);
            __syncthreads();
            if (t + 6 < NT) AT_LOAD(t + 6, kreg2, vreg20, vreg21);
            AT_TILE(t + 2);
            AT_STORE(1, kreg3, vreg30, vreg31);
            __syncthreads();
            if (t + 7 < NT) AT_LOAD(t + 7, kreg3, vreg30, vreg31);
            AT_TILE(t + 3);
            if (t + 4 < NT) AT_STORE(0, kreg0, vreg00, vreg01);
            __syncthreads();
        }
#undef AT_TILE
#undef AT_LOAD
#undef AT_STORE
        const float lt = lrun + __shfl_xor(lrun, 32), rl = 1.0f / lt;
        const int qa = qw + r32;
        if (qa < L) {
            bf16_t* op = (bf16_t*)OD + ((size_t)(b * LP + qa) * 12 + vh) * 128;
#pragma unroll
            for (int d = 0; d < 4; ++d)
#pragma unroll
                for (int g = 0; g < 4; ++g) { u32x2 w; w.x = pg8::cvt_pk_bf16(o[d][4 * g] * rl, o[d][4 * g + 1] * rl); w.y = pg8::cvt_pk_bf16(o[d][4 * g + 2] * rl, o[d][4 * g + 3] * rl); *(u32x2*)(op + 32 * d + 8 * g + 4 * hi) = w; }
        }
    }
}

__device__ __forceinline__ float red16(float v) {
    v += __builtin_bit_cast(float, __builtin_amdgcn_mov_dpp(__builtin_bit_cast(int, v), 0xB1, 0xF, 0xF, true));
    v += __builtin_bit_cast(float, __builtin_amdgcn_mov_dpp(__builtin_bit_cast(int, v), 0x4E, 0xF, 0xF, true));
    v += __builtin_bit_cast(float, __builtin_amdgcn_mov_dpp(__builtin_bit_cast(int, v), 0x141, 0xF, 0xF, true));
    v += __builtin_bit_cast(float, __builtin_amdgcn_mov_dpp(__builtin_bit_cast(int, v), 0x140, 0xF, 0xF, true));
    return v;
}
__device__ __forceinline__ void finalize_phase(int l_in, int gw_in, int NGW, int lane_in) {
    const int l = opq_s(l_in), gw = opq_v(gw_in), lane = opq_v(lane_in);
    const Args a = *argp();
    const float* OD = (const float*)(a.ws + WS_OD); const float* OH = (const float*)(a.ws + WS_OH); const float* ZH = (const float*)(a.ws + WS_ZH);
    bf16_t* YD = (bf16_t*)(a.ws + WS_YD); bf16_t* YH = (bf16_t*)(a.ws + WS_YH);
    const float* lp = a.diff_lambda + (size_t)l * 4 * 64;
    const float lam_init = l == 0 ? 0.2f : 0.8f - 0.6f * 0.7408182206817179f;
    const float lam = __expf(wave_sum(lp[lane] * lp[64 + lane])) - __expf(wave_sum(lp[128 + lane] * lp[192 + lane])) + lam_init;
    const int q = lane >> 4, li = lane & 15;
    f32x4 gD[2], gH[2];
#pragma unroll
    for (int e = 0; e < 2; ++e) { gD[e] = *(const f32x4*)(a.diff_ng + l * 128 + 8 * li + 4 * e) * (1.f - lam_init); gH[e] = *(const f32x4*)(a.hgrn_ng + l * 128 + 8 * li + 4 * e); }
    for (int r = gw; r < T; r += NGW) {
        const int b = r / L, t = r % L; const size_t ar = (size_t)(b * LP + t);
        f32x4 A_[3][2], B_[3][2];
#pragma unroll
        for (int p = 0; p < 3; ++p) { const int sg = p * 4 + q; const bool isd = sg < 6; const int h = isd ? sg : sg - 6;
            if (isd) { const bf16_t* pd = (const bf16_t*)OD + (ar * 12 + 2 * h) * 128 + 8 * li; const u32x4 wa = *(const u32x4*)pd, wb = *(const u32x4*)(pd + 128);
                A_[p][0] = (f32x4){bflo(wa.x), bfhi(wa.x), bflo(wa.y), bfhi(wa.y)}; A_[p][1] = (f32x4){bflo(wa.z), bfhi(wa.z), bflo(wa.w), bfhi(wa.w)};
                B_[p][0] = (f32x4){bflo(wb.x), bfhi(wb.x), bflo(wb.y), bfhi(wb.y)}; B_[p][1] = (f32x4){bflo(wb.z), bfhi(wb.z), bflo(wb.w), bfhi(wb.w)}; }
            else { const u32x4 wa = *(const u32x4*)((const bf16_t*)OH + (size_t)r * HW + h * 128 + 8 * li); const u32x4 wb = *(const u32x4*)((const bf16_t*)(a.ws + WS_HG) + (size_t)r * HW + h * 128 + 8 * li);
                A_[p][0] = (f32x4){bflo(wa.x), bfhi(wa.x), bflo(wa.y), bfhi(wa.y)}; A_[p][1] = (f32x4){bflo(wa.z), bfhi(wa.z), bflo(wa.w), bfhi(wa.w)};
                B_[p][0] = (f32x4){bflo(wb.x), bfhi(wb.x), bflo(wb.y), bfhi(wb.y)}; B_[p][1] = (f32x4){bflo(wb.z), bfhi(wb.z), bflo(wb.w), bfhi(wb.w)}; } }
#pragma unroll
        for (int p = 0; p < 3; ++p) { const int sg = p * 4 + q; const bool isd = sg < 6; const int h = isd ? sg : sg - 6;
            const float ls = isd ? lam : 0.f;
            f32x4 d0 = A_[p][0] - B_[p][0] * ls, d1 = A_[p][1] - B_[p][1] * ls;
            const f32x4 sq = d0 * d0 + d1 * d1;
            const float ms = red16((sq[0] + sq[1]) + (sq[2] + sq[3])) * (1.f / 128.f); const float rs = 1.f / sqrtf(ms + RMS_EPS);
            f32x4 w0, w1;
            if (isd) { w0 = gD[0]; w1 = gD[1]; }
            else { const f32x4 g0 = B_[p][0], g1 = B_[p][1];
                w0 = gH[0] * (f32x4){g0[0] * sigmoidf_(g0[0]), g0[1] * sigmoidf_(g0[1]), g0[2] * sigmoidf_(g0[2]), g0[3] * sigmoidf_(g0[3])};
                w1 = gH[1] * (f32x4){g1[0] * sigmoidf_(g1[0]), g1[1] * sigmoidf_(g1[1]), g1[2] * sigmoidf_(g1[2]), g1[3] * sigmoidf_(g1[3])}; }
            d0 = d0 * rs * w0; d1 = d1 * rs * w1;
            u32x4 o; o.x = pk2(d0[0], d0[1]); o.y = pk2(d0[2], d0[3]); o.z = pk2(d1[0], d1[1]); o.w = pk2(d1[2], d1[3]);
            bf16_t* po = (isd ? YD + (size_t)r * DW : YH + (size_t)r * HW) + h * 128 + 8 * li;
            *(u32x4*)po = o; }
    }
}


#ifndef DBG_STAGE
#define DBG_STAGE 0
#endif
template <int stage> __device__ __forceinline__ void dbg_out(int gw, int NGW, int lane) {
    const Args a = *argp(); unsigned char* ws = a.ws;
    const float* ZP = (const float*)(ws + WS_ZP); const float* ZH = (const float*)(ws + WS_ZH); const bf16_t* G = (const bf16_t*)(ws + WS_G);
    const bf16_t* QA = (const bf16_t*)(ws + WS_QA); const bf16_t* YP = (const bf16_t*)(ws + WS_YP); const bf16_t* YH = (const bf16_t*)(ws + WS_YH); const bf16_t* YD = (const bf16_t*)(ws + WS_YD);
    const bf16_t* MB = (const bf16_t*)(ws + WS_MB);
    for (int r = gw; r < T; r += NGW) {
        const int b = r / L, t = r % L; if (t < NMETA) continue;
        const size_t ar = (size_t)(b * LP + t);
        float* o = a.out + ((size_t)b * SEQ + (t - NMETA)) * D;
        for (int c = lane; c < D; c += 64) {
            float v = 0.f;
            if (stage == 1) v = ZH[(size_t)r * 3072 + c] + ZH[(size_t)r * 3072 + 1024 + c] + ZP[(size_t)r * PW + (c & 511)] + bf2f(G[(size_t)r * 6144 + c]) + bf2f(G[(size_t)r * 6144 + 2048 + c]) + bf2f(G[(size_t)r * 6144 + 4096 + c])
                              + bf2f(QA[ar * 768 + (c % 768)]) + bf2f(QA[(WS_KA - WS_QA) / 2 + ar * 768 + (c % 768)]) + bf2f(QA[(WS_KA - WS_QA) + ar * 768 + (c % 768)]);
            else if (stage == 2) v = bf2f(YP[(size_t)r * PW + (c & 511)]) + 2.f * bf2f(YH[(size_t)r * HW + (c % 768)]) + 3.f * bf2f(YD[(size_t)r * DW + ((c + 100) % 768)]);
            else if (stage == 3) v = bf2f(MB[(size_t)r * D + c]);
            o[c] = v;
        }
    }
}

__device__ __forceinline__ void tail_ln(int lnidx, bool final_, unsigned* cntp, unsigned char* lds_g, int rb) {
    if (rb >= 64) return;
    const int tid = opq_v((int)threadIdx.x);
    int* sh = (int*)(lds_g + 131072 + 128);
    asm volatile("s_waitcnt vmcnt(0)" ::: "memory");
    __syncthreads();
    if (tid == 0) { __builtin_amdgcn_fence(__ATOMIC_RELEASE, "agent"); asm volatile("s_waitcnt vmcnt(0)" ::: "memory");
        *sh = (int)__hip_atomic_fetch_add(cntp, 1u, __ATOMIC_RELAXED, __HIP_MEMORY_SCOPE_AGENT); }
    __syncthreads();
    if (*sh == 63) {
        if (tid == 0) { __builtin_amdgcn_fence(__ATOMIC_ACQUIRE, "agent"); asm volatile("s_waitcnt vmcnt(0)" ::: "memory"); }
        __syncthreads();
        ln_rows(lnidx, final_, MT, T, tid >> 6, 8, tid & 63);
    }
}
#ifndef STOP_L
#define STOP_L 1
#endif
#ifndef STOP_J
#define STOP_J 1
#endif
#ifndef STOP_MIX
#define STOP_MIX 0
#endif
__global__ void __launch_bounds__(512, 2) fwd_kernel(Args a_unused) {
    extern __shared__ __attribute__((aligned(16))) unsigned char lds[];
    cg::grid_group grid = cg::this_grid();
    LAS unsigned char* ldsl = (LAS unsigned char*)lds;
    volatile LAS unsigned* MISC = (volatile LAS unsigned*)(ldsl + 147456 - 512);
    if (threadIdx.x < 64) MISC[threadIdx.x] = 0u;
    __syncthreads();
    (void)xcd_barrier_post((unsigned*)(argp()->ws + WS_CTL), MISC);
#define SYNC() xcd_barrier((unsigned*)(argp()->ws + WS_CTL), (volatile LAS unsigned*)(ldsl + 147456 - 512))
#define TIDV opq_v((int)threadIdx.x)
#define BLK opq_s((int)blockIdx.x)
#define GRD opq_s((int)gridDim.x)
#define WSP (argp()->ws)
#define GEMM(EPI, Aptr, Bptr, Mv, Nv, Kv, Eobj) do { pg8::Gemm g_{Aptr, Bptr, MT, Nv, Kv}; pg8::StaticOrder S_; S_.init(MT, Nv, GRD, BLK); pg8::gemm_phase<EPI, pg8::StaticOrder, true, true>(ldsl, g_, S_, Eobj); \
        {   \
          const int rb_ = GRD - 1 - BLK, nt_ = __is_same(EPI, pg8::EpiSwiglu) ? 128 : GRD; \
          tail_gemm<EPI, __is_same(EPI, pg8::EpiSwiglu)>(Aptr, Bptr, Kv, __is_same(EPI, pg8::EpiSwiglu) ? (Nv) / 2 : (Nv), Eobj, lds, rb_ < nt_ ? rb_ : (1 << 28), nt_); } } while (0)

#define GEMM_LN(Aoff, Boff, Kv, sval, lnidx_, final__) do { const Args a_ = *argp(); unsigned char* ws = a_.ws; const int li_ = (lnidx_); \
        pg8::PanelStats st_{(unsigned*)(ws + WS_XB), (unsigned*)(ws + WS_CTL + 65536 + (size_t)li_ * 8192), LN_EPS}; \
        pg8::EpiLn E_{(float*)(ws + WS_H), (bf16_t*)(ws + WS_HB), a_.ln_g + (size_t)li_ * D, a_.ln_b + (size_t)li_ * D, (sval), st_, (final__) ? a_.out : nullptr}; \
        pg8::Gemm g_{(const bf16_t*)(ws + (Aoff)), (const bf16_t*)(ws + (Boff)), MT, D, (Kv)}; pg8::StaticOrder S_; S_.init(MT, D, GRD, BLK); \
        pg8::gemm_phase<pg8::EpiLn, pg8::StaticOrder, false, true>(ldsl, g_, S_, E_); \
        pg8::EpiResid Et_{(const float*)(ws + WS_H), (float*)(ws + WS_PRE), (sval)}; const int rb_ = GRD - 1 - BLK; \
        tail_gemm<pg8::EpiResid, false>((const bf16_t*)(ws + (Aoff)), (const bf16_t*)(ws + (Boff)), (Kv), D, Et_, lds, rb_, GRD); \
        tail_ln(li_, (final__), (unsigned*)(ws + WS_CTL + 20480 + 256 * li_), lds, rb_); } while (0)

    { const int tid = TIDV; prologue(lds, BLK * 8 + (tid >> 6), GRD * 8, tid & 63); }
    asm volatile("s_waitcnt vmcnt(0)" ::: "memory");
    grid.sync();
    for (int l = 0; l < 2; ++l) {
        for (int j = 0; j < 2; ++j) {
            if (j == 1) {
                { unsigned char* ws = WSP; pg8::EpiInproj E{(float*)(ws + WS_ZP), (float*)(ws + WS_ZH), (bf16_t*)(ws + WS_QA), (bf16_t*)(ws + WS_KA), (bf16_t*)(ws + WS_VA), (bf16_t*)(ws + WS_G)};
                  GEMM(pg8::EpiInproj, (const bf16_t*)(ws + WS_HB), (const bf16_t*)(ws + WS_WIN + (size_t)l * SZ_WIN), MP, INCOLS, D, E); }
                SYNC();
                if constexpr (DBG_STAGE == 1) { const int tid = TIDV; dbg_out<1>(BLK * 8 + (tid >> 6), GRD * 8, tid & 63); return; }
                { const int blk = BLK, G = GRD; pool_phase(l, lds, blk, G); hgrn_pre(l, lds, blk, G); }
                SYNC();
                attn_phase(l, lds, ldsl, (unsigned*)(argp()->ws + WS_CTL + 16384 + 256 * l), 24);
                SYNC();
                { const int tid = TIDV; finalize_phase(l, BLK * 8 + (tid >> 6), GRD * 8, tid & 63); }
                SYNC();
                if constexpr (DBG_STAGE == 2) { const int tid = TIDV; dbg_out<2>(BLK * 8 + (tid >> 6), GRD * 8, tid & 63); return; }
                { unsigned char* ws = WSP;
                  pg8::EpiBranch E0{(const bf16_t*)(ws + WS_G), 0, (float*)(ws + WS_MF), (bf16_t*)(ws + WS_MB), 0};
                  GEMM(pg8::EpiBranch, (const bf16_t*)(ws + WS_YP), (const bf16_t*)(ws + WS_WBP + (size_t)l * D * PW * 2), MP, D, PW, E0); }
                { unsigned char* ws = WSP;
                  pg8::EpiBranch E1{(const bf16_t*)(ws + WS_G), 2048, (float*)(ws + WS_MF), (bf16_t*)(ws + WS_MB), 1};
                  GEMM(pg8::EpiBranch, (const bf16_t*)(ws + WS_YH), (const bf16_t*)(ws + WS_WBH + (size_t)l * D * HW * 2), MP, D, HW, E1); }
                { unsigned char* ws = WSP;
                  pg8::EpiBranch E2{(const bf16_t*)(ws + WS_G), 4096, (float*)(ws + WS_MF), (bf16_t*)(ws + WS_MB), 2};
                  GEMM(pg8::EpiBranch, (const bf16_t*)(ws + WS_YD), (const bf16_t*)(ws + WS_WBD + (size_t)l * D * DW * 2), MP, D, DW, E2); }
                SYNC();
                if constexpr (DBG_STAGE == 3) { const int tid = TIDV; dbg_out<3>(BLK * 8 + (tid >> 6), GRD * 8, tid & 63); return; }
                GEMM_LN(WS_MB, WS_WO + (size_t)l * D * D * 2, D, 1.0f, l * 3 + 1, false);
                SYNC();
            }
            { unsigned char* ws = WSP; pg8::EpiSwiglu E{(bf16_t*)(ws + WS_ACT)};
              GEMM(pg8::EpiSwiglu, (const bf16_t*)(ws + WS_HB), (const bf16_t*)(ws + WS_WUP + (size_t)(l * 2 + j) * SZ_WUP), MP, 2 * DFF, D, E); }
            SYNC();
            GEMM_LN(WS_ACT, WS_WDN + (size_t)(l * 2 + j) * SZ_WDN, DFF, 0.5f, l * 3 + 2 * j, (l == 1 && j == 1));
            if (l == 1 && j == 1) return;
            SYNC();
        }
    }
#undef GEMM
}

extern "C" void kernel_launch(void* const* d_in, const int* in_sizes, int n_in, void* d_out, int out_size, void* d_ws, size_t ws_size, hipStream_t stream) {
    static int grid = 0;
    if (grid == 0) {
        int dev = 0, cus = 0, per_cu = 0;
        (void)hipGetDevice(&dev);
        (void)hipDeviceGetAttribute(&cus, hipDeviceAttributeMultiprocessorCount, dev);
        (void)hipFuncSetAttribute((const void*)fwd_kernel, hipFuncAttributeMaxDynamicSharedMemorySize, LDS_BYTES);
        (void)hipOccupancyMaxActiveBlocksPerMultiprocessor(&per_cu, (const void*)fwd_kernel, 512, LDS_BYTES);
        if (per_cu < 1) per_cu = 1;
        grid = cus * per_cu;
        if (ws_size < WS_END3 || cus * per_cu != 256) { fprintf(stderr, "kernel_launch: workspace too small: %zu < %zu\n", ws_size, (size_t)WS_END); grid = -1; }
    }
    if (grid < 0) return;
    Args a{};
    a.x = (const float*)d_in[0]; a.meta = (const float*)d_in[1]; a.ln_g = (const float*)d_in[2]; a.ln_b = (const float*)d_in[3];
    a.ffn_w_in = (const float*)d_in[4]; a.ffn_w_out = (const float*)d_in[5]; a.w_in = (const float*)d_in[6]; a.pool_w = (const float*)d_in[7];
    a.pool_scale = (const float*)d_in[8]; a.hgrn_lb = (const float*)d_in[9]; a.hgrn_ng = (const float*)d_in[10]; a.diff_lambda = (const float*)d_in[11];
    a.diff_ng = (const float*)d_in[12]; a.w_bp = (const float*)d_in[13]; a.w_bh = (const float*)d_in[14]; a.w_bd = (const float*)d_in[15]; a.w_out = (const float*)d_in[16];
    a.out = (float*)d_out; a.ws = (unsigned char*)d_ws;
    (void)hipMemsetAsync((char*)d_ws + WS_CTL, 0, 131072, stream);
    void* args[] = {&a};
    hipError_t e = hipLaunchCooperativeKernel((const void*)fwd_kernel, dim3(grid), dim3(512), args, LDS_BYTES, stream);
    if (e != hipSuccess) fprintf(stderr, "cooperative launch failed: %s (grid %d)\n", hipGetErrorString(e), grid);
}
```

```cpp
#include <hip/hip_runtime.h>
#include <hip/hip_cooperative_groups.h>
#include <cstdio>
#include <cstdint>
namespace cg = cooperative_groups;

#define LAS __attribute__((address_space(3)))
typedef unsigned short bf16_t;
typedef short bf16x8 __attribute__((ext_vector_type(8)));
typedef float f32x4 __attribute__((ext_vector_type(4)));
typedef float f32x2 __attribute__((ext_vector_type(2)));
typedef unsigned u32x4 __attribute__((ext_vector_type(4)));
typedef unsigned u32x2 __attribute__((ext_vector_type(2)));
typedef short s16x4 __attribute__((ext_vector_type(4)));
typedef float f32x16_t __attribute__((ext_vector_type(16)));

constexpr int D = 2048, NB = 2, SEQ = 4096, NMETA = 16, L = SEQ + NMETA  , T = NB * L  , MP = 8448  ;
constexpr int DFF = 5632, INCOLS = 12032, LP = 4352  ;
constexpr int PW = 512, HW = 768, DW = 768;
constexpr float ALPHA = 1.4142135623730951f;
constexpr float LN_EPS = 1e-5f, RMS_EPS = 1e-6f;
constexpr float C2 = 0.125f * 1.4426950408889634f;

constexpr size_t al(size_t x) { return (x + 4095) & ~(size_t)4095; }
constexpr size_t WS_CTL = 0, CTL_BYTES = 1 << 20;
constexpr size_t SZ_WUP = (size_t)2 * DFF * D * 2, SZ_WDN = (size_t)D * DFF * 2, SZ_WIN = (size_t)INCOLS * D * 2;
constexpr size_t WS_WUP = WS_CTL + CTL_BYTES;
constexpr size_t WS_WDN = WS_WUP + 4 * SZ_WUP;
constexpr size_t WS_WIN = WS_WDN + 4 * SZ_WDN;
constexpr size_t WS_WBP = WS_WIN + 2 * SZ_WIN;
constexpr size_t WS_WBH = WS_WBP + 2 * (size_t)D * PW * 2;
constexpr size_t WS_WBD = WS_WBH + 2 * (size_t)D * HW * 2;
constexpr size_t WS_WO = WS_WBD + 2 * (size_t)D * DW * 2;
constexpr size_t WS_H = al(WS_WO + 2 * (size_t)D * D * 2);
constexpr size_t WS_HB = al(WS_H + (size_t)MP * D * 4);
constexpr size_t WS_PRE = al(WS_HB + (size_t)MP * D * 2);
constexpr size_t WS_ACT = al(WS_PRE + (size_t)MP * D * 4);
constexpr size_t WS_ZP = al(WS_ACT + (size_t)MP * DFF * 2);
constexpr size_t WS_ZH = al(WS_ZP + (size_t)MP * PW * 4);
constexpr size_t WS_QA = al(WS_ZH + (size_t)MP * 3072 * 4);
constexpr size_t WS_KA = al(WS_QA + (size_t)NB * LP * 768 * 2);
constexpr size_t WS_VA = al(WS_KA + (size_t)NB * LP * 768 * 2);
constexpr size_t WS_G = al(WS_VA + (size_t)NB * LP * 768 * 2);
constexpr size_t WS_YP = al(WS_G + (size_t)MP * 6144 * 2);
constexpr size_t WS_YH = al(WS_YP + (size_t)MP * PW * 2);
constexpr size_t WS_YD = al(WS_YH + (size_t)MP * HW * 2);
constexpr size_t WS_OH = al(WS_YD + (size_t)MP * DW * 2);
constexpr size_t WS_OD = al(WS_OH + (size_t)T * HW * 4);
constexpr size_t WS_MF = al(WS_OD + (size_t)NB * LP * 1536 * 4);
constexpr size_t WS_MB = al(WS_MF + (size_t)MP * D * 4);
constexpr size_t WS_END = al(WS_MB + (size_t)MP * D * 2);
static_assert(WS_KA - WS_QA == WS_VA - WS_KA, "Q/K/V attention buffers equally spaced");
constexpr size_t WS_HG = WS_END, WS_HV = al(WS_HG + (size_t)MP * HW * 2), WS_HQ = al(WS_HV + (size_t)MP * HW * 2), WS_END_HG = al(WS_HQ + (size_t)MP * HW * 2);

constexpr int LDS_BYTES = 147456;

typedef float f32x2_t __attribute__((ext_vector_type(2))); typedef __bf16 bf16x2_t __attribute__((ext_vector_type(2)));
__device__ __forceinline__ unsigned pk2(float lo, float hi) { f32x2_t v = {lo, hi}; bf16x2_t b = __builtin_convertvector(v, bf16x2_t); return __builtin_bit_cast(unsigned, b); }
__device__ __forceinline__ unsigned f2bf(float f) { return pk2(f, 0.f) & 0xffffu; }
__device__ __forceinline__ float bf2f(unsigned short v) { return __builtin_bit_cast(float, (unsigned)v << 16); }
__device__ __forceinline__ float bflo(unsigned w) { return __builtin_bit_cast(float, w << 16); }
__device__ __forceinline__ float bfhi(unsigned w) { return __builtin_bit_cast(float, w & 0xffff0000u); }
__device__ __forceinline__ float wave_sum(float v) {
#pragma unroll
    for (int o = 1; o < 64; o <<= 1) v += __shfl_xor(v, o);
    return v;
}
__device__ __forceinline__ float sigmoidf_(float x) { return __builtin_amdgcn_rcpf(1.0f + __builtin_amdgcn_exp2f(-1.4426950408889634f * x)); }

__device__ __forceinline__ int opq_v(int x) { asm volatile("" : "+v"(x)); return x; }
__device__ __forceinline__ int opq_s(int x) { asm volatile("" : "+s"(x)); return x; }


#define XB_TMO      128
#define XB_XCNT(j)  (256  + 64 * (j))
#define XB_XSUB(j)  (1280 + 64 * (j))
#define XB_XGEN(j)  (2304 + 64 * (j))
#define XB_TOP      3328
#define XB_TOPGEN   3392
#define XCD_BAR_WORDS 3456
#define XB_SPIN_CAP (1u << 22)
__device__ __forceinline__ unsigned xb_ld(unsigned* p)              { return __hip_atomic_load(p, __ATOMIC_RELAXED, __HIP_MEMORY_SCOPE_AGENT); }
__device__ __forceinline__ unsigned xb_add(unsigned* p, unsigned v) { return __hip_atomic_fetch_add(p, v, __ATOMIC_RELAXED, __HIP_MEMORY_SCOPE_AGENT); }
__device__ __forceinline__ unsigned xb_xcc_id() { return (unsigned)__builtin_amdgcn_s_getreg((3 << 11) | 20) & 0xFu; }
#define XB_SPIN(cond, bar) do { unsigned _sp = 0; while (cond) { __builtin_amdgcn_s_sleep(1); \
    if ((++_sp & 255u) == 0u) { if (xb_ld(&(bar)[XB_TMO])) break; if (_sp > XB_SPIN_CAP) { atomicAdd(&(bar)[XB_TMO], 1u); break; } } } } while (0)
struct XcdBarrier { unsigned* bar; unsigned x; volatile LAS unsigned* st; };
__device__ __forceinline__ XcdBarrier xcd_barrier_post(unsigned* bar, volatile LAS unsigned* st) {
    XcdBarrier b; b.bar = bar; b.x = xb_xcc_id(); b.st = st;
    if (threadIdx.x == 0) (void)xb_add(&bar[XB_XCNT(b.x)], 1u);
    return b;
}
__device__ __forceinline__ void xcd_barrier_complete(unsigned* bar, unsigned x, unsigned& nloc, unsigned& nx) {
    const unsigned G = gridDim.x * gridDim.y * gridDim.z;
    unsigned sum, cnt, mine, sp = 0u;
    for (;;) {
        sum = 0u; cnt = 0u; mine = 0u;
#pragma unroll
        for (unsigned j = 0; j < 16; ++j) { const unsigned c = xb_ld(&bar[XB_XCNT(j)]); sum += c; cnt += (c > 0u) ? 1u : 0u; mine = (j == x) ? c : mine; }
        if (sum == G) break;
        __builtin_amdgcn_s_sleep(1);
        if ((++sp & 255u) == 0u) { if (xb_ld(&bar[XB_TMO])) break; if (sp > XB_SPIN_CAP) { atomicAdd(&bar[XB_TMO], 1u); break; } }
    }
    nloc = mine > 0u ? mine : 1u; nx = cnt > 0u ? cnt : 1u;
}
__device__ __forceinline__ void xcd_barrier(unsigned* bar, volatile LAS unsigned* st) {
    asm volatile("s_waitcnt vmcnt(0)" ::: "memory");
    __syncthreads();
    if (threadIdx.x == 0) {
        const unsigned x = xb_xcc_id();
        __builtin_amdgcn_s_waitcnt(0);
        unsigned nloc = st[0], nx = st[1];
        if (nloc == 0u) { xcd_barrier_complete(bar, x, nloc, nx); st[0] = nloc; st[1] = nx; }
        const unsigned old = xb_add(&bar[XB_XSUB(x)], 1u);
        const unsigned gen = old / nloc;
        if (old + 1u == (gen + 1u) * nloc) {
            __builtin_amdgcn_fence(__ATOMIC_RELEASE, "agent");
            asm volatile("s_waitcnt vmcnt(0)" ::: "memory");
            const unsigned og = xb_add(&bar[XB_TOP], 1u);
            const unsigned tg = og / nx;
            if (og + 1u == (tg + 1u) * nx) xb_add(&bar[XB_TOPGEN], 1u);
            else XB_SPIN(xb_ld(&bar[XB_TOPGEN]) == tg, bar);
            __builtin_amdgcn_fence(__ATOMIC_ACQUIRE, "agent");
            xb_add(&bar[XB_XGEN(x)], 1u);
            asm volatile("s_waitcnt vmcnt(0)" ::: "memory");
        } else {
            XB_SPIN(xb_ld(&bar[XB_XGEN(x)]) == gen, bar);
            __builtin_amdgcn_fence(__ATOMIC_ACQUIRE, "agent");
            asm volatile("s_waitcnt vmcnt(0)" ::: "memory");
        }
    }
    __syncthreads();
}

namespace pg8 {
constexpr int BM = 256, BK = 64, HALF = 128, HTB = HALF * BK * 2, STAGE_BYTES = 8 * HTB, NXCD = 8, WGM = 8;
__host__ __device__ __forceinline__ int lds_byte(int r, int c) { const int st = (r >> 4) * 2 + (c >> 5), rr = r & 15, cc = c & 31, ob = rr * 64 + cc * 2; return st * 1024 + (ob ^ (((ob >> 9) & 1) << 5)); }
__host__ __device__ __forceinline__ void stage_rc(int b, int& R, int& C) { const int st = b / 1024, sb = b % 1024, swz = sb ^ (((sb >> 9) & 1) << 5); R = (st >> 1) * 16 + swz / 64; C = (st & 1) * 32 + (swz % 64) / 2; }
__host__ __device__ __forceinline__ int perm32(int rho) { const int n = rho >> 4, i = rho & 15; return 8 * (i >> 2) + 4 * n + (i & 3); }
struct Unit { int pm, pn; };
struct Gemm { const bf16_t* A; const bf16_t* Bt; int M, N, K; };
struct StaticOrder {
    int nM, nN, nwg, G, c;
    __host__ __device__ void init(int M, int N, int G_, int c_) { nM = M / BM; nN = N / BM; nwg = nM * nN; G = G_; c = c_; }
    __host__ __device__ bool next(int i, Unit& u) const {
        const long Lx = (long)i * G + c; if (Lx >= nwg) return false;
        int wgid = (int)Lx; { const int q = nwg / NXCD, r = nwg % NXCD, xcd = wgid % NXCD, off = wgid / NXCD; wgid = (xcd < r ? xcd * (q + 1) : r * (q + 1) + (xcd - r) * q) + off; }
        const int nig = WGM * nN, gid = wgid / nig, fm = gid * WGM, gsz = (nM - fm) < WGM ? (nM - fm) : WGM;
        u.pm = fm + ((wgid % nig) % gsz); u.pn = (wgid % nig) / gsz; return true;
    }
    __device__ __forceinline__ void a_ready(const Unit&) const {}
    __device__ __forceinline__ void done(const Unit&) const {}
};
__device__ __forceinline__ unsigned cvt_pk_bf16(float lo, float hi) { f32x2_t v = {lo, hi}; bf16x2_t b = __builtin_convertvector(v, bf16x2_t); return __builtin_bit_cast(unsigned, b); }

template <class Epi, class Sched, bool ALIGN_EPI = false, bool SP2 = false>
__device__ __forceinline__ void gemm_phase(LAS unsigned char* lds, const Gemm g, const Sched& S, const Epi& E) {
    const int tid = opq_v((int)threadIdx.x), wid = __builtin_amdgcn_readfirstlane(tid >> 6), lane = tid & 63, wr = wid >> 2, wc = wid & 3, fr = lane & 15, fq = lane >> 4;
    const int K = g.K, nt = K / BK;
    unsigned voffA[2], voffB[2];
#pragma unroll
    for (int i = 0; i < 2; ++i) { int R, C; stage_rc(tid * 16 + i * 8192, R, C); const int Rb = Epi::PERM ? ((R & ~31) + perm32(R & 31)) : R;
        voffA[i] = (unsigned)(R * K + C) * 2u; voffB[i] = (unsigned)(Rb * K + C) * 2u; }
    const size_t kstep = (size_t)(BK * 2);
    const size_t hstep = (size_t)HALF * K * 2;
    const size_t tstep = 2 * hstep;
    const unsigned ldsw = (unsigned)wid * 1024u;
    const int aoff = lds_byte(wr * 64 + fr, fq * 8), boff = lds_byte(wc * 32 + fr, fq * 8);
#define PG8_SA(b, h) (((b) * 2 + (h)) * HTB)
#define PG8_SB(b, h) ((4 + (b) * 2 + (h)) * HTB)
#define PG8_STAGE(bufoff, gbase, voff) do { _Pragma("unroll") for (int _i = 0; _i < 2; ++_i) \
        __builtin_amdgcn_global_load_lds((const unsigned*)((const char*)(gbase) + (voff)[_i]), (LAS unsigned*)(lds + (bufoff) + ldsw + _i * 8192), 16, 0, 0); } while (0)
#define PG8_LDA(dst, b, h) do { _Pragma("unroll") for (int m = 0; m < 4; ++m) _Pragma("unroll") for (int k = 0; k < 2; ++k) dst[m][k] = *(const LAS bf16x8*)(lds + PG8_SA(b, h) + aoff + m * 2048 + k * 1024); } while (0)
#define PG8_LDB(dst, b, h) do { _Pragma("unroll") for (int n = 0; n < 2; ++n) _Pragma("unroll") for (int k = 0; k < 2; ++k) dst[n][k] = *(const LAS bf16x8*)(lds + PG8_SB(b, h) + boff + n * 2048 + k * 1024); } while (0)
#define PG8_MMA(ai, bj, At, Bt) do { __builtin_amdgcn_s_setprio(1); _Pragma("unroll") for (int m = 0; m < 4; ++m) _Pragma("unroll") for (int n = 0; n < 2; ++n) _Pragma("unroll") for (int k = 0; k < 2; ++k) \
        acc[ai][bj][m][n] = __builtin_amdgcn_mfma_f32_16x16x32_bf16(Bt[n][k], At[m][k], acc[ai][bj][m][n], 0, 0, 0); __builtin_amdgcn_s_setprio(0); } while (0)
#define PG8_WAIT_V(n) asm volatile("s_waitcnt vmcnt(" #n ")" ::: "memory")
#define PG8_WAIT_L(n) asm volatile("s_waitcnt lgkmcnt(" #n ")" ::: "memory")
#define PG8_BAR __builtin_amdgcn_s_barrier()
#define PG8_SCHED __builtin_amdgcn_sched_barrier(0)
    Unit cur, nxt; int ui = 0;
    if (!S.next(0, cur)) return;
    f32x4 acc[2][2][4][2];
#pragma unroll
    for (int a = 0; a < 2; ++a)
#pragma unroll
        for (int b = 0; b < 2; ++b)
#pragma unroll
            for (int m = 0; m < 4; ++m)
#pragma unroll
                for (int n = 0; n < 2; ++n) acc[a][b][m][n] = (f32x4){0.f, 0.f, 0.f, 0.f};
    bf16x8 At[4][2], B0[2][2], B1[2][2];
    const char* cA = (const char*)g.A + (size_t)cur.pm * tstep; const char* cB = (const char*)g.Bt + (size_t)cur.pn * tstep;
    S.a_ready(cur);
    if constexpr (SP2) {
        PG8_STAGE(PG8_SB(0, 0), cB, voffB); PG8_STAGE(PG8_SB(0, 1), cB + hstep, voffB); PG8_STAGE(PG8_SA(0, 0), cA, voffA); PG8_STAGE(PG8_SA(0, 1), cA + hstep, voffA);
        if (wr == 1) PG8_BAR;
        PG8_WAIT_V(2); PG8_BAR;
        PG8_STAGE(PG8_SB(1, 0), cB + kstep, voffB); PG8_STAGE(PG8_SA(1, 0), cA + kstep, voffA); PG8_STAGE(PG8_SB(1, 1), cB + hstep + kstep, voffB);
        PG8_WAIT_V(6); PG8_BAR;
    } else {
        PG8_STAGE(PG8_SB(0, 0), cB, voffB); PG8_STAGE(PG8_SA(0, 0), cA, voffA); PG8_STAGE(PG8_SB(0, 1), cB + hstep, voffB); PG8_STAGE(PG8_SA(0, 1), cA + hstep, voffA);
        if (wr == 1) PG8_BAR;
        PG8_WAIT_V(4); PG8_BAR;
        PG8_STAGE(PG8_SB(1, 0), cB + kstep, voffB); PG8_STAGE(PG8_SA(1, 0), cA + kstep, voffA); PG8_STAGE(PG8_SB(1, 1), cB + hstep + kstep, voffB);
        PG8_WAIT_V(6); PG8_BAR;
    }
    for (;;) {
        const bool has_next = S.next(ui + 1, nxt);
        const char* nA = has_next ? (const char*)g.A + (size_t)nxt.pm * tstep : cA; const char* nB = has_next ? (const char*)g.Bt + (size_t)nxt.pn * tstep : cB;
        for (int t = 0; t < nt; t += 2) {
            const bool last = (t == nt - 2);
            const char* a1 = cA + (size_t)(t + 1) * kstep;
            const char* a2 = last ? nA : cA + (size_t)(t + 2) * kstep; const char* b2 = last ? nB : cB + (size_t)(t + 2) * kstep;
            const char* a3 = a2 + kstep; const char* b3 = b2 + kstep;
            if (last && has_next) S.a_ready(nxt);
            if constexpr (SP2) {
            PG8_LDB(B0, 0, 0); PG8_LDB(B1, 0, 1); PG8_SCHED; PG8_LDA(At, 0, 0); PG8_STAGE(PG8_SA(1, 1), a1 + hstep, voffA);
            PG8_WAIT_V(8); PG8_WAIT_L(0); PG8_BAR; PG8_MMA(0, 0, At, B0); PG8_MMA(0, 1, At, B1); PG8_BAR; PG8_SCHED;
            PG8_LDA(At, 0, 1); PG8_STAGE(PG8_SB(0, 0), b2, voffB); PG8_STAGE(PG8_SB(0, 1), b2 + hstep, voffB); PG8_STAGE(PG8_SA(0, 0), a2, voffA);
            PG8_WAIT_V(8); PG8_WAIT_L(0); PG8_BAR; PG8_MMA(1, 0, At, B0); PG8_MMA(1, 1, At, B1); PG8_BAR; PG8_SCHED;
            PG8_LDB(B0, 1, 0); PG8_LDB(B1, 1, 1); PG8_SCHED; PG8_LDA(At, 1, 0); PG8_STAGE(PG8_SA(0, 1), a2 + hstep, voffA);
            PG8_WAIT_V(8); PG8_WAIT_L(0); PG8_BAR; PG8_MMA(0, 0, At, B0); PG8_MMA(0, 1, At, B1); PG8_BAR; PG8_SCHED;
            PG8_LDA(At, 1, 1); PG8_STAGE(PG8_SB(1, 0), b3, voffB); PG8_STAGE(PG8_SB(1, 1), b3 + hstep, voffB); PG8_STAGE(PG8_SA(1, 0), a3, voffA);
            PG8_WAIT_V(8); PG8_WAIT_L(0); PG8_BAR; PG8_MMA(1, 0, At, B0); PG8_MMA(1, 1, At, B1); PG8_BAR; PG8_SCHED;
            } else {
            PG8_LDB(B0, 0, 0); PG8_SCHED; PG8_LDA(At, 0, 0); PG8_STAGE(PG8_SA(1, 1), a1 + hstep, voffA);
            PG8_WAIT_L(8); PG8_BAR; PG8_WAIT_L(0); PG8_MMA(0, 0, At, B0); PG8_BAR; PG8_SCHED;
            PG8_LDB(B1, 0, 1); PG8_STAGE(PG8_SB(0, 0), b2, voffB);
            PG8_BAR; PG8_WAIT_L(0); PG8_MMA(0, 1, At, B1); PG8_BAR;
            PG8_LDA(At, 0, 1); PG8_STAGE(PG8_SA(0, 0), a2, voffA);
            PG8_BAR; PG8_WAIT_L(0); PG8_MMA(1, 0, At, B0); PG8_BAR; PG8_SCHED;
            PG8_STAGE(PG8_SB(0, 1), b2 + hstep, voffB);
            PG8_WAIT_V(6); PG8_BAR; PG8_MMA(1, 1, At, B1); PG8_BAR;
            PG8_LDB(B0, 1, 0); PG8_SCHED; PG8_LDA(At, 1, 0); PG8_STAGE(PG8_SA(0, 1), a2 + hstep, voffA);
            PG8_WAIT_L(8); PG8_BAR; PG8_WAIT_L(0); PG8_MMA(0, 0, At, B0); PG8_BAR; PG8_SCHED;
            PG8_LDB(B1, 1, 1); PG8_STAGE(PG8_SB(1, 0), b3, voffB);
            PG8_BAR; PG8_WAIT_L(0); PG8_MMA(0, 1, At, B1); PG8_BAR;
            PG8_LDA(At, 1, 1); PG8_STAGE(PG8_SA(1, 0), a3, voffA);
            PG8_BAR; PG8_WAIT_L(0); PG8_MMA(1, 0, At, B0); PG8_BAR; PG8_SCHED;
            PG8_STAGE(PG8_SB(1, 1), b3 + hstep, voffB);
            PG8_WAIT_V(6); PG8_BAR; PG8_MMA(1, 1, At, B1); PG8_BAR;
            }
        }
        if constexpr (ALIGN_EPI) { if (wr == 0) PG8_BAR; }
        if constexpr (!Epi::AFTER_DRAIN) { E(acc, cur, wr, wc, fr, fq); S.done(cur); }
        if (!has_next) break;
#pragma unroll
        for (int a = 0; a < 2; ++a)
#pragma unroll
            for (int b = 0; b < 2; ++b)
#pragma unroll
                for (int m = 0; m < 4; ++m)
#pragma unroll
                    for (int n = 0; n < 2; ++n) acc[a][b][m][n] = (f32x4){0.f, 0.f, 0.f, 0.f};
        cur = nxt; cA = nA; cB = nB; ++ui;
        if constexpr (ALIGN_EPI) { if (wr == 1) PG8_BAR; }
    }
    PG8_WAIT_V(0);
    if constexpr (!ALIGN_EPI) { if (wr == 0) PG8_BAR; }
    PG8_BAR;
    if constexpr (Epi::AFTER_DRAIN) { E.fused(acc, cur, wr, wc, fr, fq, lds, wid, lane); S.done(cur); }
#undef PG8_SA
#undef PG8_SB
#undef PG8_STAGE
#undef PG8_LDA
#undef PG8_LDB
#undef PG8_MMA
#undef PG8_WAIT_V
#undef PG8_WAIT_L
#undef PG8_BAR
#undef PG8_SCHED
}

struct EpiSwiglu {
    static constexpr bool PERM = true, AFTER_DRAIN = false;
    bf16_t* O;
    __device__ __forceinline__ void tail(int row, int col, float a_, float u_) const { O[(size_t)row * DFF + col] = (bf16_t)f2bf(a_ * sigmoidf_(a_) * u_); }
    __device__ __forceinline__ void operator()(const f32x4 (&acc)[2][2][4][2], const Unit& u, int wr, int wc, int fr, int fq) const {
        const int row0 = u.pm * BM + wr * 64 + fr, col0 = u.pn * 128 + wc * 32 + 8 * fq;
#pragma unroll
        for (int ai = 0; ai < 2; ++ai)
#pragma unroll
            for (int m = 0; m < 4; ++m) {
                bf16_t* p = O + (size_t)(row0 + ai * HALF + m * 16) * DFF + col0;
                float v[8];
#pragma unroll
                for (int n = 0; n < 2; ++n)
#pragma unroll
                    for (int j = 0; j < 4; ++j) { const float a = acc[ai][0][m][n][j], g = acc[ai][1][m][n][j]; v[n * 4 + j] = a * sigmoidf_(a) * g; }
                u32x4 w; w.x = cvt_pk_bf16(v[0], v[1]); w.y = cvt_pk_bf16(v[2], v[3]); w.z = cvt_pk_bf16(v[4], v[5]); w.w = cvt_pk_bf16(v[6], v[7]);
                *(u32x4*)p = w;
            }
    }
};
struct EpiResid {
    static constexpr bool PERM = false, AFTER_DRAIN = false;
    const float* H; float* PRE; float s;
    __device__ __forceinline__ void tail(int row, int col, float v, float) const { const size_t o = (size_t)row * D + col; PRE[o] = H[o] * ALPHA + v * s; }
    __device__ __forceinline__ void operator()(const f32x4 (&acc)[2][2][4][2], const Unit& u, int wr, int wc, int fr, int fq) const {
        const int row0 = u.pm * BM + wr * 64 + fr, col0 = u.pn * BM + wc * 32 + 4 * fq;
#pragma unroll
        for (int ai = 0; ai < 2; ++ai)
#pragma unroll
            for (int m = 0; m < 4; ++m) {
                const size_t off = (size_t)(row0 + ai * HALF + m * 16) * D + col0;
#pragma unroll
                for (int bj = 0; bj < 2; ++bj)
#pragma unroll
                    for (int n = 0; n < 2; ++n) { const f32x4 h = *(const f32x4*)(H + off + bj * HALF + n * 16); *(f32x4*)(PRE + off + bj * HALF + n * 16) = h * ALPHA + acc[ai][bj][m][n] * s; }
            }
    }
};
struct EpiInproj {
    static constexpr bool PERM = true, AFTER_DRAIN = false;
    float* ZP; float* ZH; bf16_t* QA; bf16_t* KA; bf16_t* VA; bf16_t* G;
    __device__ __forceinline__ void tail(int row, int c, float v, float) const {
        if (c < 512) ZP[(size_t)row * PW + c] = v;
        else if (c < 1280) (G + (WS_HQ - WS_G) / 2)[(size_t)row * HW + (c - 512)] = (bf16_t)f2bf(v);
        else if (c < 2048) ZH[(size_t)row * 3072 + (c - 512)] = v;
        else if (c < 2816) (G + (WS_HV - WS_G) / 2)[(size_t)row * HW + (c - 2048)] = (bf16_t)f2bf(v);
        else if (c < 3584) (G + (WS_HG - WS_G) / 2)[(size_t)row * HW + (c - 2816)] = (bf16_t)f2bf(v);
        else if (c < 5888) { const int seg = (c - 3584) / 768, cc = c - 3584 - seg * 768; const int b_ = row >= L ? 1 : 0, t_ = row - b_ * L;
            if (seg == 2) VA[((size_t)b_ * 768 + cc) * LP + t_] = (bf16_t)f2bf(v);
            else (QA + (size_t)seg * ((WS_KA - WS_QA) / 2))[(size_t)(b_ * LP + t_) * 768 + cc] = (bf16_t)f2bf(seg == 0 ? v * C2 : v); }
        else G[(size_t)row * 6144 + (c - 5888)] = (bf16_t)f2bf(sigmoidf_(v));
    }
    __device__ __forceinline__ void operator()(const f32x4 (&acc)[2][2][4][2], const Unit& u, int wr, int wc, int fr, int fq) const {
        const int row0 = u.pm * BM + wr * 64 + fr, pn = u.pn;
#pragma unroll
        for (int ai = 0; ai < 2; ++ai)
#pragma unroll
            for (int m = 0; m < 4; ++m) {
                const int row = row0 + ai * HALF + m * 16;
#pragma unroll
                for (int bj = 0; bj < 2; ++bj) {
                    const int c = pn * BM + bj * HALF + wc * 32 + 8 * fq;
                    const f32x4 v0 = acc[ai][bj][m][0], v1 = acc[ai][bj][m][1];
                    if (pn < 2) { float* p = ZP + (size_t)row * PW + c; *(f32x4*)p = v0; *(f32x4*)(p + 4) = v1; }
                    else if (pn < 5) { u32x4 w; w.x = cvt_pk_bf16(v0[0], v0[1]); w.y = cvt_pk_bf16(v0[2], v0[3]); w.z = cvt_pk_bf16(v1[0], v1[1]); w.w = cvt_pk_bf16(v1[2], v1[3]);
                        *(u32x4*)(G + (WS_HQ - WS_G) / 2 + (size_t)row * HW + (c - 512)) = w; }
                    else if (pn < 8) { float* p = ZH + (size_t)row * 3072 + (c - 512); *(f32x4*)p = v0; *(f32x4*)(p + 4) = v1; }
                    else if (pn < 11) { u32x4 w; w.x = cvt_pk_bf16(v0[0], v0[1]); w.y = cvt_pk_bf16(v0[2], v0[3]); w.z = cvt_pk_bf16(v1[0], v1[1]); w.w = cvt_pk_bf16(v1[2], v1[3]);
                        *(u32x4*)(G + (WS_HV - WS_G) / 2 + (size_t)row * HW + (c - 2048)) = w; }
                    else if (pn < 14) { u32x4 w; w.x = cvt_pk_bf16(v0[0], v0[1]); w.y = cvt_pk_bf16(v0[2], v0[3]); w.z = cvt_pk_bf16(v1[0], v1[1]); w.w = cvt_pk_bf16(v1[2], v1[3]);
                        *(u32x4*)(G + (WS_HG - WS_G) / 2 + (size_t)row * HW + (c - 2816)) = w; }
                    else if (pn < 23) {
                        const int seg = (pn - 14) / 3, cc = c - 3584 - seg * 768;
                        if (row < T && seg == 2) {
                            const int b_ = row >= L ? 1 : 0, t_ = row - b_ * L;
                            bf16_t* vt = VA + ((size_t)b_ * 768 + cc) * LP + t_;
                            vt[0] = (bf16_t)f2bf(v0[0]); vt[LP] = (bf16_t)f2bf(v0[1]); vt[2 * LP] = (bf16_t)f2bf(v0[2]); vt[3 * LP] = (bf16_t)f2bf(v0[3]);
                            vt[4 * LP] = (bf16_t)f2bf(v1[0]); vt[5 * LP] = (bf16_t)f2bf(v1[1]); vt[6 * LP] = (bf16_t)f2bf(v1[2]); vt[7 * LP] = (bf16_t)f2bf(v1[3]);
                        } else if (row < T) {
                            const int arow = row >= L ? row - L + LP : row;
                            bf16_t* base = QA + (size_t)seg * ((WS_KA - WS_QA) / 2); const float sc = seg == 0 ? C2 : 1.f;
                            u32x4 w; w.x = cvt_pk_bf16(v0[0] * sc, v0[1] * sc); w.y = cvt_pk_bf16(v0[2] * sc, v0[3] * sc); w.z = cvt_pk_bf16(v1[0] * sc, v1[1] * sc); w.w = cvt_pk_bf16(v1[2] * sc, v1[3] * sc);
                            *(u32x4*)(base + (size_t)arow * 768 + cc) = w;
                        }
                    } else {
                        u32x4 w; w.x = cvt_pk_bf16(sigmoidf_(v0[0]), sigmoidf_(v0[1])); w.y = cvt_pk_bf16(sigmoidf_(v0[2]), sigmoidf_(v0[3]));
                        w.z = cvt_pk_bf16(sigmoidf_(v1[0]), sigmoidf_(v1[1])); w.w = cvt_pk_bf16(sigmoidf_(v1[2]), sigmoidf_(v1[3]));
                        *(u32x4*)(G + (size_t)row * 6144 + (c - 5888)) = w;
                    }
                }
            }
    }
};
struct EpiBranch {
    static constexpr bool PERM = true, AFTER_DRAIN = false;
    const bf16_t* G; int goff; float* MF; bf16_t* MB; int mode;
    __device__ __forceinline__ void tail(int row, int c, float v, float) const {
        v *= bf2f(G[(size_t)row * 6144 + goff + c]); bf16_t* mb = MB + (size_t)row * D + c;
        if (mode != 0) v += bf2f(__hip_atomic_load(mb, __ATOMIC_RELAXED, __HIP_MEMORY_SCOPE_AGENT));
        *mb = (bf16_t)f2bf(v);
    }
    __device__ __forceinline__ void operator()(const f32x4 (&acc)[2][2][4][2], const Unit& u, int wr, int wc, int fr, int fq) const {
        const int row0 = u.pm * BM + wr * 64 + fr;
#pragma unroll
        for (int ai = 0; ai < 2; ++ai)
#pragma unroll
            for (int m = 0; m < 4; ++m) {
                const int row = row0 + ai * HALF + m * 16;
#pragma unroll
                for (int bj = 0; bj < 2; ++bj) {
                    const int c = u.pn * BM + bj * HALF + wc * 32 + 8 * fq;
                    const u32x4 gw = *(const u32x4*)(G + (size_t)row * 6144 + goff + c);
                    f32x4 v0 = acc[ai][bj][m][0], v1 = acc[ai][bj][m][1];
                    v0[0] *= bflo(gw.x); v0[1] *= bfhi(gw.x); v0[2] *= bflo(gw.y); v0[3] *= bfhi(gw.y);
                    v1[0] *= bflo(gw.z); v1[1] *= bfhi(gw.z); v1[2] *= bflo(gw.w); v1[3] *= bfhi(gw.w);
                    bf16_t* mb = MB + (size_t)row * D + c;
                    if (mode != 0) { const u32x4 pw = __builtin_nontemporal_load((const u32x4*)mb);
                        v0[0] += bflo(pw.x); v0[1] += bfhi(pw.x); v0[2] += bflo(pw.y); v0[3] += bfhi(pw.y); v1[0] += bflo(pw.z); v1[1] += bfhi(pw.z); v1[2] += bflo(pw.w); v1[3] += bfhi(pw.w); }
                    u32x4 w; w.x = cvt_pk_bf16(v0[0], v0[1]); w.y = cvt_pk_bf16(v0[2], v0[3]); w.z = cvt_pk_bf16(v1[0], v1[1]); w.w = cvt_pk_bf16(v1[2], v1[3]);
                    *(u32x4*)mb = w;
                }
            }
    }
};

struct PanelStats {
    unsigned* xbuf;
    unsigned* cnt;
    float eps;
    __device__ __forceinline__ void run(const f32x4 (&v)[2][2][4][2], const Unit& u, int wr, int wc, int fr, int fq, LAS unsigned char* lds, int wid, int lane) const {
        LAS f32x2* P = (LAS f32x2*)lds;
        LAS f32x2* S = (LAS f32x2*)(lds + 8192);
#pragma unroll
        for (int ai = 0; ai < 2; ++ai)
#pragma unroll
            for (int m = 0; m < 4; ++m) {
                float s = 0.f;
#pragma unroll
                for (int bj = 0; bj < 2; ++bj)
#pragma unroll
                    for (int n = 0; n < 2; ++n) { const f32x4 x = v[ai][bj][m][n]; s += (x[0] + x[1]) + (x[2] + x[3]); }
                s += __shfl_xor(s, 16); s += __shfl_xor(s, 32);
                const float mw = s * (1.0f / 64.0f); float q = 0.f;
#pragma unroll
                for (int bj = 0; bj < 2; ++bj)
#pragma unroll
                    for (int n = 0; n < 2; ++n) { const f32x4 d = v[ai][bj][m][n] - mw; q += (d[0] * d[0] + d[1] * d[1]) + (d[2] * d[2] + d[3] * d[3]); }
                q += __shfl_xor(q, 16); q += __shfl_xor(q, 32);
                if (fq == 0) P[(ai * HALF + wr * 64 + m * 16 + fr) * 4 + wc] = (f32x2){mw, q};
            }
        asm volatile("s_waitcnt lgkmcnt(0)" ::: "memory"); __builtin_amdgcn_s_barrier(); asm volatile("" ::: "memory");
        const int row = wid * 32 + (lane & 31);
        if (lane < 32) {
            const f32x2 a = P[row * 4 + 0], b = P[row * 4 + 1], c = P[row * 4 + 2], d = P[row * 4 + 3];
            const float mt = (a.x + b.x + c.x + d.x) * 0.25f;
            const float da = a.x - mt, db = b.x - mt, dc = c.x - mt, dd = d.x - mt;
            const float m2 = (a.y + b.y) + (c.y + d.y) + 64.0f * ((da * da + db * db) + (dc * dc + dd * dd));
            unsigned long long* slot = (unsigned long long*)xbuf + ((size_t)(u.pm * BM + row) * 8 + u.pn);
            __hip_atomic_store(slot, ((unsigned long long)__float_as_uint(m2) << 32) | __float_as_uint(mt), __ATOMIC_RELAXED, __HIP_MEMORY_SCOPE_AGENT);
        }
        asm volatile("s_waitcnt vmcnt(0)" ::: "memory");
        if (lane == 0) __hip_atomic_fetch_add(cnt + 64 * u.pm, 1u, __ATOMIC_RELAXED, __HIP_MEMORY_SCOPE_AGENT);
        if (wid == 0) {
            unsigned sp = 0;
            while ((unsigned)__builtin_amdgcn_readfirstlane(__hip_atomic_load(cnt + 64 * u.pm, __ATOMIC_RELAXED, __HIP_MEMORY_SCOPE_AGENT)) < 64u) { __builtin_amdgcn_s_sleep(2); if (++sp > (1u << 24)) break; }
            __builtin_amdgcn_fence(__ATOMIC_ACQUIRE, "agent");
        }
        asm volatile("s_waitcnt vmcnt(0) lgkmcnt(0)" ::: "memory"); __builtin_amdgcn_s_barrier(); asm volatile("" ::: "memory");
        if (lane < 32) {
            const unsigned long long* slot = (const unsigned long long*)xbuf + (size_t)(u.pm * BM + row) * 8; float mt[8], m2[8]; float ms = 0.f;
#pragma unroll
            for (int t = 0; t < 8; ++t) { const unsigned long long w = __hip_atomic_load(slot + t, __ATOMIC_RELAXED, __HIP_MEMORY_SCOPE_AGENT); mt[t] = __uint_as_float((unsigned)w); m2[t] = __uint_as_float((unsigned)(w >> 32)); ms += mt[t]; }
            const float mean = ms * 0.125f; float q = 0.f;
#pragma unroll
            for (int t = 0; t < 8; ++t) { const float dm = mt[t] - mean; q += m2[t] + 256.0f * dm * dm; }
            S[row] = (f32x2){mean, 1.0f / sqrtf(q * (1.0f / 2048.0f) + eps)};
        }
        asm volatile("s_waitcnt lgkmcnt(0)" ::: "memory"); __builtin_amdgcn_s_barrier(); asm volatile("" ::: "memory");
    }
};
struct EpiLn {
    static constexpr bool PERM = false, AFTER_DRAIN = true;
    float* H; bf16_t* HB; const float* g; const float* bta; float s; PanelStats st; float* out;
    __device__ __forceinline__ void fused(f32x4 (&acc)[2][2][4][2], const Unit& u, int wr, int wc, int fr, int fq, LAS unsigned char* lds, int wid, int lane) const {
        const LAS f32x2* S = (const LAS f32x2*)(lds + 8192);
        const int col0 = u.pn * BM + wc * 32 + 4 * fq;
#pragma unroll
        for (int ai = 0; ai < 2; ++ai)
#pragma unroll
            for (int m = 0; m < 4; ++m) { const size_t off = (size_t)(u.pm * BM + ai * HALF + wr * 64 + m * 16 + fr) * D + col0;
#pragma unroll
                for (int bj = 0; bj < 2; ++bj)
#pragma unroll
                    for (int n = 0; n < 2; ++n) { const f32x4 h = *(const f32x4*)(H + off + bj * HALF + n * 16); acc[ai][bj][m][n] = h * ALPHA + acc[ai][bj][m][n] * s; }
                asm volatile("" : "+v"(acc[ai][0][m][0]), "+v"(acc[ai][0][m][1]), "+v"(acc[ai][1][m][0]), "+v"(acc[ai][1][m][1]));
                if (m & 1) asm volatile("" ::: "memory"); }
        st.run(acc, u, wr, wc, fr, fq, lds, wid, lane);
#pragma unroll
        for (int ai = 0; ai < 2; ++ai)
#pragma unroll
            for (int m = 0; m < 4; ++m) { const int r = ai * HALF + wr * 64 + m * 16 + fr, row = u.pm * BM + r; const f32x2 sr = S[r];
#pragma unroll
                for (int bj = 0; bj < 2; ++bj)
#pragma unroll
                    for (int n = 0; n < 2; ++n) { const int c = col0 + bj * HALF + n * 16; const f32x4 o = (acc[ai][bj][m][n] - sr.x) * sr.y * *(const f32x4*)(g + c) + *(const f32x4*)(bta + c);
                        if (out) { const int b_ = row >= L ? 1 : 0, t_ = row - b_ * L; if (t_ >= NMETA) *(f32x4*)(out + ((size_t)b_ * SEQ + (t_ - NMETA)) * D + c) = o; }
                        else { *(f32x4*)(H + (size_t)row * D + c) = o; u32x2 w; w.x = cvt_pk_bf16(o[0], o[1]); w.y = cvt_pk_bf16(o[2], o[3]); *(u32x2*)(HB + (size_t)row * D + c) = w; } } }
    }
};
}


constexpr int MT = 8192;
template <class Epi, bool PAIR>
__device__ __forceinline__ void tail_gemm(const bf16_t* A, const bf16_t* Bt, int K, int ncols, const Epi& E, unsigned char* lds_g, int blk, int nblk) {
    const int tid = opq_v((int)threadIdx.x), lane = tid & 63, wid = __builtin_amdgcn_readfirstlane(tid >> 6), m = lane & 31, hi = lane >> 5;
    float* P = (float*)lds_g;
    const int kslice = K / 8, k0 = wid * kslice;
    for (int tu = blk; tu < ncols / 32; tu += nblk) {
        const int n0 = tu * 32, brow = PAIR ? ((n0 / 128) * 256 + (n0 % 128)) : n0;
        const bf16_t* ap = A + (size_t)(MT + m) * K + k0 + 8 * hi; const bf16_t* bp = Bt + (size_t)(brow + m) * K + k0 + 8 * hi;
        f32x16_t acc0 = (f32x16_t){0.f, 0.f, 0.f, 0.f, 0.f, 0.f, 0.f, 0.f, 0.f, 0.f, 0.f, 0.f, 0.f, 0.f, 0.f, 0.f}, acc1 = acc0;
#pragma unroll 8
        for (int ks = 0; ks < kslice; ks += 16) {
            const bf16x8 av = *(const bf16x8*)(ap + ks), bv = *(const bf16x8*)(bp + ks);
            acc0 = __builtin_amdgcn_mfma_f32_32x32x16_bf16(av, bv, acc0, 0, 0, 0);
            if (PAIR) { const bf16x8 bu = *(const bf16x8*)(bp + (size_t)128 * K + ks); acc1 = __builtin_amdgcn_mfma_f32_32x32x16_bf16(av, bu, acc1, 0, 0, 0); }
        }
        __syncthreads();
#pragma unroll
        for (int r = 0; r < 16; ++r) { const int rm = (r & 3) + 8 * (r >> 2) + 4 * hi; P[wid * 1024 + rm * 32 + m] = acc0[r]; if (PAIR) P[8192 + wid * 1024 + rm * 32 + m] = acc1[r]; }
        __syncthreads();
#pragma unroll
        for (int e = 0; e < 2; ++e) { const int idx = tid * 2 + e; float v0 = 0.f, v1 = 0.f;
#pragma unroll
            for (int w = 0; w < 8; ++w) { v0 += P[w * 1024 + idx]; if (PAIR) v1 += P[8192 + w * 1024 + idx]; }
            E.tail(MT + (idx >> 5), n0 + (idx & 31), v0, v1); }
    }
    __syncthreads();
}

struct Args {
    const float* x; const float* meta; const float* ln_g; const float* ln_b; const float* ffn_w_in; const float* ffn_w_out; const float* w_in;
    const float* pool_w; const float* pool_scale; const float* hgrn_lb; const float* hgrn_ng; const float* diff_lambda; const float* diff_ng;
    const float* w_bp; const float* w_bh; const float* w_bd; const float* w_out;
    float* out; unsigned char* ws;
};

typedef const Args* ArgP;
__device__ __forceinline__ ArgP argp() { unsigned z; asm volatile("s_mov_b32 %0, 0" : "=s"(z)); return (ArgP)(const void*)((const __attribute__((address_space(4))) char*)__builtin_amdgcn_kernarg_segment_ptr() + z); }

__device__ __forceinline__ void transpose_item(const float* W, int K, int N, bf16_t* WT, int swiglu, float* scr, int item, int lane) {
    const int nblk = N / 64, kb = item / nblk, nb = item % nblk, k0 = 64 * kb, n0 = 64 * nb;
    int drow0 = n0;
    if (swiglu) { const int half = n0 / DFF, rem = n0 % DFF; drow0 = (rem / 128) * 256 + half * 128 + (rem % 128); }
    f32x4 v[16];
#pragma unroll
    for (int i = 0; i < 16; ++i) v[i] = *(const f32x4*)(W + (size_t)(k0 + 4 * i + (lane >> 4)) * N + n0 + 4 * (lane & 15));
#pragma unroll
    for (int i = 0; i < 16; ++i) { float* s = scr + (4 * i + (lane >> 4)) * 65 + 4 * (lane & 15); s[0] = v[i][0]; s[1] = v[i][1]; s[2] = v[i][2]; s[3] = v[i][3]; }
    asm volatile("s_waitcnt lgkmcnt(0)" ::: "memory");
    const int c = lane & 7;
#pragma unroll
    for (int j = 0; j < 8; ++j) { const int n = (lane >> 3) + 8 * j; const float* s = scr + (8 * c) * 65 + n;
        u32x4 o; o.x = pk2(s[0 * 65], s[1 * 65]); o.y = pk2(s[2 * 65], s[3 * 65]); o.z = pk2(s[4 * 65], s[5 * 65]); o.w = pk2(s[6 * 65], s[7 * 65]);
        *(u32x4*)(WT + (size_t)(drow0 + n) * K + k0 + 8 * c) = o; }
    asm volatile("s_waitcnt lgkmcnt(0)" ::: "memory");
}

__device__ __forceinline__ void prologue(unsigned char* lds_g, int gw, int NGW, int lane) {
    const Args a = *argp();
    float* scr = (float*)lds_g + (opq_v((int)threadIdx.x) >> 6) * (64 * 65);
    unsigned char* ws = a.ws;
    constexpr int I_UP = (D / 64) * (2 * DFF / 64), I_DN = (DFF / 64) * (D / 64), I_IN = (D / 64) * (INCOLS / 64);
    constexpr int I_BP = (PW / 64) * (D / 64), I_BH = (HW / 64) * (D / 64), I_WO = (D / 64) * (D / 64);
    constexpr int PER_L = 2 * I_UP + 2 * I_DN + I_IN + I_BP + 2 * I_BH + I_WO;
    for (int it = gw; it < 2 * PER_L; it += NGW) {
        const int l = it / PER_L; int r = it % PER_L;
        if (r < 2 * I_UP) { const int j = r / I_UP; r %= I_UP; transpose_item(a.ffn_w_in + (size_t)(l * 2 + j) * D * 2 * DFF, D, 2 * DFF, (bf16_t*)(ws + WS_WUP + (size_t)(l * 2 + j) * SZ_WUP), 1, scr, r, lane); continue; } r -= 2 * I_UP;
        if (r < 2 * I_DN) { const int j = r / I_DN; r %= I_DN; transpose_item(a.ffn_w_out + (size_t)(l * 2 + j) * DFF * D, DFF, D, (bf16_t*)(ws + WS_WDN + (size_t)(l * 2 + j) * SZ_WDN), 0, scr, r, lane); continue; } r -= 2 * I_DN;
        if (r < I_IN) { transpose_item(a.w_in + (size_t)l * D * INCOLS, D, INCOLS, (bf16_t*)(ws + WS_WIN + (size_t)l * SZ_WIN), 0, scr, r, lane); continue; } r -= I_IN;
        if (r < I_BP) { transpose_item(a.w_bp + (size_t)l * PW * D, PW, D, (bf16_t*)(ws + WS_WBP + (size_t)l * D * PW * 2), 0, scr, r, lane); continue; } r -= I_BP;
        if (r < I_BH) { transpose_item(a.w_bh + (size_t)l * HW * D, HW, D, (bf16_t*)(ws + WS_WBH + (size_t)l * D * HW * 2), 0, scr, r, lane); continue; } r -= I_BH;
        if (r < I_BH) { transpose_item(a.w_bd + (size_t)l * DW * D, DW, D, (bf16_t*)(ws + WS_WBD + (size_t)l * D * DW * 2), 0, scr, r, lane); continue; } r -= I_BH;
        transpose_item(a.w_out + (size_t)l * D * D, D, D, (bf16_t*)(ws + WS_WO + (size_t)l * D * D * 2), 0, scr, r, lane);
    }
    float* H = (float*)(ws + WS_H); bf16_t* HB = (bf16_t*)(ws + WS_HB);
    for (int r = gw; r < MP; r += NGW) {
        const float* src = nullptr;
        if (r < T) { const int b = r / L, t = r % L; src = t < NMETA ? a.meta + (size_t)t * D : a.x + ((size_t)b * SEQ + (t - NMETA)) * D; }
#pragma unroll
        for (int j = 0; j < 8; ++j) {
            f32x4 v = src ? *(const f32x4*)(src + 4 * lane + 256 * j) : (f32x4){0.f, 0.f, 0.f, 0.f};
            *(f32x4*)(H + (size_t)r * D + 4 * lane + 256 * j) = v;
            u32x2 w; w.x = pk2(v[0], v[1]); w.y = pk2(v[2], v[3]);
            *(u32x2*)(HB + (size_t)r * D + 4 * lane + 256 * j) = w;
        }
    }
    for (int i = gw; i < NB * (LP - L) * 2; i += NGW) {
        const int seg = i / (NB * (LP - L)), rr = i % (NB * (LP - L)), b = rr / (LP - L), t = L + rr % (LP - L);
        bf16_t* base = (bf16_t*)(ws + WS_QA + (size_t)seg * (WS_KA - WS_QA)) + (size_t)(b * LP + t) * 768;
        for (int c = lane; c < 768 / 8; c += 64) *(u32x4*)(base + 8 * c) = (u32x4){0u, 0u, 0u, 0u};
    }
    for (int i = gw; i < NB * 768; i += NGW) {
        bf16_t* base = (bf16_t*)(ws + WS_VA) + (size_t)i * LP + L;
        for (int c = lane; c < (LP - L) / 8; c += 64) *(u32x4*)(base + 8 * c) = (u32x4){0u, 0u, 0u, 0u};
    }
}

__device__ __forceinline__ void ln_rows(int lnidx, bool final_, int r_begin, int r_end, int gw, int NGW, int lane) {
    const Args a = *argp(); const float* g = a.ln_g + (size_t)lnidx * D; const float* bvec = a.ln_b + (size_t)lnidx * D;
    const float* PRE = (const float*)(a.ws + WS_PRE); float* H = (float*)(a.ws + WS_H); bf16_t* HB = (bf16_t*)(a.ws + WS_HB);
    for (int r = r_begin + gw; r < r_end; r += NGW) {
        f32x4 v[8]; float s = 0.f;
#pragma unroll
        for (int j = 0; j < 8; ++j) { v[j] = *(const f32x4*)(PRE + (size_t)r * D + 4 * lane + 256 * j); s += (v[j][0] + v[j][1]) + (v[j][2] + v[j][3]); }
        const float mean = wave_sum(s) * (1.f / D); float s2 = 0.f;
#pragma unroll
        for (int j = 0; j < 8; ++j) { v[j] = v[j] - mean; s2 += (v[j][0] * v[j][0] + v[j][1] * v[j][1]) + (v[j][2] * v[j][2] + v[j][3] * v[j][3]); }
        const float rstd = 1.f / sqrtf(wave_sum(s2) * (1.f / D) + LN_EPS);
        if (final_) {
            const int b = r / L, t = r % L;
            if (t >= NMETA) {
                float* o = a.out + ((size_t)b * SEQ + (t - NMETA)) * D;
#pragma unroll
                for (int j = 0; j < 8; ++j) { const f32x4 gg = *(const f32x4*)(g + 4 * lane + 256 * j), bb = *(const f32x4*)(bvec + 4 * lane + 256 * j); *(f32x4*)(o + 4 * lane + 256 * j) = v[j] * rstd * gg + bb; }
            }
        } else {
#pragma unroll
            for (int j = 0; j < 8; ++j) { const f32x4 gg = *(const f32x4*)(g + 4 * lane + 256 * j), bb = *(const f32x4*)(bvec + 4 * lane + 256 * j); const f32x4 o = v[j] * rstd * gg + bb;
                *(f32x4*)(H + (size_t)r * D + 4 * lane + 256 * j) = o; u32x2 w; w.x = pk2(o[0], o[1]); w.y = pk2(o[2], o[3]); *(u32x2*)(HB + (size_t)r * D + 4 * lane + 256 * j) = w; }
        }
    }
}

__device__ __forceinline__ void pool_phase(int l, unsigned char* lds_g, int blk, int nblk) {
    const Args a = *argp();
    const float* ZP = (const float*)(a.ws + WS_ZP); bf16_t* YP = (bf16_t*)(a.ws + WS_YP);
    constexpr int WP = 136;
    bf16_t* WT = (bf16_t*)lds_g;
    bf16_t* Pb = WT + 128 * WP;
    float* U = (float*)(lds_g + 53248);
    const int tid = opq_v((int)threadIdx.x), lane = tid & 63, wid = tid >> 6, r32 = lane & 31, hi = lane >> 5;
    const int g = blk & 3, bi = blk >> 2, nb = nblk >> 2, w = 2 << g;
    const float* Wg = a.pool_w + ((size_t)l * 4 + g) * 128 * 128;
    for (int i = tid; i < 128 * 32; i += 512) { const int c = i >> 5, d4 = i & 31; const f32x4 v = *(const f32x4*)(Wg + c * 128 + 4 * d4);
        WT[(4 * d4 + 0) * WP + c] = (bf16_t)f2bf(v[0]); WT[(4 * d4 + 1) * WP + c] = (bf16_t)f2bf(v[1]); WT[(4 * d4 + 2) * WP + c] = (bf16_t)f2bf(v[2]); WT[(4 * d4 + 3) * WP + c] = (bf16_t)f2bf(v[3]); }
    const int dt = wid & 3, tt = wid >> 2;
    const float scv = a.pool_scale[l * PW + g * 128 + 32 * dt + r32];
    constexpr int TPB = (L + 63) / 64;
    for (int tile = bi; tile < NB * TPB; tile += nb) {
        const int b = tile / TPB, t0 = (tile % TPB) * 64;
        __syncthreads();
        for (int i = tid; i < 79 * 32; i += 512) { const int rr = i >> 5, c4 = i & 31, t = t0 - 15 + rr;
            ((f32x4*)U)[i] = (t >= 0 && t < L) ? *(const f32x4*)(ZP + (size_t)(b * L + t) * PW + g * 128 + 4 * c4) : (f32x4){0.f, 0.f, 0.f, 0.f}; }
        __syncthreads();
        { const int c = tid & 127, ts = (tid >> 7) * 16;
            float s_ = 0.f;
            for (int q = 1; q < w; ++q) { const int t = t0 + ts - q; if (t >= 0) s_ += U[(ts - q + 15) * 128 + c]; }
            for (int k = 0; k < 16; ++k) { const int ti = ts + k, t = t0 + ti; const float ut = U[(ti + 15) * 128 + c]; s_ += ut;
                const int cnt = (t + 1) < w ? (t + 1) : w;
                Pb[ti * WP + c] = (bf16_t)f2bf(s_ / (float)cnt - ut);
                if (t + 1 - w >= 0) s_ -= U[(ti + 15 - w + 1) * 128 + c]; } }
        __syncthreads();
        f32x16_t acc = (f32x16_t){0.f, 0.f, 0.f, 0.f, 0.f, 0.f, 0.f, 0.f, 0.f, 0.f, 0.f, 0.f, 0.f, 0.f, 0.f, 0.f};
#pragma unroll
        for (int i = 0; i < 8; ++i) { const bf16x8 av = *(const bf16x8*)(Pb + (32 * tt + r32) * WP + 16 * i + 8 * hi), bv = *(const bf16x8*)(WT + (32 * dt + r32) * WP + 16 * i + 8 * hi);
            acc = __builtin_amdgcn_mfma_f32_32x32x16_bf16(av, bv, acc, 0, 0, 0); }
#pragma unroll
        for (int r = 0; r < 16; ++r) { const int t = t0 + 32 * tt + (r & 3) + 8 * (r >> 2) + 4 * hi;
            if (t < L) YP[(size_t)(b * L + t) * PW + g * 128 + 32 * dt + r32] = (bf16_t)f2bf(acc[r] * scv); }
    }
    __syncthreads();
}

__device__ __forceinline__ void hgrn_naive(int l, unsigned char* lds_g, int blk) {
    const Args a = *argp();
    const float* ZH = (const float*)(a.ws + WS_ZH); float* OH = (float*)(a.ws + WS_OH);
    const int tid = opq_v((int)threadIdx.x), ch = tid >> 8, j = tid & 127, kh = (tid >> 7) & 1, chain = blk * 2 + ch, b = chain / 6, h = chain % 6;
    float* sh = (float*)lds_g + ch * 640;
    float lb = 0.f;
    if (l == 1) { const float x0 = a.hgrn_lb[h * 128 + j], x1 = a.hgrn_lb[HW + h * 128 + j]; const float e0 = __expf(x0), e1 = __expf(x1); lb = e1 / (e0 + e1); }
    float S[64];
#pragma unroll
    for (int k = 0; k < 64; ++k) S[k] = 0.f;
    for (int t = 0; t < L; ++t) {
        const float* z = ZH + (size_t)(b * L + t) * 3072 + h * 128;
        if (kh == 0) { const float fz = z[768 + j], f = lb + (1.f - lb) * (1.f / (1.f + __expf(-fz))); sh[j] = f; sh[128 + j] = 1.f - f; sh[256 + j] = z[j]; }
        const float vj = z[1536 + j];
        __syncthreads();
        float o = 0.f;
#pragma unroll
        for (int k4 = 0; k4 < 16; ++k4) {
            const f32x4 f4 = *(const f32x4*)(sh + kh * 64 + 4 * k4), k4v = *(const f32x4*)(sh + 128 + kh * 64 + 4 * k4), q4 = *(const f32x4*)(sh + 256 + kh * 64 + 4 * k4);
#pragma unroll
            for (int e = 0; e < 4; ++e) { S[4 * k4 + e] = f4[e] * S[4 * k4 + e] + k4v[e] * vj; o += q4[e] * S[4 * k4 + e]; }
        }
        sh[384 + kh * 128 + j] = o;
        __syncthreads();
        if (kh == 0) OH[(size_t)(b * L + t) * HW + h * 128 + j] = (sh[384 + j] + sh[512 + j]) * 0.08838834764831845f;
    }
}

__device__ __forceinline__ void attn_naive(int blk, int nblk) {
    const Args a = *argp();
    const bf16_t* QA = (const bf16_t*)(a.ws + WS_QA); const bf16_t* KA = (const bf16_t*)(a.ws + WS_KA); const bf16_t* VA = (const bf16_t*)(a.ws + WS_VA);
    float* OD = (float*)(a.ws + WS_OD);
    const int tid = opq_v((int)threadIdx.x), wid = tid >> 6;
    for (int unit = blk; unit < NB * 12 * 4 * 9; unit += nblk) {
        const int qc = unit % 9, vq = (unit / 9) & 3, vh = (unit / 36) % 12, b = unit / 432, h = vh >> 1;
        const int q = qc * 512 + tid; const int qq = q < L ? q : L - 1;
        float qf[64];
        { const bf16_t* qp = QA + (size_t)(b * LP + qq) * 768 + vh * 64;
#pragma unroll
            for (int i = 0; i < 8; ++i) { const u32x4 w = *(const u32x4*)(qp + 8 * i); qf[8 * i] = bflo(w.x); qf[8 * i + 1] = bfhi(w.x); qf[8 * i + 2] = bflo(w.y); qf[8 * i + 3] = bfhi(w.y); qf[8 * i + 4] = bflo(w.z); qf[8 * i + 5] = bfhi(w.z); qf[8 * i + 6] = bflo(w.w); qf[8 * i + 7] = bfhi(w.w); } }
        int kmax = qc * 512 + wid * 64 + 63; if (kmax > L - 1) kmax = L - 1;
        kmax = __builtin_amdgcn_readfirstlane(kmax);
        float mx = -INFINITY, lsum = 0.f, o[32];
#pragma unroll
        for (int i = 0; i < 32; ++i) o[i] = 0.f;
        for (int key = 0; key <= kmax; ++key) {
            const bf16_t* kp = KA + (size_t)(b * LP + key) * 768 + vh * 64;
            float s = 0.f;
#pragma unroll
            for (int i = 0; i < 8; ++i) { const u32x4 w = *(const u32x4*)(kp + 8 * i);
                s += qf[8 * i] * bflo(w.x) + qf[8 * i + 1] * bfhi(w.x) + qf[8 * i + 2] * bflo(w.y) + qf[8 * i + 3] * bfhi(w.y) + qf[8 * i + 4] * bflo(w.z) + qf[8 * i + 5] * bfhi(w.z) + qf[8 * i + 6] * bflo(w.w) + qf[8 * i + 7] * bfhi(w.w); }
            if (key <= qq) {
                const float mn = fmaxf(mx, s), al_ = __builtin_amdgcn_exp2f(mx - mn), p = __builtin_amdgcn_exp2f(s - mn);
                lsum = lsum * al_ + p; mx = mn;
                const bf16_t* vp = VA + (size_t)(b * LP + key) * 768 + h * 128 + vq * 32;
#pragma unroll
                for (int i = 0; i < 4; ++i) { const u32x4 w = *(const u32x4*)(vp + 8 * i);
                    o[8 * i] = o[8 * i] * al_ + p * bflo(w.x); o[8 * i + 1] = o[8 * i + 1] * al_ + p * bfhi(w.x); o[8 * i + 2] = o[8 * i + 2] * al_ + p * bflo(w.y); o[8 * i + 3] = o[8 * i + 3] * al_ + p * bfhi(w.y);
                    o[8 * i + 4] = o[8 * i + 4] * al_ + p * bflo(w.z); o[8 * i + 5] = o[8 * i + 5] * al_ + p * bfhi(w.z); o[8 * i + 6] = o[8 * i + 6] * al_ + p * bflo(w.w); o[8 * i + 7] = o[8 * i + 7] * al_ + p * bfhi(w.w); }
            }
        }
        if (q < L) { const float rl = 1.f / lsum; float* op = OD + ((size_t)(b * LP + q) * 12 + vh) * 128 + vq * 32;
#pragma unroll
            for (int i = 0; i < 8; ++i) *(f32x4*)(op + 4 * i) = (f32x4){o[4 * i] * rl, o[4 * i + 1] * rl, o[4 * i + 2] * rl, o[4 * i + 3] * rl}; }
    }
}


constexpr int HC = 32, HNC = (L + HC - 1) / HC;
constexpr int HR_QP = 136  , HR_Q = 0, HR_K = HC * HR_QP * 2  , HR_A = HR_K + 128 * HC * 2  , HR_D = HR_A + HC * HC * 2  , HR_SH = HR_D + 512  ;
constexpr int HR_V = HR_SH, HR_VH = 64 * HC * 2  , HR_BYTES = HR_SH + 2 * HR_VH  , HS_BYTES = HR_SH + HR_VH  ;
constexpr int HG_NS = 4;
constexpr size_t WS_REC = WS_END_HG;
constexpr size_t WS_END2 = WS_REC + (size_t)12 * 257 * 14336;
constexpr size_t WS_XB = WS_END2, WS_END3 = WS_XB + (size_t)8192 * 8 * 8;
static_assert(12 * HNC * HR_BYTES <= 12 * 257 * 14336 && HG_NS * HS_BYTES + 16384 <= 131072 && HR_SH % 1024 == 0, "hgrn record / ring / output staging");

__device__ __forceinline__ void hgrn_pre(int l, unsigned char* lds_g, int blk, int nblk) {
    const Args a = *argp();
    const float* ZH = (const float*)(a.ws + WS_ZH); unsigned char* REC = a.ws + WS_REC;
    const int tid = opq_v((int)threadIdx.x);
    constexpr int HP = 132;
    float* lf = (float*)lds_g; float* kk = lf + HC * HP; float* qs = kk + HC * HP; float* bc = qs + HC * HP; float* vv = bc + HC * HP;
    for (int rec = blk; rec < 12 * HNC; rec += nblk) {
        const int bh = rec / HNC, c = rec % HNC, b = bh / 6, h = bh % 6;
        const size_t r0 = (size_t)b * L + HC * c;
        float lb = 0.f;
        if (l == 1) { const int k = tid & 127; const float x0 = a.hgrn_lb[h * 128 + k], x1 = a.hgrn_lb[HW + h * 128 + k]; const float e0 = __expf(x0), e1 = __expf(x1); lb = e1 / (e0 + e1); }
        for (int idx = tid; idx < HC * 128; idx += 512) {
            const int t = idx >> 7, k = idx & 127;
            float lfv = 0.f, kv = 0.f, qv = 0.f, vvv = 0.f;
            if (HC * c + t < L) {
                const float* z = ZH + (r0 + t) * 3072 + h * 128 + k;
                const float f = lb + (1.f - lb) * (1.f / (1.f + __expf(-z[768])));
                lfv = __logf(f); kv = 1.f - f; qv = bf2f(((const bf16_t*)(a.ws + WS_HQ))[(r0 + t) * HW + h * 128 + k]) * 0.08838834764831845f; vvv = bf2f(((const bf16_t*)(a.ws + WS_HV))[(r0 + t) * HW + h * 128 + k]);
            }
            lf[t * HP + k] = lfv; kk[t * HP + k] = kv; qs[t * HP + k] = qv; vv[t * HP + k] = vvv;
        }
        __syncthreads();
        if (tid < 128) { float cv[HC];
#pragma unroll
            for (int t = 0; t < HC; ++t) cv[t] = lf[t * HP + tid];
            float run = 0.f;
#pragma unroll
            for (int t = 0; t < HC; ++t) { run += cv[t]; bc[t * HP + tid] = run; } }
        __syncthreads();
        unsigned char* R = REC + (size_t)rec * HR_BYTES;
        for (int idx = tid; idx < HC * 128; idx += 512) {
            { const int t = idx >> 7, k = idx & 127; ((bf16_t*)(R + HR_Q))[t * HR_QP + k] = (bf16_t)f2bf(qs[t * HP + k] * __expf(bc[t * HP + k])); }
            { const int k = idx >> 5, s_ = idx & 31; ((bf16_t*)(R + HR_K))[idx] = (bf16_t)f2bf(kk[s_ * HP + k] * __expf(bc[(HC - 1) * HP + k] - bc[s_ * HP + k]));
              ((bf16_t*)(R + HR_V))[idx] = (bf16_t)f2bf(vv[s_ * HP + k]); }
        }
        if (tid < 128) ((float*)(R + HR_D))[tid] = __expf(bc[(HC - 1) * HP + tid]);
#pragma unroll
        for (int e = 0; e < 2; ++e) { const int p = tid + 512 * e, t = p >> 5, s_ = p & 31; float acc = 0.f;
            if (s_ <= t) {
#pragma unroll 2
                for (int k = 0; k < 128; k += 4) { const f32x4 q4 = *(const f32x4*)(qs + t * HP + k), k4 = *(const f32x4*)(kk + s_ * HP + k), bt = *(const f32x4*)(bc + t * HP + k), bs = *(const f32x4*)(bc + s_ * HP + k);
                    acc += q4[0] * k4[0] * __expf(bt[0] - bs[0]) + q4[1] * k4[1] * __expf(bt[1] - bs[1]) + q4[2] * k4[2] * __expf(bt[2] - bs[2]) + q4[3] * k4[3] * __expf(bt[3] - bs[3]); } }
            ((bf16_t*)(R + HR_A))[p] = (bf16_t)f2bf(acc); }
        __syncthreads();
    }
}

__device__ __forceinline__ void hgrn_scan(int bh, int vhalf, LAS unsigned char* ldsl) {
    const Args a = *argp();
    const unsigned char* REC = a.ws + WS_REC + (size_t)bh * HNC * HR_BYTES; float* OH = (float*)(a.ws + WS_OH);
    const int tid = opq_v((int)threadIdx.x), lane = tid & 63, wid = __builtin_amdgcn_readfirstlane(tid >> 6), n = lane & 15, g = lane >> 4;
    const int b = bh / 6, h = bh % 6;
    const bool loader = wid < 4 || wid >= 6; const int li = wid < 4 ? wid : wid - 2; const bool four = loader && li < 5;
    LAS unsigned char* OST = ldsl + HG_NS * HS_BYTES;
#define HG_PIECE(q_) do { const int pb_ = 384 * (q_) + 64 * li;   \
        const unsigned char* s_ = (pb_ < 1216 ? rsrc_ + (size_t)pb_ * 16 : rsrc_ + HR_SH + HR_VH * vhalf + (size_t)(pb_ - 1216) * 16) + lane * 16; \
        __builtin_amdgcn_global_load_lds((const unsigned*)s_, (LAS unsigned*)(rdst_ + pb_ * 16), 16, 0, 0); } while (0)
#define HG_DMA(cc) do { if (loader) { const int c_ = (cc) < HNC ? (cc) : HNC - 1; const unsigned char* rsrc_ = REC + (size_t)c_ * HR_BYTES; LAS unsigned char* rdst_ = ldsl + ((cc) % HG_NS) * HS_BYTES; \
        HG_PIECE(0); HG_PIECE(1); HG_PIECE(2); if (four) HG_PIECE(3); } } while (0)
#define HG_OUT(ss) do { const LAS float* src_ = (const LAS float*)(OST + ((ss) & 1) * 8192); const int e_ = (wid - 4) * 64 + lane; \
        _Pragma("unroll") for (int q_ = 0; q_ < 4; ++q_) { const int idx_ = e_ + 128 * q_, t_ = idx_ >> 4, c4_ = idx_ & 15;    \
            if (HC * (ss) + t_ < L) { const f32x4 v_ = *(const LAS f32x4*)(src_ + (c4_ >> 2) * 512 + t_ * 16 + (c4_ & 3) * 4); \
                u32x2 w_; w_.x = pg8::cvt_pk_bf16(v_[0], v_[1]); w_.y = pg8::cvt_pk_bf16(v_[2], v_[3]);                    \
                *(u32x2*)((bf16_t*)OH + ((size_t)b * L + HC * (ss) + t_) * HW + h * 128 + 64 * vhalf + 4 * c4_) = w_; } } } while (0)
    f32x4 S[8];
#pragma unroll
    for (int i = 0; i < 8; ++i) S[i] = (f32x4){0.f, 0.f, 0.f, 0.f};
    for (int c = 0; c < HG_NS - 1; ++c) HG_DMA(c);
    for (int s_ = 0; s_ < HNC; ++s_) {
        if (four) asm volatile("s_waitcnt vmcnt(8)" ::: "memory"); else if (loader) asm volatile("s_waitcnt vmcnt(6)" ::: "memory");
        asm volatile("s_waitcnt lgkmcnt(0)" ::: "memory");
        __builtin_amdgcn_s_barrier();
        asm volatile("" ::: "memory");
        const LAS unsigned char* R = ldsl + (s_ % HG_NS) * HS_BYTES;
        if ((wid == 4 || wid == 5) && s_ > 0) HG_OUT(s_ - 1);
        if (wid < 4) {
            s16x4 qa0[2][4], qa1[2][4]; bf16x8 at[2], ka[8], vb; f32x4 dv[8];
#pragma unroll
            for (int mt = 0; mt < 2; ++mt)
#pragma unroll
                for (int kb = 0; kb < 4; ++kb) { qa0[mt][kb] = *(const LAS s16x4*)(R + HR_Q + ((16 * mt + n) * HR_QP + 32 * kb + 4 * g) * 2); qa1[mt][kb] = *(const LAS s16x4*)(R + HR_Q + ((16 * mt + n) * HR_QP + 32 * kb + 16 + 4 * g) * 2); }
            vb = *(const LAS bf16x8*)(R + HR_SH + ((16 * wid + n) * HC + 8 * g) * 2);
#pragma unroll
            for (int mt = 0; mt < 2; ++mt) at[mt] = *(const LAS bf16x8*)(R + HR_A + ((16 * mt + n) * HC + 8 * g) * 2);
#pragma unroll
            for (int kt = 0; kt < 8; ++kt) { ka[kt] = *(const LAS bf16x8*)(R + HR_K + ((16 * kt + n) * HC + 8 * g) * 2); dv[kt] = *(const LAS f32x4*)(R + HR_D + (16 * kt + 4 * g) * 4); }
            asm volatile("s_waitcnt lgkmcnt(0)" ::: "memory");
            __builtin_amdgcn_sched_barrier(0);
            f32x4 o0 = (f32x4){0.f, 0.f, 0.f, 0.f}, o1 = o0;
            o0 = __builtin_amdgcn_mfma_f32_16x16x32_bf16(at[0], vb, o0, 0, 0, 0);
            o1 = __builtin_amdgcn_mfma_f32_16x16x32_bf16(at[1], vb, o1, 0, 0, 0);
#pragma unroll
            for (int kb = 0; kb < 4; ++kb) {
                u32x4 w; w.x = pg8::cvt_pk_bf16(S[2 * kb][0], S[2 * kb][1]); w.y = pg8::cvt_pk_bf16(S[2 * kb][2], S[2 * kb][3]); w.z = pg8::cvt_pk_bf16(S[2 * kb + 1][0], S[2 * kb + 1][1]); w.w = pg8::cvt_pk_bf16(S[2 * kb + 1][2], S[2 * kb + 1][3]);
                const bf16x8 sb = __builtin_bit_cast(bf16x8, w);
                const bf16x8 q0 = (bf16x8){qa0[0][kb][0], qa0[0][kb][1], qa0[0][kb][2], qa0[0][kb][3], qa1[0][kb][0], qa1[0][kb][1], qa1[0][kb][2], qa1[0][kb][3]};
                const bf16x8 q1 = (bf16x8){qa0[1][kb][0], qa0[1][kb][1], qa0[1][kb][2], qa0[1][kb][3], qa1[1][kb][0], qa1[1][kb][1], qa1[1][kb][2], qa1[1][kb][3]};
                o0 = __builtin_amdgcn_mfma_f32_16x16x32_bf16(q0, sb, o0, 0, 0, 0);
                o1 = __builtin_amdgcn_mfma_f32_16x16x32_bf16(q1, sb, o1, 0, 0, 0);
            }
#pragma unroll
            for (int kt = 0; kt < 8; ++kt) S[kt] = __builtin_amdgcn_mfma_f32_16x16x32_bf16(ka[kt], vb, S[kt] * dv[kt], 0, 0, 0);
            { LAS float* st = (LAS float*)(OST + (s_ & 1) * 8192) + wid * 512 + (4 * g) * 16 + n;
#pragma unroll
                for (int jj = 0; jj < 4; ++jj) { st[jj * 16] = o0[jj]; st[256 + jj * 16] = o1[jj]; } }
        }
        HG_DMA(s_ + HG_NS - 1);
    }
    asm volatile("s_waitcnt vmcnt(0) lgkmcnt(0)" ::: "memory");
    __builtin_amdgcn_s_barrier();
    asm volatile("" ::: "memory");
    if (wid == 4 || wid == 5) HG_OUT(HNC - 1);
    asm volatile("s_waitcnt vmcnt(0) lgkmcnt(0)" ::: "memory");
    __builtin_amdgcn_s_barrier();
#undef HG_PIECE
#undef HG_DMA
#undef HG_OUT
}

typedef float f32x16 __attribute__((ext_vector_type(16)));
constexpr int AT_KP = 72, AT_VP = 68;
constexpr int AT_KB = 64 * AT_KP * 2, AT_VB = 128 * AT_VP * 2, AT_BUF = AT_KB + AT_VB;
__device__ __forceinline__ int crow(int r, int hi) { return (r & 3) + 8 * (r >> 2) + 4 * hi; }
__device__ __forceinline__ void attn_phase(int l, unsigned char* lds_g, LAS unsigned char* ldsl, unsigned* qctr, int nunits_hg) {
    const Args a = *argp();
    const bf16_t* QA = (const bf16_t*)(a.ws + WS_QA); const bf16_t* KA = (const bf16_t*)(a.ws + WS_KA); const bf16_t* VA = (const bf16_t*)(a.ws + WS_VA);
    float* OD = (float*)(a.ws + WS_OD);
    const int tid = opq_v((int)threadIdx.x), lane = tid & 63, wid = __builtin_amdgcn_readfirstlane(tid >> 6), r32 = lane & 31, hi = lane >> 5;
    int* sh_u = (int*)(lds_g + 131072 + 64);
    for (;;) {
        __syncthreads();
        if (tid == 0) *sh_u = (int)atomicAdd(qctr, 1u);
        __syncthreads();
        const int u = *sh_u - nunits_hg;
        if (u >= NB * 12 * 17) break;
        if (u < 0) { const int hu = u + nunits_hg; hgrn_scan(hu >> 1, hu & 1, ldsl); continue; }
        const int qb = 16 - u / 24, bv = u % 24, b = bv / 12, vh = bv % 12, h = vh >> 1;
        const int q0 = qb * 256, NT = (q0 + 256) / 64;
        const int qw = q0 + wid * 32;
        const bf16_t* Kb = KA + (size_t)b * LP * 768 + vh * 64; const bf16_t* Vb = VA + ((size_t)b * 768 + h * 128) * LP;
        bf16x8 qr[4];
#pragma unroll
        for (int i = 0; i < 4; ++i) qr[i] = *(const bf16x8*)(QA + (size_t)(b * LP + qw + r32) * 768 + vh * 64 + 16 * i + 8 * hi);
        f32x16 o[4];
#pragma unroll
        for (int d = 0; d < 4; ++d) o[d] = (f32x16){0.f, 0.f, 0.f, 0.f, 0.f, 0.f, 0.f, 0.f, 0.f, 0.f, 0.f, 0.f, 0.f, 0.f, 0.f, 0.f};
        float mrun = -INFINITY, lrun = 0.f;
        const int kr = tid >> 3, kc = tid & 7;
        u32x4 kreg0, vreg00, vreg01, kreg1, vreg10, vreg11, kreg2, vreg20, vreg21, kreg3, vreg30, vreg31;
#define AT_LOAD(t, KR, V0, V1) do { KR = *(const u32x4*)(Kb + (size_t)((t) * 64 + kr) * 768 + kc * 8); \
            V0 = *(const u32x4*)(Vb + (size_t)kr * LP + (t) * 64 + kc * 8); V1 = *(const u32x4*)(Vb + (size_t)(64 + kr) * LP + (t) * 64 + kc * 8); } while (0)
#define AT_STORE(buf, KR, V0, V1) do { unsigned char* B_ = lds_g + (buf) * AT_BUF; *(u32x4*)(B_ + (kr * AT_KP + kc * 8) * 2) = KR; \
            *(u32x2*)(B_ + AT_KB + (kr * AT_VP + kc * 8) * 2) = (u32x2){V0.x, V0.y}; *(u32x2*)(B_ + AT_KB + (kr * AT_VP + kc * 8 + 4) * 2) = (u32x2){V0.z, V0.w}; \
            *(u32x2*)(B_ + AT_KB + ((64 + kr) * AT_VP + kc * 8) * 2) = (u32x2){V1.x, V1.y}; *(u32x2*)(B_ + AT_KB + ((64 + kr) * AT_VP + kc * 8 + 4) * 2) = (u32x2){V1.z, V1.w}; } while (0)
#define AT_TILE(t) do { \
            if ((t) * 64 <= qw + 31 && qw < L) {                 \
                const unsigned char* Bc = lds_g + ((t) & 1) * AT_BUF; \
                const float nm_ = mrun == -INFINITY ? 0.f : -mrun;     \
                f32x16 p0 = (f32x16){nm_, nm_, nm_, nm_, nm_, nm_, nm_, nm_, nm_, nm_, nm_, nm_, nm_, nm_, nm_, nm_}, p1 = p0; \
                _Pragma("unroll") for (int i2 = 0; i2 < 2; ++i2) { bf16x8 kf0[2], kf1[2];     \
                  _Pragma("unroll") for (int i = 0; i < 2; ++i) { kf0[i] = *(const bf16x8*)(Bc + (r32 * AT_KP + 16 * (2 * i2 + i) + 8 * hi) * 2); kf1[i] = *(const bf16x8*)(Bc + ((32 + r32) * AT_KP + 16 * (2 * i2 + i) + 8 * hi) * 2); } \
                  asm volatile("s_waitcnt lgkmcnt(0)" ::: "memory"); __builtin_amdgcn_sched_barrier(0); \
                  _Pragma("unroll") for (int i = 0; i < 2; ++i) { p0 = __builtin_amdgcn_mfma_f32_32x32x16_bf16(kf0[i], qr[2 * i2 + i], p0, 0, 0, 0); p1 = __builtin_amdgcn_mfma_f32_32x32x16_bf16(kf1[i], qr[2 * i2 + i], p1, 0, 0, 0); } } \
                if ((t) * 64 + 63 > qw) {                        \
                    const int qa = qw + r32, kb0 = (t) * 64 + 4 * hi; \
                    _Pragma("unroll") for (int r = 0; r < 16; ++r) { const int kv = kb0 + (r & 3) + 8 * (r >> 2); if (kv > qa) p0[r] = -INFINITY; if (kv + 32 > qa) p1[r] = -INFINITY; } } \
                float rm = fmaxf(p0[0], p1[0]); \
                _Pragma("unroll") for (int r = 1; r < 16; ++r) rm = fmaxf(rm, fmaxf(p0[r], p1[r])); \
                rm = fmaxf(rm, __shfl_xor(rm, 32)); \
                if (__any(rm > 8.0f || mrun == -INFINITY)) {   \
                    const float dl_ = mrun == -INFINITY ? rm : fmaxf(rm, 0.f), al_ = mrun == -INFINITY ? 0.f : __builtin_amdgcn_exp2f(-dl_); \
                    mrun = (mrun == -INFINITY ? 0.f : mrun) + dl_; lrun *= al_; \
                    _Pragma("unroll") for (int r = 0; r < 16; ++r) { p0[r] -= dl_; p1[r] -= dl_; } \
                    _Pragma("unroll") for (int d = 0; d < 4; ++d) _Pragma("unroll") for (int r = 0; r < 16; ++r) o[d][r] *= al_; } \
                _Pragma("unroll") for (int r = 0; r < 16; ++r) { p0[r] = __builtin_amdgcn_exp2f(p0[r]); p1[r] = __builtin_amdgcn_exp2f(p1[r]); } \
                { const f32x16 sm_ = p0 + p1; const f32x4 s4_ = (f32x4){sm_[0], sm_[1], sm_[2], sm_[3]} + (f32x4){sm_[4], sm_[5], sm_[6], sm_[7]} + (f32x4){sm_[8], sm_[9], sm_[10], sm_[11]} + (f32x4){sm_[12], sm_[13], sm_[14], sm_[15]}; \
                  lrun += (s4_[0] + s4_[1]) + (s4_[2] + s4_[3]); } \
                bf16x8 pb[4]; \
                _Pragma("unroll") for (int jj = 0; jj < 4; ++jj) { u32x4 w; \
                    if (jj < 2) { w.x = pg8::cvt_pk_bf16(p0[8 * jj], p0[8 * jj + 1]); w.y = pg8::cvt_pk_bf16(p0[8 * jj + 2], p0[8 * jj + 3]); w.z = pg8::cvt_pk_bf16(p0[8 * jj + 4], p0[8 * jj + 5]); w.w = pg8::cvt_pk_bf16(p0[8 * jj + 6], p0[8 * jj + 7]); } \
                    else { const int j2 = jj - 2; w.x = pg8::cvt_pk_bf16(p1[8 * j2], p1[8 * j2 + 1]); w.y = pg8::cvt_pk_bf16(p1[8 * j2 + 2], p1[8 * j2 + 3]); w.z = pg8::cvt_pk_bf16(p1[8 * j2 + 4], p1[8 * j2 + 5]); w.w = pg8::cvt_pk_bf16(p1[8 * j2 + 6], p1[8 * j2 + 7]); } \
                    pb[jj] = __builtin_bit_cast(bf16x8, w); } \
                const unsigned char* Vc = Bc + AT_KB; \
                _Pragma("unroll") for (int d = 0; d < 4; ++d) { s16x4 vl[4], vh[4];     \
                      _Pragma("unroll") for (int jj = 0; jj < 4; ++jj) { vl[jj] = *(const s16x4*)(Vc + ((d * 32 + r32) * AT_VP + 16 * jj + 4 * hi) * 2); vh[jj] = *(const s16x4*)(Vc + ((d * 32 + r32) * AT_VP + 16 * jj + 8 + 4 * hi) * 2); } \
                      asm volatile("s_waitcnt lgkmcnt(0)" ::: "memory"); __builtin_amdgcn_sched_barrier(0); \
                      _Pragma("unroll") for (int jj = 0; jj < 4; ++jj) { const bf16x8 va = (bf16x8){vl[jj][0], vl[jj][1], vl[jj][2], vl[jj][3], vh[jj][0], vh[jj][1], vh[jj][2], vh[jj][3]}; \
                          o[d] = __builtin_amdgcn_mfma_f32_32x32x16_bf16(va, pb[jj], o[d], 0, 0, 0); } } \
            } } while (0)
        AT_LOAD(0, kreg0, vreg00, vreg01); AT_STORE(0, kreg0, vreg00, vreg01);
        AT_LOAD(1, kreg1, vreg10, vreg11); AT_LOAD(2, kreg2, vreg20, vreg21); AT_LOAD(3, kreg3, vreg30, vreg31);
        __syncthreads();
        for (int t = 0; t < NT; t += 4) {
            if (t + 4 < NT) AT_LOAD(t + 4, kreg0, vreg00, vreg01);
            AT_TILE(t);
            AT_STORE(1, kreg1, vreg10, vreg11);
            __syncthreads();
            if (t + 5 < NT) AT_LOAD(t + 5, kreg1, vreg10, vreg11);
            AT_TILE(t + 1);
            AT_STORE(0, kreg2, vreg20, vreg21);
            __syncthreads();
            if (t + 6 < NT) AT_LOAD(t + 6, kreg2, vreg20, vreg21);
            AT_TILE(t + 2);
            AT_STORE(1, kreg3, vreg30, vreg31);
            __syncthreads();
            if (t + 7 < NT) AT_LOAD(t + 7, kreg3, vreg30, vreg31);
            AT_TILE(t + 3);
            if (t + 4 < NT) AT_STORE(0, kreg0, vreg00, vreg01);
            __syncthreads();
        }
#undef AT_TILE
#undef AT_LOAD
#undef AT_STORE
        const float lt = lrun + __shfl_xor(lrun, 32), rl = 1.0f / lt;
        const int qa = qw + r32;
        if (qa < L) {
            bf16_t* op = (bf16_t*)OD + ((size_t)(b * LP + qa) * 12 + vh) * 128;
#pragma unroll
            for (int d = 0; d < 4; ++d)
#pragma unroll
                for (int g = 0; g < 4; ++g) { u32x2 w; w.x = pg8::cvt_pk_bf16(o[d][4 * g] * rl, o[d][4 * g + 1] * rl); w.y = pg8::cvt_pk_bf16(o[d][4 * g + 2] * rl, o[d][4 * g + 3] * rl); *(u32x2*)(op + 32 * d + 8 * g + 4 * hi) = w; }
        }
    }
}

__device__ __forceinline__ float red16(float v) {
    v += __builtin_bit_cast(float, __builtin_amdgcn_mov_dpp(__builtin_bit_cast(int, v), 0xB1, 0xF, 0xF, true));
    v += __builtin_bit_cast(float, __builtin_amdgcn_mov_dpp(__builtin_bit_cast(int, v), 0x4E, 0xF, 0xF, true));
    v += __builtin_bit_cast(float, __builtin_amdgcn_mov_dpp(__builtin_bit_cast(int, v), 0x141, 0xF, 0xF, true));
    v += __builtin_bit_cast(float, __builtin_amdgcn_mov_dpp(__builtin_bit_cast(int, v), 0x140, 0xF, 0xF, true));
    return v;
}
__device__ __forceinline__ void finalize_phase(int l_in, int gw_in, int NGW, int lane_in) {
    const int l = opq_s(l_in), gw = opq_v(gw_in), lane = opq_v(lane_in);
    const Args a = *argp();
    const float* OD = (const float*)(a.ws + WS_OD); const float* OH = (const float*)(a.ws + WS_OH); const float* ZH = (const float*)(a.ws + WS_ZH);
    bf16_t* YD = (bf16_t*)(a.ws + WS_YD); bf16_t* YH = (bf16_t*)(a.ws + WS_YH);
    const float* lp = a.diff_lambda + (size_t)l * 4 * 64;
    const float lam_init = l == 0 ? 0.2f : 0.8f - 0.6f * 0.7408182206817179f;
    const float lam = __expf(wave_sum(lp[lane] * lp[64 + lane])) - __expf(wave_sum(lp[128 + lane] * lp[192 + lane])) + lam_init;
    const int q = lane >> 4, li = lane & 15;
    f32x4 gD[2], gH[2];
#pragma unroll
    for (int e = 0; e < 2; ++e) { gD[e] = *(const f32x4*)(a.diff_ng + l * 128 + 8 * li + 4 * e) * (1.f - lam_init); gH[e] = *(const f32x4*)(a.hgrn_ng + l * 128 + 8 * li + 4 * e); }
    for (int r = gw; r < T; r += NGW) {
        const int b = r / L, t = r % L; const size_t ar = (size_t)(b * LP + t);
        f32x4 A_[3][2], B_[3][2];
#pragma unroll
        for (int p = 0; p < 3; ++p) { const int sg = p * 4 + q; const bool isd = sg < 6; const int h = isd ? sg : sg - 6;
            if (isd) { const bf16_t* pd = (const bf16_t*)OD + (ar * 12 + 2 * h) * 128 + 8 * li; const u32x4 wa = *(const u32x4*)pd, wb = *(const u32x4*)(pd + 128);
                A_[p][0] = (f32x4){bflo(wa.x), bfhi(wa.x), bflo(wa.y), bfhi(wa.y)}; A_[p][1] = (f32x4){bflo(wa.z), bfhi(wa.z), bflo(wa.w), bfhi(wa.w)};
                B_[p][0] = (f32x4){bflo(wb.x), bfhi(wb.x), bflo(wb.y), bfhi(wb.y)}; B_[p][1] = (f32x4){bflo(wb.z), bfhi(wb.z), bflo(wb.w), bfhi(wb.w)}; }
            else { const u32x4 wa = *(const u32x4*)((const bf16_t*)OH + (size_t)r * HW + h * 128 + 8 * li); const u32x4 wb = *(const u32x4*)((const bf16_t*)(a.ws + WS_HG) + (size_t)r * HW + h * 128 + 8 * li);
                A_[p][0] = (f32x4){bflo(wa.x), bfhi(wa.x), bflo(wa.y), bfhi(wa.y)}; A_[p][1] = (f32x4){bflo(wa.z), bfhi(wa.z), bflo(wa.w), bfhi(wa.w)};
                B_[p][0] = (f32x4){bflo(wb.x), bfhi(wb.x), bflo(wb.y), bfhi(wb.y)}; B_[p][1] = (f32x4){bflo(wb.z), bfhi(wb.z), bflo(wb.w), bfhi(wb.w)}; } }
#pragma unroll
        for (int p = 0; p < 3; ++p) { const int sg = p * 4 + q; const bool isd = sg < 6; const int h = isd ? sg : sg - 6;
            const float ls = isd ? lam : 0.f;
            f32x4 d0 = A_[p][0] - B_[p][0] * ls, d1 = A_[p][1] - B_[p][1] * ls;
            const f32x4 sq = d0 * d0 + d1 * d1;
            const float ms = red16((sq[0] + sq[1]) + (sq[2] + sq[3])) * (1.f / 128.f); const float rs = 1.f / sqrtf(ms + RMS_EPS);
            f32x4 w0, w1;
            if (isd) { w0 = gD[0]; w1 = gD[1]; }
            else { const f32x4 g0 = B_[p][0], g1 = B_[p][1];
                w0 = gH[0] * (f32x4){g0[0] * sigmoidf_(g0[0]), g0[1] * sigmoidf_(g0[1]), g0[2] * sigmoidf_(g0[2]), g0[3] * sigmoidf_(g0[3])};
                w1 = gH[1] * (f32x4){g1[0] * sigmoidf_(g1[0]), g1[1] * sigmoidf_(g1[1]), g1[2] * sigmoidf_(g1[2]), g1[3] * sigmoidf_(g1[3])}; }
            d0 = d0 * rs * w0; d1 = d1 * rs * w1;
            u32x4 o; o.x = pk2(d0[0], d0[1]); o.y = pk2(d0[2], d0[3]); o.z = pk2(d1[0], d1[1]); o.w = pk2(d1[2], d1[3]);
            bf16_t* po = (isd ? YD + (size_t)r * DW : YH + (size_t)r * HW) + h * 128 + 8 * li;
            *(u32x4*)po = o; }
    }
}


#ifndef DBG_STAGE
#define DBG_STAGE 0
#endif
template <int stage> __device__ __forceinline__ void dbg_out(int gw, int NGW, int lane) {
    const Args a = *argp(); unsigned char* ws = a.ws;
    const float* ZP = (const float*)(ws + WS_ZP); const float* ZH = (const float*)(ws + WS_ZH); const bf16_t* G = (const bf16_t*)(ws + WS_G);
    const bf16_t* QA = (const bf16_t*)(ws + WS_QA); const bf16_t* YP = (const bf16_t*)(ws + WS_YP); const bf16_t* YH = (const bf16_t*)(ws + WS_YH); const bf16_t* YD = (const bf16_t*)(ws + WS_YD);
    const bf16_t* MB = (const bf16_t*)(ws + WS_MB);
    for (int r = gw; r < T; r += NGW) {
        const int b = r / L, t = r % L; if (t < NMETA) continue;
        const size_t ar = (size_t)(b * LP + t);
        float* o = a.out + ((size_t)b * SEQ + (t - NMETA)) * D;
        for (int c = lane; c < D; c += 64) {
            float v = 0.f;
            if (stage == 1) v = ZH[(size_t)r * 3072 + c] + ZH[(size_t)r * 3072 + 1024 + c] + ZP[(size_t)r * PW + (c & 511)] + bf2f(G[(size_t)r * 6144 + c]) + bf2f(G[(size_t)r * 6144 + 2048 + c]) + bf2f(G[(size_t)r * 6144 + 4096 + c])
                              + bf2f(QA[ar * 768 + (c % 768)]) + bf2f(QA[(WS_KA - WS_QA) / 2 + ar * 768 + (c % 768)]) + bf2f(QA[(WS_KA - WS_QA) + ar * 768 + (c % 768)]);
            else if (stage == 2) v = bf2f(YP[(size_t)r * PW + (c & 511)]) + 2.f * bf2f(YH[(size_t)r * HW + (c % 768)]) + 3.f * bf2f(YD[(size_t)r * DW + ((c + 100) % 768)]);
            else if (stage == 3) v = bf2f(MB[(size_t)r * D + c]);
            o[c] = v;
        }
    }
}

__device__ __forceinline__ void tail_ln(int lnidx, bool final_, unsigned* cntp, unsigned char* lds_g, int rb) {
    if (rb >= 64) return;
    const int tid = opq_v((int)threadIdx.x);
    int* sh = (int*)(lds_g + 131072 + 128);
    asm volatile("s_waitcnt vmcnt(0)" ::: "memory");
    __syncthreads();
    if (tid == 0) { __builtin_amdgcn_fence(__ATOMIC_RELEASE, "agent"); asm volatile("s_waitcnt vmcnt(0)" ::: "memory");
        *sh = (int)__hip_atomic_fetch_add(cntp, 1u, __ATOMIC_RELAXED, __HIP_MEMORY_SCOPE_AGENT); }
    __syncthreads();
    if (*sh == 63) {
        if (tid == 0) { __builtin_amdgcn_fence(__ATOMIC_ACQUIRE, "agent"); asm volatile("s_waitcnt vmcnt(0)" ::: "memory"); }
        __syncthreads();
        ln_rows(lnidx, final_, MT, T, tid >> 6, 8, tid & 63);
    }
}
#ifndef STOP_L
#define STOP_L 1
#endif
#ifndef STOP_J
#define STOP_J 1
#endif
#ifndef STOP_MIX
#define STOP_MIX 0
#endif
__global__ void __launch_bounds__(512, 2) fwd_kernel(Args a_unused) {
    extern __shared__ __attribute__((aligned(16))) unsigned char lds[];
    cg::grid_group grid = cg::this_grid();
    LAS unsigned char* ldsl = (LAS unsigned char*)lds;
    volatile LAS unsigned* MISC = (volatile LAS unsigned*)(ldsl + 147456 - 512);
    if (threadIdx.x < 64) MISC[threadIdx.x] = 0u;
    __syncthreads();
    (void)xcd_barrier_post((unsigned*)(argp()->ws + WS_CTL), MISC);
#define SYNC() xcd_barrier((unsigned*)(argp()->ws + WS_CTL), (volatile LAS unsigned*)(ldsl + 147456 - 512))
#define TIDV opq_v((int)threadIdx.x)
#define BLK opq_s((int)blockIdx.x)
#define GRD opq_s((int)gridDim.x)
#define WSP (argp()->ws)
#define GEMM(EPI, Aptr, Bptr, Mv, Nv, Kv, Eobj) do { pg8::Gemm g_{Aptr, Bptr, MT, Nv, Kv}; pg8::StaticOrder S_; S_.init(MT, Nv, GRD, BLK); pg8::gemm_phase<EPI, pg8::StaticOrder, true, true>(ldsl, g_, S_, Eobj); \
        {   \
          const int rb_ = GRD - 1 - BLK, nt_ = __is_same(EPI, pg8::EpiSwiglu) ? 128 : GRD; \
          tail_gemm<EPI, __is_same(EPI, pg8::EpiSwiglu)>(Aptr, Bptr, Kv, __is_same(EPI, pg8::EpiSwiglu) ? (Nv) / 2 : (Nv), Eobj, lds, rb_ < nt_ ? rb_ : (1 << 28), nt_); } } while (0)

#define GEMM_LN(Aoff, Boff, Kv, sval, lnidx_, final__) do { const Args a_ = *argp(); unsigned char* ws = a_.ws; const int li_ = (lnidx_); \
        pg8::PanelStats st_{(unsigned*)(ws + WS_XB), (unsigned*)(ws + WS_CTL + 65536 + (size_t)li_ * 8192), LN_EPS}; \
        pg8::EpiLn E_{(float*)(ws + WS_H), (bf16_t*)(ws + WS_HB), a_.ln_g + (size_t)li_ * D, a_.ln_b + (size_t)li_ * D, (sval), st_, (final__) ? a_.out : nullptr}; \
        pg8::Gemm g_{(const bf16_t*)(ws + (Aoff)), (const bf16_t*)(ws + (Boff)), MT, D, (Kv)}; pg8::StaticOrder S_; S_.init(MT, D, GRD, BLK); \
        pg8::gemm_phase<pg8::EpiLn, pg8::StaticOrder, false, true>(ldsl, g_, S_, E_); \
        pg8::EpiResid Et_{(const float*)(ws + WS_H), (float*)(ws + WS_PRE), (sval)}; const int rb_ = GRD - 1 - BLK; \
        tail_gemm<pg8::EpiResid, false>((const bf16_t*)(ws + (Aoff)), (const bf16_t*)(ws + (Boff)), (Kv), D, Et_, lds, rb_, GRD); \
        tail_ln(li_, (final__), (unsigned*)(ws + WS_CTL + 20480 + 256 * li_), lds, rb_); } while (0)

    { const int tid = TIDV; prologue(lds, BLK * 8 + (tid >> 6), GRD * 8, tid & 63); }
    asm volatile("s_waitcnt vmcnt(0)" ::: "memory");
    grid.sync();
    for (int l = 0; l < 2; ++l) {
        for (int j = 0; j < 2; ++j) {
            if (j == 1) {
                { unsigned char* ws = WSP; pg8::EpiInproj E{(float*)(ws + WS_ZP), (float*)(ws + WS_ZH), (bf16_t*)(ws + WS_QA), (bf16_t*)(ws + WS_KA), (bf16_t*)(ws + WS_VA), (bf16_t*)(ws + WS_G)};
                  GEMM(pg8::EpiInproj, (const bf16_t*)(ws + WS_HB), (const bf16_t*)(ws + WS_WIN + (size_t)l * SZ_WIN), MP, INCOLS, D, E); }
                SYNC();
                if constexpr (DBG_STAGE == 1) { const int tid = TIDV; dbg_out<1>(BLK * 8 + (tid >> 6), GRD * 8, tid & 63); return; }
                { const int blk = BLK, G = GRD; pool_phase(l, lds, blk, G); hgrn_pre(l, lds, blk, G); }
                SYNC();
                attn_phase(l, lds, ldsl, (unsigned*)(argp()->ws + WS_CTL + 16384 + 256 * l), 24);
                SYNC();
                { const int tid = TIDV; finalize_phase(l, BLK * 8 + (tid >> 6), GRD * 8, tid & 63); }
                SYNC();
                if constexpr (DBG_STAGE == 2) { const int tid = TIDV; dbg_out<2>(BLK * 8 + (tid >> 6), GRD * 8, tid & 63); return; }
                { unsigned char* ws = WSP;
                  pg8::EpiBranch E0{(const bf16_t*)(ws + WS_G), 0, (float*)(ws + WS_MF), (bf16_t*)(ws + WS_MB), 0};
                  GEMM(pg8::EpiBranch, (const bf16_t*)(ws + WS_YP), (const bf16_t*)(ws + WS_WBP + (size_t)l * D * PW * 2), MP, D, PW, E0); }
                { unsigned char* ws = WSP;
                  pg8::EpiBranch E1{(const bf16_t*)(ws + WS_G), 2048, (float*)(ws + WS_MF), (bf16_t*)(ws + WS_MB), 1};
                  GEMM(pg8::EpiBranch, (const bf16_t*)(ws + WS_YH), (const bf16_t*)(ws + WS_WBH + (size_t)l * D * HW * 2), MP, D, HW, E1); }
                { unsigned char* ws = WSP;
                  pg8::EpiBranch E2{(const bf16_t*)(ws + WS_G), 4096, (float*)(ws + WS_MF), (bf16_t*)(ws + WS_MB), 2};
                  GEMM(pg8::EpiBranch, (const bf16_t*)(ws + WS_YD), (const bf16_t*)(ws + WS_WBD + (size_t)l * D * DW * 2), MP, D, DW, E2); }
                SYNC();
                if constexpr (DBG_STAGE == 3) { const int tid = TIDV; dbg_out<3>(BLK * 8 + (tid >> 6), GRD * 8, tid & 63); return; }
                GEMM_LN(WS_MB, WS_WO + (size_t)l * D * D * 2, D, 1.0f, l * 3 + 1, false);
                SYNC();
            }
            { unsigned char* ws = WSP; pg8::EpiSwiglu E{(bf16_t*)(ws + WS_ACT)};
              GEMM(pg8::EpiSwiglu, (const bf16_t*)(ws + WS_HB), (const bf16_t*)(ws + WS_WUP + (size_t)(l * 2 + j) * SZ_WUP), MP, 2 * DFF, D, E); }
            SYNC();
            GEMM_LN(WS_ACT, WS_WDN + (size_t)(l * 2 + j) * SZ_WDN, DFF, 0.5f, l * 3 + 2 * j, (l == 1 && j == 1));
            if (l == 1 && j == 1) return;
            SYNC();
        }
    }
#undef GEMM
}

extern "C" void kernel_launch(void* const* d_in, const int* in_sizes, int n_in, void* d_out, int out_size, void* d_ws, size_t ws_size, hipStream_t stream) {
    static int grid = 0;
    if (grid == 0) {
        int dev = 0, cus = 0, per_cu = 0;
        (void)hipGetDevice(&dev);
        (void)hipDeviceGetAttribute(&cus, hipDeviceAttributeMultiprocessorCount, dev);
        (void)hipFuncSetAttribute((const void*)fwd_kernel, hipFuncAttributeMaxDynamicSharedMemorySize, LDS_BYTES);
        (void)hipOccupancyMaxActiveBlocksPerMultiprocessor(&per_cu, (const void*)fwd_kernel, 512, LDS_BYTES);
        if (per_cu < 1) per_cu = 1;
        grid = cus * per_cu;
        if (ws_size < WS_END3 || cus * per_cu != 256) { fprintf(stderr, "kernel_launch: workspace too small: %zu < %zu\n", ws_size, (size_t)WS_END); grid = -1; }
    }
    if (grid < 0) return;
    Args a{};
    a.x = (const float*)d_in[0]; a.meta = (const float*)d_in[1]; a.ln_g = (const float*)d_in[2]; a.ln_b = (const float*)d_in[3];
    a.ffn_w_in = (const float*)d_in[4]; a.ffn_w_out = (const float*)d_in[5]; a.w_in = (const float*)d_in[6]; a.pool_w = (const float*)d_in[7];
    a.pool_scale = (const float*)d_in[8]; a.hgrn_lb = (const float*)d_in[9]; a.hgrn_ng = (const float*)d_in[10]; a.diff_lambda = (const float*)d_in[11];
    a.diff_ng = (const float*)d_in[12]; a.w_bp = (const float*)d_in[13]; a.w_bh = (const float*)d_in[14]; a.w_bd = (const float*)d_in[15]; a.w_out = (const float*)d_in[16];
    a.out = (float*)d_out; a.ws = (unsigned char*)d_ws;
    (void)hipMemsetAsync((char*)d_ws + WS_CTL, 0, 131072, stream);
    void* args[] = {&a};
    hipError_t e = hipLaunchCooperativeKernel((const void*)fwd_kernel, dim3(grid), dim3(512), args, LDS_BYTES, stream);
    if (e != hipSuccess) fprintf(stderr, "cooperative launch failed: %s (grid %d)\n", hipGetErrorString(e), grid);
}
```

```cpp
#include <hip/hip_runtime.h>
#include <hip/hip_cooperative_groups.h>
#include <cstdio>
#include <cstdint>
namespace cg = cooperative_groups;

#define LAS __attribute__((address_space(3)))
typedef unsigned short bf16_t;
typedef short bf16x8 __attribute__((ext_vector_type(8)));
typedef float f32x4 __attribute__((ext_vector_type(4)));
typedef float f32x2 __attribute__((ext_vector_type(2)));
typedef unsigned u32x4 __attribute__((ext_vector_type(4)));
typedef unsigned u32x2 __attribute__((ext_vector_type(2)));
typedef short s16x4 __attribute__((ext_vector_type(4)));
typedef float f32x16_t __attribute__((ext_vector_type(16)));

constexpr int D = 2048, NB = 2, SEQ = 4096, NMETA = 16, L = SEQ + NMETA  , T = NB * L  , MP = 8448  ;
constexpr int DFF = 5632, INCOLS = 12032, LP = 4352  ;
constexpr int PW = 512, HW = 768, DW = 768;
constexpr float ALPHA = 1.4142135623730951f;
constexpr float LN_EPS = 1e-5f, RMS_EPS = 1e-6f;
constexpr float C2 = 0.125f * 1.4426950408889634f;

constexpr size_t al(size_t x) { return (x + 4095) & ~(size_t)4095; }
constexpr size_t WS_CTL = 0, CTL_BYTES = 1 << 20;
constexpr size_t SZ_WUP = (size_t)2 * DFF * D * 2, SZ_WDN = (size_t)D * DFF * 2, SZ_WIN = (size_t)INCOLS * D * 2;
constexpr size_t WS_WUP = WS_CTL + CTL_BYTES;
constexpr size_t WS_WDN = WS_WUP + 4 * SZ_WUP;
constexpr size_t WS_WIN = WS_WDN + 4 * SZ_WDN;
constexpr size_t WS_WBP = WS_WIN + 2 * SZ_WIN;
constexpr size_t WS_WBH = WS_WBP + 2 * (size_t)D * PW * 2;
constexpr size_t WS_WBD = WS_WBH + 2 * (size_t)D * HW * 2;
constexpr size_t WS_WO = WS_WBD + 2 * (size_t)D * DW * 2;
constexpr size_t WS_H = al(WS_WO + 2 * (size_t)D * D * 2);
constexpr size_t WS_HB = al(WS_H + (size_t)MP * D * 4);
constexpr size_t WS_PRE = al(WS_HB + (size_t)MP * D * 2);
constexpr size_t WS_ACT = al(WS_PRE + (size_t)MP * D * 4);
constexpr size_t WS_ZP = al(WS_ACT + (size_t)MP * DFF * 2);
constexpr size_t WS_ZH = al(WS_ZP + (size_t)MP * PW * 4);
constexpr size_t WS_QA = al(WS_ZH + (size_t)MP * 3072 * 4);
constexpr size_t WS_KA = al(WS_QA + (size_t)NB * LP * 768 * 2);
constexpr size_t WS_VA = al(WS_KA + (size_t)NB * LP * 768 * 2);
constexpr size_t WS_G = al(WS_VA + (size_t)NB * LP * 768 * 2);
constexpr size_t WS_YP = al(WS_G + (size_t)MP * 6144 * 2);
constexpr size_t WS_YH = al(WS_YP + (size_t)MP * PW * 2);
constexpr size_t WS_YD = al(WS_YH + (size_t)MP * HW * 2);
constexpr size_t WS_OH = al(WS_YD + (size_t)MP * DW * 2);
constexpr size_t WS_OD = al(WS_OH + (size_t)T * HW * 4);
constexpr size_t WS_MF = al(WS_OD + (size_t)NB * LP * 1536 * 4);
constexpr size_t WS_MB = al(WS_MF + (size_t)MP * D * 4);
constexpr size_t WS_END = al(WS_MB + (size_t)MP * D * 2);
static_assert(WS_KA - WS_QA == WS_VA - WS_KA, "Q/K/V attention buffers equally spaced");
constexpr size_t WS_HG = WS_END, WS_HV = al(WS_HG + (size_t)MP * HW * 2), WS_HQ = al(WS_HV + (size_t)MP * HW * 2), WS_END_HG = al(WS_HQ + (size_t)MP * HW * 2);

constexpr int LDS_BYTES = 147456;

typedef float f32x2_t __attribute__((ext_vector_type(2))); typedef __bf16 bf16x2_t __attribute__((ext_vector_type(2)));
__device__ __forceinline__ unsigned pk2(float lo, float hi) { f32x2_t v = {lo, hi}; bf16x2_t b = __builtin_convertvector(v, bf16x2_t); return __builtin_bit_cast(unsigned, b); }
__device__ __forceinline__ unsigned f2bf(float f) { return pk2(f, 0.f) & 0xffffu; }
__device__ __forceinline__ float bf2f(unsigned short v) { return __builtin_bit_cast(float, (unsigned)v << 16); }
__device__ __forceinline__ float bflo(unsigned w) { return __builtin_bit_cast(float, w << 16); }
__device__ __forceinline__ float bfhi(unsigned w) { return __builtin_bit_cast(float, w & 0xffff0000u); }
__device__ __forceinline__ float wave_sum(float v) {
#pragma unroll
    for (int o = 1; o < 64; o <<= 1) v += __shfl_xor(v, o);
    return v;
}
__device__ __forceinline__ float sigmoidf_(float x) { return __builtin_amdgcn_rcpf(1.0f + __builtin_amdgcn_exp2f(-1.4426950408889634f * x)); }

__device__ __forceinline__ int opq_v(int x) { asm volatile("" : "+v"(x)); return x; }
__device__ __forceinline__ int opq_s(int x) { asm volatile("" : "+s"(x)); return x; }


#define XB_TMO      128
#define XB_XCNT(j)  (256  + 64 * (j))
#define XB_XSUB(j)  (1280 + 64 * (j))
#define XB_XGEN(j)  (2304 + 64 * (j))
#define XB_TOP      3328
#define XB_TOPGEN   3392
#define XCD_BAR_WORDS 3456
#define XB_SPIN_CAP (1u << 22)
__device__ __forceinline__ unsigned xb_ld(unsigned* p)              { return __hip_atomic_load(p, __ATOMIC_RELAXED, __HIP_MEMORY_SCOPE_AGENT); }
__device__ __forceinline__ unsigned xb_add(unsigned* p, unsigned v) { return __hip_atomic_fetch_add(p, v, __ATOMIC_RELAXED, __HIP_MEMORY_SCOPE_AGENT); }
__device__ __forceinline__ unsigned xb_xcc_id() { return (unsigned)__builtin_amdgcn_s_getreg((3 << 11) | 20) & 0xFu; }
#define XB_SPIN(cond, bar) do { unsigned _sp = 0; while (cond) { __builtin_amdgcn_s_sleep(1); \
    if ((++_sp & 255u) == 0u) { if (xb_ld(&(bar)[XB_TMO])) break; if (_sp > XB_SPIN_CAP) { atomicAdd(&(bar)[XB_TMO], 1u); break; } } } } while (0)
struct XcdBarrier { unsigned* bar; unsigned x; volatile LAS unsigned* st; };
__device__ __forceinline__ XcdBarrier xcd_barrier_post(unsigned* bar, volatile LAS unsigned* st) {
    XcdBarrier b; b.bar = bar; b.x = xb_xcc_id(); b.st = st;
    if (threadIdx.x == 0) (void)xb_add(&bar[XB_XCNT(b.x)], 1u);
    return b;
}
__device__ __forceinline__ void xcd_barrier_complete(unsigned* bar, unsigned x, unsigned& nloc, unsigned& nx) {
    const unsigned G = gridDim.x * gridDim.y * gridDim.z;
    unsigned sum, cnt, mine, sp = 0u;
    for (;;) {
        sum = 0u; cnt = 0u; mine = 0u;
#pragma unroll
        for (unsigned j = 0; j < 16; ++j) { const unsigned c = xb_ld(&bar[XB_XCNT(j)]); sum += c; cnt += (c > 0u) ? 1u : 0u; mine = (j == x) ? c : mine; }
        if (sum == G) break;
        __builtin_amdgcn_s_sleep(1);
        if ((++sp & 255u) == 0u) { if (xb_ld(&bar[XB_TMO])) break; if (sp > XB_SPIN_CAP) { atomicAdd(&bar[XB_TMO], 1u); break; } }
    }
    nloc = mine > 0u ? mine : 1u; nx = cnt > 0u ? cnt : 1u;
}
__device__ __forceinline__ void xcd_barrier(unsigned* bar, volatile LAS unsigned* st) {
    asm volatile("s_waitcnt vmcnt(0)" ::: "memory");
    __syncthreads();
    if (threadIdx.x == 0) {
        const unsigned x = xb_xcc_id();
        __builtin_amdgcn_s_waitcnt(0);
        unsigned nloc = st[0], nx = st[1];
        if (nloc == 0u) { xcd_barrier_complete(bar, x, nloc, nx); st[0] = nloc; st[1] = nx; }
        const unsigned old = xb_add(&bar[XB_XSUB(x)], 1u);
        const unsigned gen = old / nloc;
        if (old + 1u == (gen + 1u) * nloc) {
            __builtin_amdgcn_fence(__ATOMIC_RELEASE, "agent");
            asm volatile("s_waitcnt vmcnt(0)" ::: "memory");
            const unsigned og = xb_add(&bar[XB_TOP], 1u);
            const unsigned tg = og / nx;
            if (og + 1u == (tg + 1u) * nx) xb_add(&bar[XB_TOPGEN], 1u);
            else XB_SPIN(xb_ld(&bar[XB_TOPGEN]) == tg, bar);
            __builtin_amdgcn_fence(__ATOMIC_ACQUIRE, "agent");
            xb_add(&bar[XB_XGEN(x)], 1u);
            asm volatile("s_waitcnt vmcnt(0)" ::: "memory");
        } else {
            XB_SPIN(xb_ld(&bar[XB_XGEN(x)]) == gen, bar);
            __builtin_amdgcn_fence(__ATOMIC_ACQUIRE, "agent");
            asm volatile("s_waitcnt vmcnt(0)" ::: "memory");
        }
    }
    __syncthreads();
}

namespace pg8 {
constexpr int BM = 256, BK = 64, HALF = 128, HTB = HALF * BK * 2, STAGE_BYTES = 8 * HTB, NXCD = 8, WGM = 8;
__host__ __device__ __forceinline__ int lds_byte(int r, int c) { const int st = (r >> 4) * 2 + (c >> 5), rr = r & 15, cc = c & 31, ob = rr * 64 + cc * 2; return st * 1024 + (ob ^ (((ob >> 9) & 1) << 5)); }
__host__ __device__ __forceinline__ void stage_rc(int b, int& R, int& C) { const int st = b / 1024, sb = b % 1024, swz = sb ^ (((sb >> 9) & 1) << 5); R = (st >> 1) * 16 + swz / 64; C = (st & 1) * 32 + (swz % 64) / 2; }
__host__ __device__ __forceinline__ int perm32(int rho) { const int n = rho >> 4, i = rho & 15; return 8 * (i >> 2) + 4 * n + (i & 3); }
struct Unit { int pm, pn; };
struct Gemm { const bf16_t* A; const bf16_t* Bt; int M, N, K; };
struct StaticOrder {
    int nM, nN, nwg, G, c;
    __host__ __device__ void init(int M, int N, int G_, int c_) { nM = M / BM; nN = N / BM; nwg = nM * nN; G = G_; c = c_; }
    __host__ __device__ bool next(int i, Unit& u) const {
        const long Lx = (long)i * G + c; if (Lx >= nwg) return false;
        int wgid = (int)Lx; { const int q = nwg / NXCD, r = nwg % NXCD, xcd = wgid % NXCD, off = wgid / NXCD; wgid = (xcd < r ? xcd * (q + 1) : r * (q + 1) + (xcd - r) * q) + off; }
        const int nig = WGM * nN, gid = wgid / nig, fm = gid * WGM, gsz = (nM - fm) < WGM ? (nM - fm) : WGM;
        u.pm = fm + ((wgid % nig) % gsz); u.pn = (wgid % nig) / gsz; return true;
    }
    __device__ __forceinline__ void a_ready(const Unit&) const {}
    __device__ __forceinline__ void done(const Unit&) const {}
};
__device__ __forceinline__ unsigned cvt_pk_bf16(float lo, float hi) { f32x2_t v = {lo, hi}; bf16x2_t b = __builtin_convertvector(v, bf16x2_t); return __builtin_bit_cast(unsigned, b); }

template <class Epi, class Sched, bool ALIGN_EPI = false, bool SP2 = false>
__device__ __forceinline__ void gemm_phase(LAS unsigned char* lds, const Gemm g, const Sched& S, const Epi& E) {
    const int tid = opq_v((int)threadIdx.x), wid = __builtin_amdgcn_readfirstlane(tid >> 6), lane = tid & 63, wr = wid >> 2, wc = wid & 3, fr = lane & 15, fq = lane >> 4;
    const int K = g.K, nt = K / BK;
    unsigned voffA[2], voffB[2];
#pragma unroll
    for (int i = 0; i < 2; ++i) { int R, C; stage_rc(tid * 16 + i * 8192, R, C); const int Rb = Epi::PERM ? ((R & ~31) + perm32(R & 31)) : R;
        voffA[i] = (unsigned)(R * K + C) * 2u; voffB[i] = (unsigned)(Rb * K + C) * 2u; }
    const size_t kstep = (size_t)(BK * 2);
    const size_t hstep = (size_t)HALF * K * 2;
    const size_t tstep = 2 * hstep;
    const unsigned ldsw = (unsigned)wid * 1024u;
    const int aoff = lds_byte(wr * 64 + fr, fq * 8), boff = lds_byte(wc * 32 + fr, fq * 8);
#define PG8_SA(b, h) (((b) * 2 + (h)) * HTB)
#define PG8_SB(b, h) ((4 + (b) * 2 + (h)) * HTB)
#define PG8_STAGE(bufoff, gbase, voff) do { _Pragma("unroll") for (int _i = 0; _i < 2; ++_i) \
        __builtin_amdgcn_global_load_lds((const unsigned*)((const char*)(gbase) + (voff)[_i]), (LAS unsigned*)(lds + (bufoff) + ldsw + _i * 8192), 16, 0, 0); } while (0)
#define PG8_LDA(dst, b, h) do { _Pragma("unroll") for (int m = 0; m < 4; ++m) _Pragma("unroll") for (int k = 0; k < 2; ++k) dst[m][k] = *(const LAS bf16x8*)(lds + PG8_SA(b, h) + aoff + m * 2048 + k * 1024); } while (0)
#define PG8_LDB(dst, b, h) do { _Pragma("unroll") for (int n = 0; n < 2; ++n) _Pragma("unroll") for (int k = 0; k < 2; ++k) dst[n][k] = *(const LAS bf16x8*)(lds + PG8_SB(b, h) + boff + n * 2048 + k * 1024); } while (0)
#define PG8_MMA(ai, bj, At, Bt) do { __builtin_amdgcn_s_setprio(1); _Pragma("unroll") for (int m = 0; m < 4; ++m) _Pragma("unroll") for (int n = 0; n < 2; ++n) _Pragma("unroll") for (int k = 0; k < 2; ++k) \
        acc[ai][bj][m][n] = __builtin_amdgcn_mfma_f32_16x16x32_bf16(Bt[n][k], At[m][k], acc[ai][bj][m][n], 0, 0, 0); __builtin_amdgcn_s_setprio(0); } while (0)
#define PG8_WAIT_V(n) asm volatile("s_waitcnt vmcnt(" #n ")" ::: "memory")
#define PG8_WAIT_L(n) asm volatile("s_waitcnt lgkmcnt(" #n ")" ::: "memory")
#define PG8_BAR __builtin_amdgcn_s_barrier()
#define PG8_SCHED __builtin_amdgcn_sched_barrier(0)
    Unit cur, nxt; int ui = 0;
    if (!S.next(0, cur)) return;
    f32x4 acc[2][2][4][2];
#pragma unroll
    for (int a = 0; a < 2; ++a)
#pragma unroll
        for (int b = 0; b < 2; ++b)
#pragma unroll
            for (int m = 0; m < 4; ++m)
#pragma unroll
                for (int n = 0; n < 2; ++n) acc[a][b][m][n] = (f32x4){0.f, 0.f, 0.f, 0.f};
    bf16x8 At[4][2], B0[2][2], B1[2][2];
    const char* cA = (const char*)g.A + (size_t)cur.pm * tstep; const char* cB = (const char*)g.Bt + (size_t)cur.pn * tstep;
    S.a_ready(cur);
    if constexpr (SP2) {
        PG8_STAGE(PG8_SB(0, 0), cB, voffB); PG8_STAGE(PG8_SB(0, 1), cB + hstep, voffB); PG8_STAGE(PG8_SA(0, 0), cA, voffA); PG8_STAGE(PG8_SA(0, 1), cA + hstep, voffA);
        if (wr == 1) PG8_BAR;
        PG8_WAIT_V(2); PG8_BAR;
        PG8_STAGE(PG8_SB(1, 0), cB + kstep, voffB); PG8_STAGE(PG8_SA(1, 0), cA + kstep, voffA); PG8_STAGE(PG8_SB(1, 1), cB + hstep + kstep, voffB);
        PG8_WAIT_V(6); PG8_BAR;
    } else {
        PG8_STAGE(PG8_SB(0, 0), cB, voffB); PG8_STAGE(PG8_SA(0, 0), cA, voffA); PG8_STAGE(PG8_SB(0, 1), cB + hstep, voffB); PG8_STAGE(PG8_SA(0, 1), cA + hstep, voffA);
        if (wr == 1) PG8_BAR;
        PG8_WAIT_V(4); PG8_BAR;
        PG8_STAGE(PG8_SB(1, 0), cB + kstep, voffB); PG8_STAGE(PG8_SA(1, 0), cA + kstep, voffA); PG8_STAGE(PG8_SB(1, 1), cB + hstep + kstep, voffB);
        PG8_WAIT_V(6); PG8_BAR;
    }
    for (;;) {
        const bool has_next = S.next(ui + 1, nxt);
        const char* nA = has_next ? (const char*)g.A + (size_t)nxt.pm * tstep : cA; const char* nB = has_next ? (const char*)g.Bt + (size_t)nxt.pn * tstep : cB;
        for (int t = 0; t < nt; t += 2) {
            const bool last = (t == nt - 2);
            const char* a1 = cA + (size_t)(t + 1) * kstep;
            const char* a2 = last ? nA : cA + (size_t)(t + 2) * kstep; const char* b2 = last ? nB : cB + (size_t)(t + 2) * kstep;
            const char* a3 = a2 + kstep; const char* b3 = b2 + kstep;
            if (last && has_next) S.a_ready(nxt);
            if constexpr (SP2) {
            PG8_LDB(B0, 0, 0); PG8_LDB(B1, 0, 1); PG8_SCHED; PG8_LDA(At, 0, 0); PG8_STAGE(PG8_SA(1, 1), a1 + hstep, voffA);
            PG8_WAIT_V(8); PG8_WAIT_L(0); PG8_BAR; PG8_MMA(0, 0, At, B0); PG8_MMA(0, 1, At, B1); PG8_BAR; PG8_SCHED;
            PG8_LDA(At, 0, 1); PG8_STAGE(PG8_SB(0, 0), b2, voffB); PG8_STAGE(PG8_SB(0, 1), b2 + hstep, voffB); PG8_STAGE(PG8_SA(0, 0), a2, voffA);
            PG8_WAIT_V(8); PG8_WAIT_L(0); PG8_BAR; PG8_MMA(1, 0, At, B0); PG8_MMA(1, 1, At, B1); PG8_BAR; PG8_SCHED;
            PG8_LDB(B0, 1, 0); PG8_LDB(B1, 1, 1); PG8_SCHED; PG8_LDA(At, 1, 0); PG8_STAGE(PG8_SA(0, 1), a2 + hstep, voffA);
            PG8_WAIT_V(8); PG8_WAIT_L(0); PG8_BAR; PG8_MMA(0, 0, At, B0); PG8_MMA(0, 1, At, B1); PG8_BAR; PG8_SCHED;
            PG8_LDA(At, 1, 1); PG8_STAGE(PG8_SB(1, 0), b3, voffB); PG8_STAGE(PG8_SB(1, 1), b3 + hstep, voffB); PG8_STAGE(PG8_SA(1, 0), a3, voffA);
            PG8_WAIT_V(8); PG8_WAIT_L(0); PG8_BAR; PG8_MMA(1, 0, At, B0); PG8_MMA(1, 1, At, B1); PG8_BAR; PG8_SCHED;
            } else {
            PG8_LDB(B0, 0, 0); PG8_SCHED; PG8_LDA(At, 0, 0); PG8_STAGE(PG8_SA(1, 1), a1 + hstep, voffA);
            PG8_WAIT_L(8); PG8_BAR; PG8_WAIT_L(0); PG8_MMA(0, 0, At, B0); PG8_BAR; PG8_SCHED;
            PG8_LDB(B1, 0, 1); PG8_STAGE(PG8_SB(0, 0), b2, voffB);
            PG8_BAR; PG8_WAIT_L(0); PG8_MMA(0, 1, At, B1); PG8_BAR;
            PG8_LDA(At, 0, 1); PG8_STAGE(PG8_SA(0, 0), a2, voffA);
            PG8_BAR; PG8_WAIT_L(0); PG8_MMA(1, 0, At, B0); PG8_BAR; PG8_SCHED;
            PG8_STAGE(PG8_SB(0, 1), b2 + hstep, voffB);
            PG8_WAIT_V(6); PG8_BAR; PG8_MMA(1, 1, At, B1); PG8_BAR;
            PG8_LDB(B0, 1, 0); PG8_SCHED; PG8_LDA(At, 1, 0); PG8_STAGE(PG8_SA(0, 1), a2 + hstep, voffA);
            PG8_WAIT_L(8); PG8_BAR; PG8_WAIT_L(0); PG8_MMA(0, 0, At, B0); PG8_BAR; PG8_SCHED;
            PG8_LDB(B1, 1, 1); PG8_STAGE(PG8_SB(1, 0), b3, voffB);
            PG8_BAR; PG8_WAIT_L(0); PG8_MMA(0, 1, At, B1); PG8_BAR;
            PG8_LDA(At, 1, 1); PG8_STAGE(PG8_SA(1, 0), a3, voffA);
            PG8_BAR; PG8_WAIT_L(0); PG8_MMA(1, 0, At, B0); PG8_BAR; PG8_SCHED;
            PG8_STAGE(PG8_SB(1, 1), b3 + hstep, voffB);
            PG8_WAIT_V(6); PG8_BAR; PG8_MMA(1, 1, At, B1); PG8_BAR;
            }
        }
        if constexpr (ALIGN_EPI) { if (wr == 0) PG8_BAR; }
        if constexpr (!Epi::AFTER_DRAIN) { E(acc, cur, wr, wc, fr, fq); S.done(cur); }
        if (!has_next) break;
#pragma unroll
        for (int a = 0; a < 2; ++a)
#pragma unroll
            for (int b = 0; b < 2; ++b)
#pragma unroll
                for (int m = 0; m < 4; ++m)
#pragma unroll
                    for (int n = 0; n < 2; ++n) acc[a][b][m][n] = (f32x4){0.f, 0.f, 0.f, 0.f};
        cur = nxt; cA = nA; cB = nB; ++ui;
        if constexpr (ALIGN_EPI) { if (wr == 1) PG8_BAR; }
    }
    PG8_WAIT_V(0);
    if constexpr (!ALIGN_EPI) { if (wr == 0) PG8_BAR; }
    PG8_BAR;
    if constexpr (Epi::AFTER_DRAIN) { E.fused(acc, cur, wr, wc, fr, fq, lds, wid, lane); S.done(cur); }
#undef PG8_SA
#undef PG8_SB
#undef PG8_STAGE
#undef PG8_LDA
#undef PG8_LDB
#undef PG8_MMA
#undef PG8_WAIT_V
#undef PG8_WAIT_L
#undef PG8_BAR
#undef PG8_SCHED
}

struct EpiSwiglu {
    static constexpr bool PERM = true, AFTER_DRAIN = false;
    bf16_t* O;
    __device__ __forceinline__ void tail(int row, int col, float a_, float u_) const { O[(size_t)row * DFF + col] = (bf16_t)f2bf(a_ * sigmoidf_(a_) * u_); }
    __device__ __forceinline__ void operator()(const f32x4 (&acc)[2][2][4][2], const Unit& u, int wr, int wc, int fr, int fq) const {
        const int row0 = u.pm * BM + wr * 64 + fr, col0 = u.pn * 128 + wc * 32 + 8 * fq;
#pragma unroll
        for (int ai = 0; ai < 2; ++ai)
#pragma unroll
            for (int m = 0; m < 4; ++m) {
                bf16_t* p = O + (size_t)(row0 + ai * HALF + m * 16) * DFF + col0;
                float v[8];
#pragma unroll
                for (int n = 0; n < 2; ++n)
#pragma unroll
                    for (int j = 0; j < 4; ++j) { const float a = acc[ai][0][m][n][j], g = acc[ai][1][m][n][j]; v[n * 4 + j] = a * sigmoidf_(a) * g; }
                u32x4 w; w.x = cvt_pk_bf16(v[0], v[1]); w.y = cvt_pk_bf16(v[2], v[3]); w.z = cvt_pk_bf16(v[4], v[5]); w.w = cvt_pk_bf16(v[6], v[7]);
                *(u32x4*)p = w;
            }
    }
};
struct EpiResid {
    static constexpr bool PERM = false, AFTER_DRAIN = false;
    const float* H; float* PRE; float s;
    __device__ __forceinline__ void tail(int row, int col, float v, float) const { const size_t o = (size_t)row * D + col; PRE[o] = H[o] * ALPHA + v * s; }
    __device__ __forceinline__ void operator()(const f32x4 (&acc)[2][2][4][2], const Unit& u, int wr, int wc, int fr, int fq) const {
        const int row0 = u.pm * BM + wr * 64 + fr, col0 = u.pn * BM + wc * 32 + 4 * fq;
#pragma unroll
        for (int ai = 0; ai < 2; ++ai)
#pragma unroll
            for (int m = 0; m < 4; ++m) {
                const size_t off = (size_t)(row0 + ai * HALF + m * 16) * D + col0;
#pragma unroll
                for (int bj = 0; bj < 2; ++bj)
#pragma unroll
                    for (int n = 0; n < 2; ++n) { const f32x4 h = *(const f32x4*)(H + off + bj * HALF + n * 16); *(f32x4*)(PRE + off + bj * HALF + n * 16) = h * ALPHA + acc[ai][bj][m][n] * s; }
            }
    }
};
struct EpiInproj {
    static constexpr bool PERM = true, AFTER_DRAIN = false;
    float* ZP; float* ZH; bf16_t* QA; bf16_t* KA; bf16_t* VA; bf16_t* G;
    __device__ __forceinline__ void tail(int row, int c, float v, float) const {
        if (c < 512) ((bf16_t*)ZP)[(size_t)row * PW + c] = (bf16_t)f2bf(v);
        else if (c < 1280) (G + (WS_HQ - WS_G) / 2)[(size_t)row * HW + (c - 512)] = (bf16_t)f2bf(v);
        else if (c < 2048) ZH[(size_t)row * 3072 + (c - 512)] = v;
        else if (c < 2816) (G + (WS_HV - WS_G) / 2)[(size_t)row * HW + (c - 2048)] = (bf16_t)f2bf(v);
        else if (c < 3584) (G + (WS_HG - WS_G) / 2)[(size_t)row * HW + (c - 2816)] = (bf16_t)f2bf(v);
        else if (c < 5888) { const int seg = (c - 3584) / 768, cc = c - 3584 - seg * 768; const int b_ = row >= L ? 1 : 0, t_ = row - b_ * L;
            if (seg == 2) VA[((size_t)b_ * 768 + cc) * LP + t_] = (bf16_t)f2bf(v);
            else (QA + (size_t)seg * ((WS_KA - WS_QA) / 2))[(size_t)(b_ * LP + t_) * 768 + cc] = (bf16_t)f2bf(seg == 0 ? v * C2 : v); }
        else G[(size_t)row * 6144 + (c - 5888)] = (bf16_t)f2bf(sigmoidf_(v));
    }
    __device__ __forceinline__ void operator()(const f32x4 (&acc)[2][2][4][2], const Unit& u, int wr, int wc, int fr, int fq) const {
        const int row0 = u.pm * BM + wr * 64 + fr, pn = u.pn;
#pragma unroll
        for (int ai = 0; ai < 2; ++ai)
#pragma unroll
            for (int m = 0; m < 4; ++m) {
                const int row = row0 + ai * HALF + m * 16;
#pragma unroll
                for (int bj = 0; bj < 2; ++bj) {
                    const int c = pn * BM + bj * HALF + wc * 32 + 8 * fq;
                    const f32x4 v0 = acc[ai][bj][m][0], v1 = acc[ai][bj][m][1];
                    if (pn < 2) { u32x4 w; w.x = cvt_pk_bf16(v0[0], v0[1]); w.y = cvt_pk_bf16(v0[2], v0[3]); w.z = cvt_pk_bf16(v1[0], v1[1]); w.w = cvt_pk_bf16(v1[2], v1[3]);
                        *(u32x4*)((bf16_t*)ZP + (size_t)row * PW + c) = w; }
                    else if (pn < 5) { u32x4 w; w.x = cvt_pk_bf16(v0[0], v0[1]); w.y = cvt_pk_bf16(v0[2], v0[3]); w.z = cvt_pk_bf16(v1[0], v1[1]); w.w = cvt_pk_bf16(v1[2], v1[3]);
                        *(u32x4*)(G + (WS_HQ - WS_G) / 2 + (size_t)row * HW + (c - 512)) = w; }
                    else if (pn < 8) { float* p = ZH + (size_t)row * 3072 + (c - 512); *(f32x4*)p = v0; *(f32x4*)(p + 4) = v1; }
                    else if (pn < 11) { u32x4 w; w.x = cvt_pk_bf16(v0[0], v0[1]); w.y = cvt_pk_bf16(v0[2], v0[3]); w.z = cvt_pk_bf16(v1[0], v1[1]); w.w = cvt_pk_bf16(v1[2], v1[3]);
                        *(u32x4*)(G + (WS_HV - WS_G) / 2 + (size_t)row * HW + (c - 2048)) = w; }
                    else if (pn < 14) { u32x4 w; w.x = cvt_pk_bf16(v0[0], v0[1]); w.y = cvt_pk_bf16(v0[2], v0[3]); w.z = cvt_pk_bf16(v1[0], v1[1]); w.w = cvt_pk_bf16(v1[2], v1[3]);
                        *(u32x4*)(G + (WS_HG - WS_G) / 2 + (size_t)row * HW + (c - 2816)) = w; }
                    else if (pn < 23) {
                        const int seg = (pn - 14) / 3, cc = c - 3584 - seg * 768;
                        if (row < T && seg == 2) {
                            const int b_ = row >= L ? 1 : 0, t_ = row - b_ * L;
                            bf16_t* vt = VA + ((size_t)b_ * 768 + cc) * LP + t_;
                            vt[0] = (bf16_t)f2bf(v0[0]); vt[LP] = (bf16_t)f2bf(v0[1]); vt[2 * LP] = (bf16_t)f2bf(v0[2]); vt[3 * LP] = (bf16_t)f2bf(v0[3]);
                            vt[4 * LP] = (bf16_t)f2bf(v1[0]); vt[5 * LP] = (bf16_t)f2bf(v1[1]); vt[6 * LP] = (bf16_t)f2bf(v1[2]); vt[7 * LP] = (bf16_t)f2bf(v1[3]);
                        } else if (row < T) {
                            const int arow = row >= L ? row - L + LP : row;
                            bf16_t* base = QA + (size_t)seg * ((WS_KA - WS_QA) / 2); const float sc = seg == 0 ? C2 : 1.f;
                            u32x4 w; w.x = cvt_pk_bf16(v0[0] * sc, v0[1] * sc); w.y = cvt_pk_bf16(v0[2] * sc, v0[3] * sc); w.z = cvt_pk_bf16(v1[0] * sc, v1[1] * sc); w.w = cvt_pk_bf16(v1[2] * sc, v1[3] * sc);
                            *(u32x4*)(base + (size_t)arow * 768 + cc) = w;
                        }
                    } else {
                        u32x4 w; w.x = cvt_pk_bf16(sigmoidf_(v0[0]), sigmoidf_(v0[1])); w.y = cvt_pk_bf16(sigmoidf_(v0[2]), sigmoidf_(v0[3]));
                        w.z = cvt_pk_bf16(sigmoidf_(v1[0]), sigmoidf_(v1[1])); w.w = cvt_pk_bf16(sigmoidf_(v1[2]), sigmoidf_(v1[3]));
                        *(u32x4*)(G + (size_t)row * 6144 + (c - 5888)) = w;
                    }
                }
            }
    }
};
struct EpiBranch {
    static constexpr bool PERM = true, AFTER_DRAIN = false;
    const bf16_t* G; int goff; float* MF; bf16_t* MB; int mode;
    __device__ __forceinline__ void tail(int row, int c, float v, float) const {
        v *= bf2f(G[(size_t)row * 6144 + goff + c]); bf16_t* mb = MB + (size_t)row * D + c;
        if (mode != 0) v += bf2f(__hip_atomic_load(mb, __ATOMIC_RELAXED, __HIP_MEMORY_SCOPE_AGENT));
        *mb = (bf16_t)f2bf(v);
    }
    __device__ __forceinline__ void operator()(const f32x4 (&acc)[2][2][4][2], const Unit& u, int wr, int wc, int fr, int fq) const {
        const int row0 = u.pm * BM + wr * 64 + fr;
#pragma unroll
        for (int ai = 0; ai < 2; ++ai)
#pragma unroll
            for (int m = 0; m < 4; ++m) {
                const int row = row0 + ai * HALF + m * 16;
#pragma unroll
                for (int bj = 0; bj < 2; ++bj) {
                    const int c = u.pn * BM + bj * HALF + wc * 32 + 8 * fq;
                    const u32x4 gw = *(const u32x4*)(G + (size_t)row * 6144 + goff + c);
                    f32x4 v0 = acc[ai][bj][m][0], v1 = acc[ai][bj][m][1];
                    v0[0] *= bflo(gw.x); v0[1] *= bfhi(gw.x); v0[2] *= bflo(gw.y); v0[3] *= bfhi(gw.y);
                    v1[0] *= bflo(gw.z); v1[1] *= bfhi(gw.z); v1[2] *= bflo(gw.w); v1[3] *= bfhi(gw.w);
                    bf16_t* mb = MB + (size_t)row * D + c;
                    if (mode != 0) { const u32x4 pw = __builtin_nontemporal_load((const u32x4*)mb);
                        v0[0] += bflo(pw.x); v0[1] += bfhi(pw.x); v0[2] += bflo(pw.y); v0[3] += bfhi(pw.y); v1[0] += bflo(pw.z); v1[1] += bfhi(pw.z); v1[2] += bflo(pw.w); v1[3] += bfhi(pw.w); }
                    u32x4 w; w.x = cvt_pk_bf16(v0[0], v0[1]); w.y = cvt_pk_bf16(v0[2], v0[3]); w.z = cvt_pk_bf16(v1[0], v1[1]); w.w = cvt_pk_bf16(v1[2], v1[3]);
                    *(u32x4*)mb = w;
                }
            }
    }
};

struct PanelStats {
    unsigned* xbuf;
    unsigned* cnt;
    float eps;
    __device__ __forceinline__ void run(const f32x4 (&v)[2][2][4][2], const Unit& u, int wr, int wc, int fr, int fq, LAS unsigned char* lds, int wid, int lane) const {
        LAS f32x2* P = (LAS f32x2*)lds;
        LAS f32x2* S = (LAS f32x2*)(lds + 8192);
#pragma unroll
        for (int ai = 0; ai < 2; ++ai)
#pragma unroll
            for (int m = 0; m < 4; ++m) {
                float s = 0.f;
#pragma unroll
                for (int bj = 0; bj < 2; ++bj)
#pragma unroll
                    for (int n = 0; n < 2; ++n) { const f32x4 x = v[ai][bj][m][n]; s += (x[0] + x[1]) + (x[2] + x[3]); }
                s += __shfl_xor(s, 16); s += __shfl_xor(s, 32);
                const float mw = s * (1.0f / 64.0f); float q = 0.f;
#pragma unroll
                for (int bj = 0; bj < 2; ++bj)
#pragma unroll
                    for (int n = 0; n < 2; ++n) { const f32x4 d = v[ai][bj][m][n] - mw; q += (d[0] * d[0] + d[1] * d[1]) + (d[2] * d[2] + d[3] * d[3]); }
                q += __shfl_xor(q, 16); q += __shfl_xor(q, 32);
                if (fq == 0) P[(ai * HALF + wr * 64 + m * 16 + fr) * 4 + wc] = (f32x2){mw, q};
            }
        asm volatile("s_waitcnt lgkmcnt(0)" ::: "memory"); __builtin_amdgcn_s_barrier(); asm volatile("" ::: "memory");
        const int row = wid * 32 + (lane & 31);
        if (lane < 32) {
            const f32x2 a = P[row * 4 + 0], b = P[row * 4 + 1], c = P[row * 4 + 2], d = P[row * 4 + 3];
            const float mt = (a.x + b.x + c.x + d.x) * 0.25f;
            const float da = a.x - mt, db = b.x - mt, dc = c.x - mt, dd = d.x - mt;
            const float m2 = (a.y + b.y) + (c.y + d.y) + 64.0f * ((da * da + db * db) + (dc * dc + dd * dd));
            unsigned long long* slot = (unsigned long long*)xbuf + ((size_t)(u.pm * BM + row) * 8 + u.pn);
            __hip_atomic_store(slot, ((unsigned long long)__float_as_uint(m2) << 32) | __float_as_uint(mt), __ATOMIC_RELAXED, __HIP_MEMORY_SCOPE_AGENT);
        }
        asm volatile("s_waitcnt vmcnt(0)" ::: "memory");
        if (lane == 0) __hip_atomic_fetch_add(cnt + 64 * u.pm, 1u, __ATOMIC_RELAXED, __HIP_MEMORY_SCOPE_AGENT);
        if (wid == 0) {
            unsigned sp = 0;
            while ((unsigned)__builtin_amdgcn_readfirstlane(__hip_atomic_load(cnt + 64 * u.pm, __ATOMIC_RELAXED, __HIP_MEMORY_SCOPE_AGENT)) < 64u) { __builtin_amdgcn_s_sleep(2); if (++sp > (1u << 24)) break; }
            __builtin_amdgcn_fence(__ATOMIC_ACQUIRE, "agent");
        }
        asm volatile("s_waitcnt vmcnt(0) lgkmcnt(0)" ::: "memory"); __builtin_amdgcn_s_barrier(); asm volatile("" ::: "memory");
        if (lane < 32) {
            const unsigned long long* slot = (const unsigned long long*)xbuf + (size_t)(u.pm * BM + row) * 8; float mt[8], m2[8]; float ms = 0.f;
#pragma unroll
            for (int t = 0; t < 8; ++t) { const unsigned long long w = __hip_atomic_load(slot + t, __ATOMIC_RELAXED, __HIP_MEMORY_SCOPE_AGENT); mt[t] = __uint_as_float((unsigned)w); m2[t] = __uint_as_float((unsigned)(w >> 32)); ms += mt[t]; }
            const float mean = ms * 0.125f; float q = 0.f;
#pragma unroll
            for (int t = 0; t < 8; ++t) { const float dm = mt[t] - mean; q += m2[t] + 256.0f * dm * dm; }
            S[row] = (f32x2){mean, 1.0f / sqrtf(q * (1.0f / 2048.0f) + eps)};
        }
        asm volatile("s_waitcnt lgkmcnt(0)" ::: "memory"); __builtin_amdgcn_s_barrier(); asm volatile("" ::: "memory");
    }
};
struct EpiLn {
    static constexpr bool PERM = false, AFTER_DRAIN = true;
    float* H; bf16_t* HB; const float* g; const float* bta; float s; PanelStats st; float* out;
    __device__ __forceinline__ void fused(f32x4 (&acc)[2][2][4][2], const Unit& u, int wr, int wc, int fr, int fq, LAS unsigned char* lds, int wid, int lane) const {
        const LAS f32x2* S = (const LAS f32x2*)(lds + 8192);
        const int col0 = u.pn * BM + wc * 32 + 4 * fq;
#pragma unroll
        for (int ai = 0; ai < 2; ++ai)
#pragma unroll
            for (int m = 0; m < 4; ++m) { const size_t off = (size_t)(u.pm * BM + ai * HALF + wr * 64 + m * 16 + fr) * D + col0;
#pragma unroll
                for (int bj = 0; bj < 2; ++bj)
#pragma unroll
                    for (int n = 0; n < 2; ++n) { const f32x4 h = *(const f32x4*)(H + off + bj * HALF + n * 16); acc[ai][bj][m][n] = h * ALPHA + acc[ai][bj][m][n] * s; }
                asm volatile("" : "+v"(acc[ai][0][m][0]), "+v"(acc[ai][0][m][1]), "+v"(acc[ai][1][m][0]), "+v"(acc[ai][1][m][1]));
                if (m & 1) asm volatile("" ::: "memory"); }
        st.run(acc, u, wr, wc, fr, fq, lds, wid, lane);
#pragma unroll
        for (int ai = 0; ai < 2; ++ai)
#pragma unroll
            for (int m = 0; m < 4; ++m) { const int r = ai * HALF + wr * 64 + m * 16 + fr, row = u.pm * BM + r; const f32x2 sr = S[r];
#pragma unroll
                for (int bj = 0; bj < 2; ++bj)
#pragma unroll
                    for (int n = 0; n < 2; ++n) { const int c = col0 + bj * HALF + n * 16; const f32x4 o = (acc[ai][bj][m][n] - sr.x) * sr.y * *(const f32x4*)(g + c) + *(const f32x4*)(bta + c);
                        if (out) { const int b_ = row >= L ? 1 : 0, t_ = row - b_ * L; if (t_ >= NMETA) *(f32x4*)(out + ((size_t)b_ * SEQ + (t_ - NMETA)) * D + c) = o; }
                        else { *(f32x4*)(H + (size_t)row * D + c) = o; u32x2 w; w.x = cvt_pk_bf16(o[0], o[1]); w.y = cvt_pk_bf16(o[2], o[3]); *(u32x2*)(HB + (size_t)row * D + c) = w; } } }
    }
};
}


constexpr int MT = 8192;
template <class Epi, bool PAIR>
__device__ __forceinline__ void tail_gemm(const bf16_t* A, const bf16_t* Bt, int K, int ncols, const Epi& E, unsigned char* lds_g, int blk, int nblk) {
    const int tid = opq_v((int)threadIdx.x), lane = tid & 63, wid = __builtin_amdgcn_readfirstlane(tid >> 6), m = lane & 31, hi = lane >> 5;
    float* P = (float*)lds_g;
    const int kslice = K / 8, k0 = wid * kslice;
    for (int tu = blk; tu < ncols / 32; tu += nblk) {
        const int n0 = tu * 32, brow = PAIR ? ((n0 / 128) * 256 + (n0 % 128)) : n0;
        const bf16_t* ap = A + (size_t)(MT + m) * K + k0 + 8 * hi; const bf16_t* bp = Bt + (size_t)(brow + m) * K + k0 + 8 * hi;
        f32x16_t acc0 = (f32x16_t){0.f, 0.f, 0.f, 0.f, 0.f, 0.f, 0.f, 0.f, 0.f, 0.f, 0.f, 0.f, 0.f, 0.f, 0.f, 0.f}, acc1 = acc0;
#pragma unroll 8
        for (int ks = 0; ks < kslice; ks += 16) {
            const bf16x8 av = *(const bf16x8*)(ap + ks), bv = *(const bf16x8*)(bp + ks);
            acc0 = __builtin_amdgcn_mfma_f32_32x32x16_bf16(av, bv, acc0, 0, 0, 0);
            if (PAIR) { const bf16x8 bu = *(const bf16x8*)(bp + (size_t)128 * K + ks); acc1 = __builtin_amdgcn_mfma_f32_32x32x16_bf16(av, bu, acc1, 0, 0, 0); }
        }
        __syncthreads();
#pragma unroll
        for (int r = 0; r < 16; ++r) { const int rm = (r & 3) + 8 * (r >> 2) + 4 * hi; P[wid * 1024 + rm * 32 + m] = acc0[r]; if (PAIR) P[8192 + wid * 1024 + rm * 32 + m] = acc1[r]; }
        __syncthreads();
#pragma unroll
        for (int e = 0; e < 2; ++e) { const int idx = tid * 2 + e; float v0 = 0.f, v1 = 0.f;
#pragma unroll
            for (int w = 0; w < 8; ++w) { v0 += P[w * 1024 + idx]; if (PAIR) v1 += P[8192 + w * 1024 + idx]; }
            E.tail(MT + (idx >> 5), n0 + (idx & 31), v0, v1); }
    }
    __syncthreads();
}

struct Args {
    const float* x; const float* meta; const float* ln_g; const float* ln_b; const float* ffn_w_in; const float* ffn_w_out; const float* w_in;
    const float* pool_w; const float* pool_scale; const float* hgrn_lb; const float* hgrn_ng; const float* diff_lambda; const float* diff_ng;
    const float* w_bp; const float* w_bh; const float* w_bd; const float* w_out;
    float* out; unsigned char* ws;
};

typedef const Args* ArgP;
__device__ __forceinline__ ArgP argp() { unsigned z; asm volatile("s_mov_b32 %0, 0" : "=s"(z)); return (ArgP)(const void*)((const __attribute__((address_space(4))) char*)__builtin_amdgcn_kernarg_segment_ptr() + z); }

__device__ __forceinline__ void transpose_item(const float* W, int K, int N, bf16_t* WT, int swiglu, float* scr, int item, int lane) {
    const int nblk = N / 64, kb = item / nblk, nb = item % nblk, k0 = 64 * kb, n0 = 64 * nb;
    int drow0 = n0;
    if (swiglu) { const int half = n0 / DFF, rem = n0 % DFF; drow0 = (rem / 128) * 256 + half * 128 + (rem % 128); }
    f32x4 v[16];
#pragma unroll
    for (int i = 0; i < 16; ++i) v[i] = *(const f32x4*)(W + (size_t)(k0 + 4 * i + (lane >> 4)) * N + n0 + 4 * (lane & 15));
#pragma unroll
    for (int i = 0; i < 16; ++i) { float* s = scr + (4 * i + (lane >> 4)) * 65 + 4 * (lane & 15); s[0] = v[i][0]; s[1] = v[i][1]; s[2] = v[i][2]; s[3] = v[i][3]; }
    asm volatile("s_waitcnt lgkmcnt(0)" ::: "memory");
    const int c = lane & 7;
#pragma unroll
    for (int j = 0; j < 8; ++j) { const int n = (lane >> 3) + 8 * j; const float* s = scr + (8 * c) * 65 + n;
        u32x4 o; o.x = pk2(s[0 * 65], s[1 * 65]); o.y = pk2(s[2 * 65], s[3 * 65]); o.z = pk2(s[4 * 65], s[5 * 65]); o.w = pk2(s[6 * 65], s[7 * 65]);
        *(u32x4*)(WT + (size_t)(drow0 + n) * K + k0 + 8 * c) = o; }
    asm volatile("s_waitcnt lgkmcnt(0)" ::: "memory");
}

__device__ __forceinline__ void prologue(unsigned char* lds_g, int gw, int NGW, int lane) {
    const Args a = *argp();
    float* scr = (float*)lds_g + (opq_v((int)threadIdx.x) >> 6) * (64 * 65);
    unsigned char* ws = a.ws;
    constexpr int I_UP = (D / 64) * (2 * DFF / 64), I_DN = (DFF / 64) * (D / 64), I_IN = (D / 64) * (INCOLS / 64);
    constexpr int I_BP = (PW / 64) * (D / 64), I_BH = (HW / 64) * (D / 64), I_WO = (D / 64) * (D / 64);
    constexpr int PER_L = 2 * I_UP + 2 * I_DN + I_IN + I_BP + 2 * I_BH + I_WO;
    for (int it = gw; it < 2 * PER_L; it += NGW) {
        const int l = it / PER_L; int r = it % PER_L;
        if (r < 2 * I_UP) { const int j = r / I_UP; r %= I_UP; transpose_item(a.ffn_w_in + (size_t)(l * 2 + j) * D * 2 * DFF, D, 2 * DFF, (bf16_t*)(ws + WS_WUP + (size_t)(l * 2 + j) * SZ_WUP), 1, scr, r, lane); continue; } r -= 2 * I_UP;
        if (r < 2 * I_DN) { const int j = r / I_DN; r %= I_DN; transpose_item(a.ffn_w_out + (size_t)(l * 2 + j) * DFF * D, DFF, D, (bf16_t*)(ws + WS_WDN + (size_t)(l * 2 + j) * SZ_WDN), 0, scr, r, lane); continue; } r -= 2 * I_DN;
        if (r < I_IN) { transpose_item(a.w_in + (size_t)l * D * INCOLS, D, INCOLS, (bf16_t*)(ws + WS_WIN + (size_t)l * SZ_WIN), 0, scr, r, lane); continue; } r -= I_IN;
        if (r < I_BP) { transpose_item(a.w_bp + (size_t)l * PW * D, PW, D, (bf16_t*)(ws + WS_WBP + (size_t)l * D * PW * 2), 0, scr, r, lane); continue; } r -= I_BP;
        if (r < I_BH) { transpose_item(a.w_bh + (size_t)l * HW * D, HW, D, (bf16_t*)(ws + WS_WBH + (size_t)l * D * HW * 2), 0, scr, r, lane); continue; } r -= I_BH;
        if (r < I_BH) { transpose_item(a.w_bd + (size_t)l * DW * D, DW, D, (bf16_t*)(ws + WS_WBD + (size_t)l * D * DW * 2), 0, scr, r, lane); continue; } r -= I_BH;
        transpose_item(a.w_out + (size_t)l * D * D, D, D, (bf16_t*)(ws + WS_WO + (size_t)l * D * D * 2), 0, scr, r, lane);
    }
    float* H = (float*)(ws + WS_H); bf16_t* HB = (bf16_t*)(ws + WS_HB);
    for (int r = gw; r < MP; r += NGW) {
        const float* src = nullptr;
        if (r < T) { const int b = r / L, t = r % L; src = t < NMETA ? a.meta + (size_t)t * D : a.x + ((size_t)b * SEQ + (t - NMETA)) * D; }
#pragma unroll
        for (int j = 0; j < 8; ++j) {
            f32x4 v = src ? *(const f32x4*)(src + 4 * lane + 256 * j) : (f32x4){0.f, 0.f, 0.f, 0.f};
            *(f32x4*)(H + (size_t)r * D + 4 * lane + 256 * j) = v;
            u32x2 w; w.x = pk2(v[0], v[1]); w.y = pk2(v[2], v[3]);
            *(u32x2*)(HB + (size_t)r * D + 4 * lane + 256 * j) = w;
        }
    }
    for (int i = gw; i < NB * (LP - L) * 2; i += NGW) {
        const int seg = i / (NB * (LP - L)), rr = i % (NB * (LP - L)), b = rr / (LP - L), t = L + rr % (LP - L);
        bf16_t* base = (bf16_t*)(ws + WS_QA + (size_t)seg * (WS_KA - WS_QA)) + (size_t)(b * LP + t) * 768;
        for (int c = lane; c < 768 / 8; c += 64) *(u32x4*)(base + 8 * c) = (u32x4){0u, 0u, 0u, 0u};
    }
    for (int i = gw; i < NB * 768; i += NGW) {
        bf16_t* base = (bf16_t*)(ws + WS_VA) + (size_t)i * LP + L;
        for (int c = lane; c < (LP - L) / 8; c += 64) *(u32x4*)(base + 8 * c) = (u32x4){0u, 0u, 0u, 0u};
    }
}

__device__ __forceinline__ void ln_rows(int lnidx, bool final_, int r_begin, int r_end, int gw, int NGW, int lane) {
    const Args a = *argp(); const float* g = a.ln_g + (size_t)lnidx * D; const float* bvec = a.ln_b + (size_t)lnidx * D;
    const float* PRE = (const float*)(a.ws + WS_PRE); float* H = (float*)(a.ws + WS_H); bf16_t* HB = (bf16_t*)(a.ws + WS_HB);
    for (int r = r_begin + gw; r < r_end; r += NGW) {
        f32x4 v[8]; float s = 0.f;
#pragma unroll
        for (int j = 0; j < 8; ++j) { v[j] = *(const f32x4*)(PRE + (size_t)r * D + 4 * lane + 256 * j); s += (v[j][0] + v[j][1]) + (v[j][2] + v[j][3]); }
        const float mean = wave_sum(s) * (1.f / D); float s2 = 0.f;
#pragma unroll
        for (int j = 0; j < 8; ++j) { v[j] = v[j] - mean; s2 += (v[j][0] * v[j][0] + v[j][1] * v[j][1]) + (v[j][2] * v[j][2] + v[j][3] * v[j][3]); }
        const float rstd = 1.f / sqrtf(wave_sum(s2) * (1.f / D) + LN_EPS);
        if (final_) {
            const int b = r / L, t = r % L;
            if (t >= NMETA) {
                float* o = a.out + ((size_t)b * SEQ + (t - NMETA)) * D;
#pragma unroll
                for (int j = 0; j < 8; ++j) { const f32x4 gg = *(const f32x4*)(g + 4 * lane + 256 * j), bb = *(const f32x4*)(bvec + 4 * lane + 256 * j); *(f32x4*)(o + 4 * lane + 256 * j) = v[j] * rstd * gg + bb; }
            }
        } else {
#pragma unroll
            for (int j = 0; j < 8; ++j) { const f32x4 gg = *(const f32x4*)(g + 4 * lane + 256 * j), bb = *(const f32x4*)(bvec + 4 * lane + 256 * j); const f32x4 o = v[j] * rstd * gg + bb;
                *(f32x4*)(H + (size_t)r * D + 4 * lane + 256 * j) = o; u32x2 w; w.x = pk2(o[0], o[1]); w.y = pk2(o[2], o[3]); *(u32x2*)(HB + (size_t)r * D + 4 * lane + 256 * j) = w; }
        }
    }
}

__device__ __forceinline__ void pool_phase(int l, unsigned char* lds_g, int blk, int nblk) {
    const Args a = *argp();
    const float* ZP = (const float*)(a.ws + WS_ZP); bf16_t* YP = (bf16_t*)(a.ws + WS_YP);
    constexpr int WP = 136;
    bf16_t* WT = (bf16_t*)lds_g;
    bf16_t* Pb = WT + 128 * WP;
    float* U = (float*)(lds_g + 53248);
    const int tid = opq_v((int)threadIdx.x), lane = tid & 63, wid = tid >> 6, r32 = lane & 31, hi = lane >> 5;
    const int g = blk & 3, bi = blk >> 2, nb = nblk >> 2, w = 2 << g;
    const float* Wg = a.pool_w + ((size_t)l * 4 + g) * 128 * 128;
    for (int i = tid; i < 128 * 32; i += 512) { const int c = i >> 5, d4 = i & 31; const f32x4 v = *(const f32x4*)(Wg + c * 128 + 4 * d4);
        WT[(4 * d4 + 0) * WP + c] = (bf16_t)f2bf(v[0]); WT[(4 * d4 + 1) * WP + c] = (bf16_t)f2bf(v[1]); WT[(4 * d4 + 2) * WP + c] = (bf16_t)f2bf(v[2]); WT[(4 * d4 + 3) * WP + c] = (bf16_t)f2bf(v[3]); }
    const int dt = wid & 3, tt = wid >> 2;
    const float scv = a.pool_scale[l * PW + g * 128 + 32 * dt + r32];
    constexpr int TPB = (L + 63) / 64;
    for (int tile = bi; tile < NB * TPB; tile += nb) {
        const int b = tile / TPB, t0 = (tile % TPB) * 64;
        __syncthreads();
        for (int i = tid; i < 79 * 32; i += 512) { const int rr = i >> 5, c4 = i & 31, t = t0 - 15 + rr;
            f32x4 uv = (f32x4){0.f, 0.f, 0.f, 0.f};
            if (t >= 0 && t < L) { const u32x2 w = *(const u32x2*)((const bf16_t*)ZP + (size_t)(b * L + t) * PW + g * 128 + 4 * c4); uv = (f32x4){bflo(w.x), bfhi(w.x), bflo(w.y), bfhi(w.y)}; }
            ((f32x4*)U)[i] = uv; }
        __syncthreads();
        { const int c = tid & 127, ts = (tid >> 7) * 16;
            float s_ = 0.f;
            for (int q = 1; q < w; ++q) { const int t = t0 + ts - q; if (t >= 0) s_ += U[(ts - q + 15) * 128 + c]; }
            for (int k = 0; k < 16; ++k) { const int ti = ts + k, t = t0 + ti; const float ut = U[(ti + 15) * 128 + c]; s_ += ut;
                const int cnt = (t + 1) < w ? (t + 1) : w;
                Pb[ti * WP + c] = (bf16_t)f2bf(s_ / (float)cnt - ut);
                if (t + 1 - w >= 0) s_ -= U[(ti + 15 - w + 1) * 128 + c]; } }
        __syncthreads();
        f32x16_t acc = (f32x16_t){0.f, 0.f, 0.f, 0.f, 0.f, 0.f, 0.f, 0.f, 0.f, 0.f, 0.f, 0.f, 0.f, 0.f, 0.f, 0.f};
#pragma unroll
        for (int i = 0; i < 8; ++i) { const bf16x8 av = *(const bf16x8*)(Pb + (32 * tt + r32) * WP + 16 * i + 8 * hi), bv = *(const bf16x8*)(WT + (32 * dt + r32) * WP + 16 * i + 8 * hi);
            acc = __builtin_amdgcn_mfma_f32_32x32x16_bf16(av, bv, acc, 0, 0, 0); }
#pragma unroll
        for (int r = 0; r < 16; ++r) { const int t = t0 + 32 * tt + (r & 3) + 8 * (r >> 2) + 4 * hi;
            if (t < L) YP[(size_t)(b * L + t) * PW + g * 128 + 32 * dt + r32] = (bf16_t)f2bf(acc[r] * scv); }
    }
    __syncthreads();
}

__device__ __forceinline__ void hgrn_naive(int l, unsigned char* lds_g, int blk) {
    const Args a = *argp();
    const float* ZH = (const float*)(a.ws + WS_ZH); float* OH = (float*)(a.ws + WS_OH);
    const int tid = opq_v((int)threadIdx.x), ch = tid >> 8, j = tid & 127, kh = (tid >> 7) & 1, chain = blk * 2 + ch, b = chain / 6, h = chain % 6;
    float* sh = (float*)lds_g + ch * 640;
    float lb = 0.f;
    if (l == 1) { const float x0 = a.hgrn_lb[h * 128 + j], x1 = a.hgrn_lb[HW + h * 128 + j]; const float e0 = __expf(x0), e1 = __expf(x1); lb = e1 / (e0 + e1); }
    float S[64];
#pragma unroll
    for (int k = 0; k < 64; ++k) S[k] = 0.f;
    for (int t = 0; t < L; ++t) {
        const float* z = ZH + (size_t)(b * L + t) * 3072 + h * 128;
        if (kh == 0) { const float fz = z[768 + j], f = lb + (1.f - lb) * (1.f / (1.f + __expf(-fz))); sh[j] = f; sh[128 + j] = 1.f - f; sh[256 + j] = z[j]; }
        const float vj = z[1536 + j];
        __syncthreads();
        float o = 0.f;
#pragma unroll
        for (int k4 = 0; k4 < 16; ++k4) {
            const f32x4 f4 = *(const f32x4*)(sh + kh * 64 + 4 * k4), k4v = *(const f32x4*)(sh + 128 + kh * 64 + 4 * k4), q4 = *(const f32x4*)(sh + 256 + kh * 64 + 4 * k4);
#pragma unroll
            for (int e = 0; e < 4; ++e) { S[4 * k4 + e] = f4[e] * S[4 * k4 + e] + k4v[e] * vj; o += q4[e] * S[4 * k4 + e]; }
        }
        sh[384 + kh * 128 + j] = o;
        __syncthreads();
        if (kh == 0) OH[(size_t)(b * L + t) * HW + h * 128 + j] = (sh[384 + j] + sh[512 + j]) * 0.08838834764831845f;
    }
}

__device__ __forceinline__ void attn_naive(int blk, int nblk) {
    const Args a = *argp();
    const bf16_t* QA = (const bf16_t*)(a.ws + WS_QA); const bf16_t* KA = (const bf16_t*)(a.ws + WS_KA); const bf16_t* VA = (const bf16_t*)(a.ws + WS_VA);
    float* OD = (float*)(a.ws + WS_OD);
    const int tid = opq_v((int)threadIdx.x), wid = tid >> 6;
    for (int unit = blk; unit < NB * 12 * 4 * 9; unit += nblk) {
        const int qc = unit % 9, vq = (unit / 9) & 3, vh = (unit / 36) % 12, b = unit / 432, h = vh >> 1;
        const int q = qc * 512 + tid; const int qq = q < L ? q : L - 1;
        float qf[64];
        { const bf16_t* qp = QA + (size_t)(b * LP + qq) * 768 + vh * 64;
#pragma unroll
            for (int i = 0; i < 8; ++i) { const u32x4 w = *(const u32x4*)(qp + 8 * i); qf[8 * i] = bflo(w.x); qf[8 * i + 1] = bfhi(w.x); qf[8 * i + 2] = bflo(w.y); qf[8 * i + 3] = bfhi(w.y); qf[8 * i + 4] = bflo(w.z); qf[8 * i + 5] = bfhi(w.z); qf[8 * i + 6] = bflo(w.w); qf[8 * i + 7] = bfhi(w.w); } }
        int kmax = qc * 512 + wid * 64 + 63; if (kmax > L - 1) kmax = L - 1;
        kmax = __builtin_amdgcn_readfirstlane(kmax);
        float mx = -INFINITY, lsum = 0.f, o[32];
#pragma unroll
        for (int i = 0; i < 32; ++i) o[i] = 0.f;
        for (int key = 0; key <= kmax; ++key) {
            const bf16_t* kp = KA + (size_t)(b * LP + key) * 768 + vh * 64;
            float s = 0.f;
#pragma unroll
            for (int i = 0; i < 8; ++i) { const u32x4 w = *(const u32x4*)(kp + 8 * i);
                s += qf[8 * i] * bflo(w.x) + qf[8 * i + 1] * bfhi(w.x) + qf[8 * i + 2] * bflo(w.y) + qf[8 * i + 3] * bfhi(w.y) + qf[8 * i + 4] * bflo(w.z) + qf[8 * i + 5] * bfhi(w.z) + qf[8 * i + 6] * bflo(w.w) + qf[8 * i + 7] * bfhi(w.w); }
            if (key <= qq) {
                const float mn = fmaxf(mx, s), al_ = __builtin_amdgcn_exp2f(mx - mn), p = __builtin_amdgcn_exp2f(s - mn);
                lsum = lsum * al_ + p; mx = mn;
                const bf16_t* vp = VA + (size_t)(b * LP + key) * 768 + h * 128 + vq * 32;
#pragma unroll
                for (int i = 0; i < 4; ++i) { const u32x4 w = *(const u32x4*)(vp + 8 * i);
                    o[8 * i] = o[8 * i] * al_ + p * bflo(w.x); o[8 * i + 1] = o[8 * i + 1] * al_ + p * bfhi(w.x); o[8 * i + 2] = o[8 * i + 2] * al_ + p * bflo(w.y); o[8 * i + 3] = o[8 * i + 3] * al_ + p * bfhi(w.y);
                    o[8 * i + 4] = o[8 * i + 4] * al_ + p * bflo(w.z); o[8 * i + 5] = o[8 * i + 5] * al_ + p * bfhi(w.z); o[8 * i + 6] = o[8 * i + 6] * al_ + p * bflo(w.w); o[8 * i + 7] = o[8 * i + 7] * al_ + p * bfhi(w.w); }
            }
        }
        if (q < L) { const float rl = 1.f / lsum; float* op = OD + ((size_t)(b * LP + q) * 12 + vh) * 128 + vq * 32;
#pragma unroll
            for (int i = 0; i < 8; ++i) *(f32x4*)(op + 4 * i) = (f32x4){o[4 * i] * rl, o[4 * i + 1] * rl, o[4 * i + 2] * rl, o[4 * i + 3] * rl}; }
    }
}


constexpr int HC = 32, HNC = (L + HC - 1) / HC;
constexpr int HR_QP = 136  , HR_Q = 0, HR_K = HC * HR_QP * 2  , HR_A = HR_K + 128 * HC * 2  , HR_D = HR_A + HC * HC * 2  , HR_SH = HR_D + 512  ;
constexpr int HR_V = HR_SH, HR_VH = 64 * HC * 2  , HR_BYTES = HR_SH + 2 * HR_VH  , HS_BYTES = HR_SH + HR_VH  ;
constexpr int HG_NS = 4;
constexpr size_t WS_REC = WS_END_HG;
constexpr size_t WS_END2 = WS_REC + (size_t)12 * 257 * 14336;
constexpr size_t WS_XB = WS_END2, WS_END3 = WS_XB + (size_t)8192 * 8 * 8;
static_assert(12 * HNC * HR_BYTES <= 12 * 257 * 14336 && HG_NS * HS_BYTES + 16384 <= 131072 && HR_SH % 1024 == 0, "hgrn record / ring / output staging");

__device__ __forceinline__ void hgrn_pre(int l, unsigned char* lds_g, int blk, int nblk) {
    const Args a = *argp();
    const float* ZH = (const float*)(a.ws + WS_ZH); unsigned char* REC = a.ws + WS_REC;
    const int tid = opq_v((int)threadIdx.x);
    constexpr int HP = 132;
    float* lf = (float*)lds_g; float* kk = lf + HC * HP; float* qs = kk + HC * HP; float* bc = qs + HC * HP; float* vv = bc + HC * HP;
    for (int rec = blk; rec < 12 * HNC; rec += nblk) {
        const int bh = rec / HNC, c = rec % HNC, b = bh / 6, h = bh % 6;
        const size_t r0 = (size_t)b * L + HC * c;
        float lb = 0.f;
        if (l == 1) { const int k = tid & 127; const float x0 = a.hgrn_lb[h * 128 + k], x1 = a.hgrn_lb[HW + h * 128 + k]; const float e0 = __expf(x0), e1 = __expf(x1); lb = e1 / (e0 + e1); }
        for (int idx = tid; idx < HC * 128; idx += 512) {
            const int t = idx >> 7, k = idx & 127;
            float lfv = 0.f, kv = 0.f, qv = 0.f, vvv = 0.f;
            if (HC * c + t < L) {
                const float* z = ZH + (r0 + t) * 3072 + h * 128 + k;
                const float f = lb + (1.f - lb) * (1.f / (1.f + __expf(-z[768])));
                lfv = __logf(f); kv = 1.f - f; qv = bf2f(((const bf16_t*)(a.ws + WS_HQ))[(r0 + t) * HW + h * 128 + k]) * 0.08838834764831845f; vvv = bf2f(((const bf16_t*)(a.ws + WS_HV))[(r0 + t) * HW + h * 128 + k]);
            }
            lf[t * HP + k] = lfv; kk[t * HP + k] = kv; qs[t * HP + k] = qv; vv[t * HP + k] = vvv;
        }
        __syncthreads();
        if (tid < 128) { float cv[HC];
#pragma unroll
            for (int t = 0; t < HC; ++t) cv[t] = lf[t * HP + tid];
            float run = 0.f;
#pragma unroll
            for (int t = 0; t < HC; ++t) { run += cv[t]; bc[t * HP + tid] = run; } }
        __syncthreads();
        unsigned char* R = REC + (size_t)rec * HR_BYTES;
        for (int idx = tid; idx < HC * 128; idx += 512) {
            { const int t = idx >> 7, k = idx & 127; ((bf16_t*)(R + HR_Q))[t * HR_QP + k] = (bf16_t)f2bf(qs[t * HP + k] * __expf(bc[t * HP + k])); }
            { const int k = idx >> 5, s_ = idx & 31; ((bf16_t*)(R + HR_K))[idx] = (bf16_t)f2bf(kk[s_ * HP + k] * __expf(bc[(HC - 1) * HP + k] - bc[s_ * HP + k]));
              ((bf16_t*)(R + HR_V))[idx] = (bf16_t)f2bf(vv[s_ * HP + k]); }
        }
        if (tid < 128) ((float*)(R + HR_D))[tid] = __expf(bc[(HC - 1) * HP + tid]);
#pragma unroll
        for (int e = 0; e < 2; ++e) { const int p = tid + 512 * e, t = p >> 5, s_ = p & 31; float acc = 0.f;
            if (s_ <= t) {
#pragma unroll 2
                for (int k = 0; k < 128; k += 4) { const f32x4 q4 = *(const f32x4*)(qs + t * HP + k), k4 = *(const f32x4*)(kk + s_ * HP + k), bt = *(const f32x4*)(bc + t * HP + k), bs = *(const f32x4*)(bc + s_ * HP + k);
                    acc += q4[0] * k4[0] * __expf(bt[0] - bs[0]) + q4[1] * k4[1] * __expf(bt[1] - bs[1]) + q4[2] * k4[2] * __expf(bt[2] - bs[2]) + q4[3] * k4[3] * __expf(bt[3] - bs[3]); } }
            ((bf16_t*)(R + HR_A))[p] = (bf16_t)f2bf(acc); }
        __syncthreads();
    }
}

__device__ __forceinline__ void hgrn_scan(int bh, int vhalf, LAS unsigned char* ldsl) {
    const Args a = *argp();
    const unsigned char* REC = a.ws + WS_REC + (size_t)bh * HNC * HR_BYTES; float* OH = (float*)(a.ws + WS_OH);
    const int tid = opq_v((int)threadIdx.x), lane = tid & 63, wid = __builtin_amdgcn_readfirstlane(tid >> 6), n = lane & 15, g = lane >> 4;
    const int b = bh / 6, h = bh % 6;
    const bool loader = wid < 4 || wid >= 6; const int li = wid < 4 ? wid : wid - 2; const bool four = loader && li < 5;
    LAS unsigned char* OST = ldsl + HG_NS * HS_BYTES;
#define HG_PIECE(q_) do { const int pb_ = 384 * (q_) + 64 * li;   \
        const unsigned char* s_ = (pb_ < 1216 ? rsrc_ + (size_t)pb_ * 16 : rsrc_ + HR_SH + HR_VH * vhalf + (size_t)(pb_ - 1216) * 16) + lane * 16; \
        __builtin_amdgcn_global_load_lds((const unsigned*)s_, (LAS unsigned*)(rdst_ + pb_ * 16), 16, 0, 0); } while (0)
#define HG_DMA(cc) do { if (loader) { const int c_ = (cc) < HNC ? (cc) : HNC - 1; const unsigned char* rsrc_ = REC + (size_t)c_ * HR_BYTES; LAS unsigned char* rdst_ = ldsl + ((cc) % HG_NS) * HS_BYTES; \
        HG_PIECE(0); HG_PIECE(1); HG_PIECE(2); if (four) HG_PIECE(3); } } while (0)
#define HG_OUT(ss) do { const LAS float* src_ = (const LAS float*)(OST + ((ss) & 1) * 8192); const int e_ = (wid - 4) * 64 + lane; \
        _Pragma("unroll") for (int q_ = 0; q_ < 4; ++q_) { const int idx_ = e_ + 128 * q_, t_ = idx_ >> 4, c4_ = idx_ & 15;    \
            if (HC * (ss) + t_ < L) { const f32x4 v_ = *(const LAS f32x4*)(src_ + (c4_ >> 2) * 512 + t_ * 16 + (c4_ & 3) * 4); \
                u32x2 w_; w_.x = pg8::cvt_pk_bf16(v_[0], v_[1]); w_.y = pg8::cvt_pk_bf16(v_[2], v_[3]);                    \
                *(u32x2*)((bf16_t*)OH + ((size_t)b * L + HC * (ss) + t_) * HW + h * 128 + 64 * vhalf + 4 * c4_) = w_; } } } while (0)
    f32x4 S[8];
#pragma unroll
    for (int i = 0; i < 8; ++i) S[i] = (f32x4){0.f, 0.f, 0.f, 0.f};
    for (int c = 0; c < HG_NS - 1; ++c) HG_DMA(c);
    for (int s_ = 0; s_ < HNC; ++s_) {
        if (four) asm volatile("s_waitcnt vmcnt(8)" ::: "memory"); else if (loader) asm volatile("s_waitcnt vmcnt(6)" ::: "memory");
        asm volatile("s_waitcnt lgkmcnt(0)" ::: "memory");
        __builtin_amdgcn_s_barrier();
        asm volatile("" ::: "memory");
        const LAS unsigned char* R = ldsl + (s_ % HG_NS) * HS_BYTES;
        if ((wid == 4 || wid == 5) && s_ > 0) HG_OUT(s_ - 1);
        if (wid < 4) {
            s16x4 qa0[2][4], qa1[2][4]; bf16x8 at[2], ka[8], vb; f32x4 dv[8];
#pragma unroll
            for (int mt = 0; mt < 2; ++mt)
#pragma unroll
                for (int kb = 0; kb < 4; ++kb) { qa0[mt][kb] = *(const LAS s16x4*)(R + HR_Q + ((16 * mt + n) * HR_QP + 32 * kb + 4 * g) * 2); qa1[mt][kb] = *(const LAS s16x4*)(R + HR_Q + ((16 * mt + n) * HR_QP + 32 * kb + 16 + 4 * g) * 2); }
            vb = *(const LAS bf16x8*)(R + HR_SH + ((16 * wid + n) * HC + 8 * g) * 2);
#pragma unroll
            for (int mt = 0; mt < 2; ++mt) at[mt] = *(const LAS bf16x8*)(R + HR_A + ((16 * mt + n) * HC + 8 * g) * 2);
#pragma unroll
            for (int kt = 0; kt < 8; ++kt) { ka[kt] = *(const LAS bf16x8*)(R + HR_K + ((16 * kt + n) * HC + 8 * g) * 2); dv[kt] = *(const LAS f32x4*)(R + HR_D + (16 * kt + 4 * g) * 4); }
            asm volatile("s_waitcnt lgkmcnt(0)" ::: "memory");
            __builtin_amdgcn_sched_barrier(0);
            f32x4 o0 = (f32x4){0.f, 0.f, 0.f, 0.f}, o1 = o0;
            o0 = __builtin_amdgcn_mfma_f32_16x16x32_bf16(at[0], vb, o0, 0, 0, 0);
            o1 = __builtin_amdgcn_mfma_f32_16x16x32_bf16(at[1], vb, o1, 0, 0, 0);
#pragma unroll
            for (int kb = 0; kb < 4; ++kb) {
                u32x4 w; w.x = pg8::cvt_pk_bf16(S[2 * kb][0], S[2 * kb][1]); w.y = pg8::cvt_pk_bf16(S[2 * kb][2], S[2 * kb][3]); w.z = pg8::cvt_pk_bf16(S[2 * kb + 1][0], S[2 * kb + 1][1]); w.w = pg8::cvt_pk_bf16(S[2 * kb + 1][2], S[2 * kb + 1][3]);
                const bf16x8 sb = __builtin_bit_cast(bf16x8, w);
                const bf16x8 q0 = (bf16x8){qa0[0][kb][0], qa0[0][kb][1], qa0[0][kb][2], qa0[0][kb][3], qa1[0][kb][0], qa1[0][kb][1], qa1[0][kb][2], qa1[0][kb][3]};
                const bf16x8 q1 = (bf16x8){qa0[1][kb][0], qa0[1][kb][1], qa0[1][kb][2], qa0[1][kb][3], qa1[1][kb][0], qa1[1][kb][1], qa1[1][kb][2], qa1[1][kb][3]};
                o0 = __builtin_amdgcn_mfma_f32_16x16x32_bf16(q0, sb, o0, 0, 0, 0);
                o1 = __builtin_amdgcn_mfma_f32_16x16x32_bf16(q1, sb, o1, 0, 0, 0);
            }
#pragma unroll
            for (int kt = 0; kt < 8; ++kt) S[kt] = __builtin_amdgcn_mfma_f32_16x16x32_bf16(ka[kt], vb, S[kt] * dv[kt], 0, 0, 0);
            { LAS float* st = (LAS float*)(OST + (s_ & 1) * 8192) + wid * 512 + (4 * g) * 16 + n;
#pragma unroll
                for (int jj = 0; jj < 4; ++jj) { st[jj * 16] = o0[jj]; st[256 + jj * 16] = o1[jj]; } }
        }
        HG_DMA(s_ + HG_NS - 1);
    }
    asm volatile("s_waitcnt vmcnt(0) lgkmcnt(0)" ::: "memory");
    __builtin_amdgcn_s_barrier();
    asm volatile("" ::: "memory");
    if (wid == 4 || wid == 5) HG_OUT(HNC - 1);
    asm volatile("s_waitcnt vmcnt(0) lgkmcnt(0)" ::: "memory");
    __builtin_amdgcn_s_barrier();
#undef HG_PIECE
#undef HG_DMA
#undef HG_OUT
}

typedef float f32x16 __attribute__((ext_vector_type(16)));
constexpr int AT_KP = 72, AT_VP = 68;
constexpr int AT_KB = 64 * AT_KP * 2, AT_VB = 128 * AT_VP * 2, AT_BUF = AT_KB + AT_VB;
__device__ __forceinline__ int crow(int r, int hi) { return (r & 3) + 8 * (r >> 2) + 4 * hi; }
__device__ __forceinline__ void attn_phase(int l, unsigned char* lds_g, LAS unsigned char* ldsl, unsigned* qctr, int nunits_hg) {
    const Args a = *argp();
    const bf16_t* QA = (const bf16_t*)(a.ws + WS_QA); const bf16_t* KA = (const bf16_t*)(a.ws + WS_KA); const bf16_t* VA = (const bf16_t*)(a.ws + WS_VA);
    float* OD = (float*)(a.ws + WS_OD);
    const int tid = opq_v((int)threadIdx.x), lane = tid & 63, wid = __builtin_amdgcn_readfirstlane(tid >> 6), r32 = lane & 31, hi = lane >> 5;
    int* sh_u = (int*)(lds_g + 131072 + 64);
    for (;;) {
        __syncthreads();
        if (tid == 0) *sh_u = (int)atomicAdd(qctr, 1u);
        __syncthreads();
        const int u = *sh_u - nunits_hg;
        if (u >= NB * 12 * 17) break;
        if (u < 0) { const int hu = u + nunits_hg; hgrn_scan(hu >> 1, hu & 1, ldsl); continue; }
        const int qb = 16 - u / 24, bv = u % 24, b = bv / 12, vh = bv % 12, h = vh >> 1;
        const int q0 = qb * 256, NT = (q0 + 256) / 64;
        const int qw = q0 + wid * 32;
        const bf16_t* Kb = KA + (size_t)b * LP * 768 + vh * 64; const bf16_t* Vb = VA + ((size_t)b * 768 + h * 128) * LP;
        bf16x8 qr[4];
#pragma unroll
        for (int i = 0; i < 4; ++i) qr[i] = *(const bf16x8*)(QA + (size_t)(b * LP + qw + r32) * 768 + vh * 64 + 16 * i + 8 * hi);
        f32x16 o[4];
#pragma unroll
        for (int d = 0; d < 4; ++d) o[d] = (f32x16){0.f, 0.f, 0.f, 0.f, 0.f, 0.f, 0.f, 0.f, 0.f, 0.f, 0.f, 0.f, 0.f, 0.f, 0.f, 0.f};
        float mrun = -INFINITY, lrun = 0.f;
        const int kr = tid >> 3, kc = tid & 7;
        u32x4 kreg0, vreg00, vreg01, kreg1, vreg10, vreg11, kreg2, vreg20, vreg21, kreg3, vreg30, vreg31;
#define AT_LOAD(t, KR, V0, V1) do { KR = *(const u32x4*)(Kb + (size_t)((t) * 64 + kr) * 768 + kc * 8); \
            V0 = *(const u32x4*)(Vb + (size_t)kr * LP + (t) * 64 + kc * 8); V1 = *(const u32x4*)(Vb + (size_t)(64 + kr) * LP + (t) * 64 + kc * 8); } while (0)
#define AT_STORE(buf, KR, V0, V1) do { unsigned char* B_ = lds_g + (buf) * AT_BUF; *(u32x4*)(B_ + (kr * AT_KP + kc * 8) * 2) = KR; \
            *(u32x2*)(B_ + AT_KB + (kr * AT_VP + kc * 8) * 2) = (u32x2){V0.x, V0.y}; *(u32x2*)(B_ + AT_KB + (kr * AT_VP + kc * 8 + 4) * 2) = (u32x2){V0.z, V0.w}; \
            *(u32x2*)(B_ + AT_KB + ((64 + kr) * AT_VP + kc * 8) * 2) = (u32x2){V1.x, V1.y}; *(u32x2*)(B_ + AT_KB + ((64 + kr) * AT_VP + kc * 8 + 4) * 2) = (u32x2){V1.z, V1.w}; } while (0)
#define AT_TILE(t) do { \
            if ((t) * 64 <= qw + 31 && qw < L) {                 \
                const unsigned char* Bc = lds_g + ((t) & 1) * AT_BUF; \
                const float nm_ = mrun == -INFINITY ? 0.f : -mrun;     \
                f32x16 p0 = (f32x16){nm_, nm_, nm_, nm_, nm_, nm_, nm_, nm_, nm_, nm_, nm_, nm_, nm_, nm_, nm_, nm_}, p1 = p0; \
                _Pragma("unroll") for (int i2 = 0; i2 < 2; ++i2) { bf16x8 kf0[2], kf1[2];     \
                  _Pragma("unroll") for (int i = 0; i < 2; ++i) { kf0[i] = *(const bf16x8*)(Bc + (r32 * AT_KP + 16 * (2 * i2 + i) + 8 * hi) * 2); kf1[i] = *(const bf16x8*)(Bc + ((32 + r32) * AT_KP + 16 * (2 * i2 + i) + 8 * hi) * 2); } \
                  asm volatile("s_waitcnt lgkmcnt(0)" ::: "memory"); __builtin_amdgcn_sched_barrier(0); \
                  _Pragma("unroll") for (int i = 0; i < 2; ++i) { p0 = __builtin_amdgcn_mfma_f32_32x32x16_bf16(kf0[i], qr[2 * i2 + i], p0, 0, 0, 0); p1 = __builtin_amdgcn_mfma_f32_32x32x16_bf16(kf1[i], qr[2 * i2 + i], p1, 0, 0, 0); } } \
                if ((t) * 64 + 63 > qw) {                        \
                    const int qa = qw + r32, kb0 = (t) * 64 + 4 * hi; \
                    _Pragma("unroll") for (int r = 0; r < 16; ++r) { const int kv = kb0 + (r & 3) + 8 * (r >> 2); if (kv > qa) p0[r] = -INFINITY; if (kv + 32 > qa) p1[r] = -INFINITY; } } \
                float rm = fmaxf(p0[0], p1[0]); \
                _Pragma("unroll") for (int r = 1; r < 16; ++r) rm = fmaxf(rm, fmaxf(p0[r], p1[r])); \
                rm = fmaxf(rm, __shfl_xor(rm, 32)); \
                if (__any(rm > 8.0f || mrun == -INFINITY)) {   \
                    const float dl_ = mrun == -INFINITY ? rm : fmaxf(rm, 0.f), al_ = mrun == -INFINITY ? 0.f : __builtin_amdgcn_exp2f(-dl_); \
                    mrun = (mrun == -INFINITY ? 0.f : mrun) + dl_; lrun *= al_; \
                    _Pragma("unroll") for (int r = 0; r < 16; ++r) { p0[r] -= dl_; p1[r] -= dl_; } \
                    _Pragma("unroll") for (int d = 0; d < 4; ++d) _Pragma("unroll") for (int r = 0; r < 16; ++r) o[d][r] *= al_; } \
                _Pragma("unroll") for (int r = 0; r < 16; ++r) { p0[r] = __builtin_amdgcn_exp2f(p0[r]); p1[r] = __builtin_amdgcn_exp2f(p1[r]); } \
                { const f32x16 sm_ = p0 + p1; const f32x4 s4_ = (f32x4){sm_[0], sm_[1], sm_[2], sm_[3]} + (f32x4){sm_[4], sm_[5], sm_[6], sm_[7]} + (f32x4){sm_[8], sm_[9], sm_[10], sm_[11]} + (f32x4){sm_[12], sm_[13], sm_[14], sm_[15]}; \
                  lrun += (s4_[0] + s4_[1]) + (s4_[2] + s4_[3]); } \
                bf16x8 pb[4]; \
                _Pragma("unroll") for (int jj = 0; jj < 4; ++jj) { u32x4 w; \
                    if (jj < 2) { w.x = pg8::cvt_pk_bf16(p0[8 * jj], p0[8 * jj + 1]); w.y = pg8::cvt_pk_bf16(p0[8 * jj + 2], p0[8 * jj + 3]); w.z = pg8::cvt_pk_bf16(p0[8 * jj + 4], p0[8 * jj + 5]); w.w = pg8::cvt_pk_bf16(p0[8 * jj + 6], p0[8 * jj + 7]); } \
                    else { const int j2 = jj - 2; w.x = pg8::cvt_pk_bf16(p1[8 * j2], p1[8 * j2 + 1]); w.y = pg8::cvt_pk_bf16(p1[8 * j2 + 2], p1[8 * j2 + 3]); w.z = pg8::cvt_pk_bf16(p1[8 * j2 + 4], p1[8 * j2 + 5]); w.w = pg8::cvt_pk_bf16(p1[8 * j2 + 6], p1[8 * j2 + 7]); } \
                    pb[jj] = __builtin_bit_cast(bf16x8, w); } \
                const unsigned char* Vc = Bc + AT_KB; \
                _Pragma("unroll") for (int d = 0; d < 4; ++d) { s16x4 vl[4], vh[4];     \
                      _Pragma("unroll") for (int jj = 0; jj < 4; ++jj) { vl[jj] = *(const s16x4*)(Vc + ((d * 32 + r32) * AT_VP + 16 * jj + 4 * hi) * 2); vh[jj] = *(const s16x4*)(Vc + ((d * 32 + r32) * AT_VP + 16 * jj + 8 + 4 * hi) * 2); } \
                      asm volatile("s_waitcnt lgkmcnt(0)" ::: "memory"); __builtin_amdgcn_sched_barrier(0); \
                      _Pragma("unroll") for (int jj = 0; jj < 4; ++jj) { const bf16x8 va = (bf16x8){vl[jj][0], vl[jj][1], vl[jj][2], vl[jj][3], vh[jj][0], vh[jj][1], vh[jj][2], vh[jj][3]}; \
                          o[d] = __builtin_amdgcn_mfma_f32_32x32x16_bf16(va, pb[jj], o[d], 0, 0, 0); } } \
            } } while (0)
        AT_LOAD(0, kreg0, vreg00, vreg01); AT_STORE(0, kreg0, vreg00, vreg01);
        AT_LOAD(1, kreg1, vreg10, vreg11); AT_LOAD(2, kreg2, vreg20, vreg21); AT_LOAD(3, kreg3, vreg30, vreg31);
        __syncthreads();
        for (int t = 0; t < NT; t += 4) {
            if (t + 4 < NT) AT_LOAD(t + 4, kreg0, vreg00, vreg01);
            AT_TILE(t);
            AT_STORE(1, kreg1, vreg10, vreg11);
            __syncthreads();
            if (t + 5 < NT) AT_LOAD(t + 5, kreg1, vreg10, vreg11);
            AT_TILE(t + 1);
            AT_STORE(0, kreg2, vreg20, vreg21);
            __syncthreads();
            if (t + 6 < NT) AT_LOAD(t + 6, kreg2, vreg20, vreg21);
            AT_TILE(t + 2);
            AT_STORE(1, kreg3, vreg30, vreg31);
            __syncthreads();
            if (t + 7 < NT) AT_LOAD(t + 7, kreg3, vreg30, vreg31);
            AT_TILE(t + 3);
            if (t + 4 < NT) AT_STORE(0, kreg0, vreg00, vreg01);
            __syncthreads();
        }
#undef AT_TILE
#undef AT_LOAD
#undef AT_STORE
        const float lt = lrun + __shfl_xor(lrun, 32), rl = 1.0f / lt;
        const int qa = qw + r32;
        if (qa < L) {
            bf16_t* op = (bf16_t*)OD + ((size_t)(b * LP + qa) * 12 + vh) * 128;
#pragma unroll
            for (int d = 0; d < 4; ++d)
#pragma unroll
                for (int g = 0; g < 4; ++g) { u32x2 w; w.x = pg8::cvt_pk_bf16(o[d][4 * g] * rl, o[d][4 * g + 1] * rl); w.y = pg8::cvt_pk_bf16(o[d][4 * g + 2] * rl, o[d][4 * g + 3] * rl); *(u32x2*)(op + 32 * d + 8 * g + 4 * hi) = w; }
        }
    }
}

__device__ __forceinline__ float red16(float v) {
    v += __builtin_bit_cast(float, __builtin_amdgcn_mov_dpp(__builtin_bit_cast(int, v), 0xB1, 0xF, 0xF, true));
    v += __builtin_bit_cast(float, __builtin_amdgcn_mov_dpp(__builtin_bit_cast(int, v), 0x4E, 0xF, 0xF, true));
    v += __builtin_bit_cast(float, __builtin_amdgcn_mov_dpp(__builtin_bit_cast(int, v), 0x141, 0xF, 0xF, true));
    v += __builtin_bit_cast(float, __builtin_amdgcn_mov_dpp(__builtin_bit_cast(int, v), 0x140, 0xF, 0xF, true));
    return v;
}
__device__ __forceinline__ void finalize_phase(int l_in, int gw_in, int NGW, int lane_in) {
    const int l = opq_s(l_in), gw = opq_v(gw_in), lane = opq_v(lane_in);
    const Args a = *argp();
    const float* OD = (const float*)(a.ws + WS_OD); const float* OH = (const float*)(a.ws + WS_OH); const float* ZH = (const float*)(a.ws + WS_ZH);
    bf16_t* YD = (bf16_t*)(a.ws + WS_YD); bf16_t* YH = (bf16_t*)(a.ws + WS_YH);
    const float* lp = a.diff_lambda + (size_t)l * 4 * 64;
    const float lam_init = l == 0 ? 0.2f : 0.8f - 0.6f * 0.7408182206817179f;
    const float lam = __expf(wave_sum(lp[lane] * lp[64 + lane])) - __expf(wave_sum(lp[128 + lane] * lp[192 + lane])) + lam_init;
    const int q = lane >> 4, li = lane & 15;
    f32x4 gD[2], gH[2];
#pragma unroll
    for (int e = 0; e < 2; ++e) { gD[e] = *(const f32x4*)(a.diff_ng + l * 128 + 8 * li + 4 * e) * (1.f - lam_init); gH[e] = *(const f32x4*)(a.hgrn_ng + l * 128 + 8 * li + 4 * e); }
    for (int r = gw; r < T; r += NGW) {
        const int b = r / L, t = r % L; const size_t ar = (size_t)(b * LP + t);
        f32x4 A_[3][2], B_[3][2];
#pragma unroll
        for (int p = 0; p < 3; ++p) { const int sg = p * 4 + q; const bool isd = sg < 6; const int h = isd ? sg : sg - 6;
            if (isd) { const bf16_t* pd = (const bf16_t*)OD + (ar * 12 + 2 * h) * 128 + 8 * li; const u32x4 wa = *(const u32x4*)pd, wb = *(const u32x4*)(pd + 128);
                A_[p][0] = (f32x4){bflo(wa.x), bfhi(wa.x), bflo(wa.y), bfhi(wa.y)}; A_[p][1] = (f32x4){bflo(wa.z), bfhi(wa.z), bflo(wa.w), bfhi(wa.w)};
                B_[p][0] = (f32x4){bflo(wb.x), bfhi(wb.x), bflo(wb.y), bfhi(wb.y)}; B_[p][1] = (f32x4){bflo(wb.z), bfhi(wb.z), bflo(wb.w), bfhi(wb.w)}; }
            else { const u32x4 wa = *(const u32x4*)((const bf16_t*)OH + (size_t)r * HW + h * 128 + 8 * li); const u32x4 wb = *(const u32x4*)((const bf16_t*)(a.ws + WS_HG) + (size_t)r * HW + h * 128 + 8 * li);
                A_[p][0] = (f32x4){bflo(wa.x), bfhi(wa.x), bflo(wa.y), bfhi(wa.y)}; A_[p][1] = (f32x4){bflo(wa.z), bfhi(wa.z), bflo(wa.w), bfhi(wa.w)};
                B_[p][0] = (f32x4){bflo(wb.x), bfhi(wb.x), bflo(wb.y), bfhi(wb.y)}; B_[p][1] = (f32x4){bflo(wb.z), bfhi(wb.z), bflo(wb.w), bfhi(wb.w)}; } }
#pragma unroll
        for (int p = 0; p < 3; ++p) { const int sg = p * 4 + q; const bool isd = sg < 6; const int h = isd ? sg : sg - 6;
            const float ls = isd ? lam : 0.f;
            f32x4 d0 = A_[p][0] - B_[p][0] * ls, d1 = A_[p][1] - B_[p][1] * ls;
            const f32x4 sq = d0 * d0 + d1 * d1;
            const float ms = red16((sq[0] + sq[1]) + (sq[2] + sq[3])) * (1.f / 128.f); const float rs = 1.f / sqrtf(ms + RMS_EPS);
            f32x4 w0, w1;
            if (isd) { w0 = gD[0]; w1 = gD[1]; }
            else { const f32x4 g0 = B_[p][0], g1 = B_[p][1];
                w0 = gH[0] * (f32x4){g0[0] * sigmoidf_(g0[0]), g0[1] * sigmoidf_(g0[1]), g0[2] * sigmoidf_(g0[2]), g0[3] * sigmoidf_(g0[3])};
                w1 = gH[1] * (f32x4){g1[0] * sigmoidf_(g1[0]), g1[1] * sigmoidf_(g1[1]), g1[2] * sigmoidf_(g1[2]), g1[3] * sigmoidf_(g1[3])}; }
            d0 = d0 * rs * w0; d1 = d1 * rs * w1;
            u32x4 o; o.x = pk2(d0[0], d0[1]); o.y = pk2(d0[2], d0[3]); o.z = pk2(d1[0], d1[1]); o.w = pk2(d1[2], d1[3]);
            bf16_t* po = (isd ? YD + (size_t)r * DW : YH + (size_t)r * HW) + h * 128 + 8 * li;
            *(u32x4*)po = o; }
    }
}


#ifndef DBG_STAGE
#define DBG_STAGE 0
#endif
template <int stage> __device__ __forceinline__ void dbg_out(int gw, int NGW, int lane) {
    const Args a = *argp(); unsigned char* ws = a.ws;
    const float* ZP = (const float*)(ws + WS_ZP); const float* ZH = (const float*)(ws + WS_ZH); const bf16_t* G = (const bf16_t*)(ws + WS_G);
    const bf16_t* QA = (const bf16_t*)(ws + WS_QA); const bf16_t* YP = (const bf16_t*)(ws + WS_YP); const bf16_t* YH = (const bf16_t*)(ws + WS_YH); const bf16_t* YD = (const bf16_t*)(ws + WS_YD);
    const bf16_t* MB = (const bf16_t*)(ws + WS_MB);
    for (int r = gw; r < T; r += NGW) {
        const int b = r / L, t = r % L; if (t < NMETA) continue;
        const size_t ar = (size_t)(b * LP + t);
        float* o = a.out + ((size_t)b * SEQ + (t - NMETA)) * D;
        for (int c = lane; c < D; c += 64) {
            float v = 0.f;
            if (stage == 1) v = ZH[(size_t)r * 3072 + c] + ZH[(size_t)r * 3072 + 1024 + c] + ZP[(size_t)r * PW + (c & 511)] + bf2f(G[(size_t)r * 6144 + c]) + bf2f(G[(size_t)r * 6144 + 2048 + c]) + bf2f(G[(size_t)r * 6144 + 4096 + c])
                              + bf2f(QA[ar * 768 + (c % 768)]) + bf2f(QA[(WS_KA - WS_QA) / 2 + ar * 768 + (c % 768)]) + bf2f(QA[(WS_KA - WS_QA) + ar * 768 + (c % 768)]);
            else if (stage == 2) v = bf2f(YP[(size_t)r * PW + (c & 511)]) + 2.f * bf2f(YH[(size_t)r * HW + (c % 768)]) + 3.f * bf2f(YD[(size_t)r * DW + ((c + 100) % 768)]);
            else if (stage == 3) v = bf2f(MB[(size_t)r * D + c]);
            o[c] = v;
        }
    }
}

__device__ __forceinline__ void tail_ln(int lnidx, bool final_, unsigned* cntp, unsigned char* lds_g, int rb) {
    if (rb >= 64) return;
    const int tid = opq_v((int)threadIdx.x);
    int* sh = (int*)(lds_g + 131072 + 128);
    asm volatile("s_waitcnt vmcnt(0)" ::: "memory");
    __syncthreads();
    if (tid == 0) { __builtin_amdgcn_fence(__ATOMIC_RELEASE, "agent"); asm volatile("s_waitcnt vmcnt(0)" ::: "memory");
        *sh = (int)__hip_atomic_fetch_add(cntp, 1u, __ATOMIC_RELAXED, __HIP_MEMORY_SCOPE_AGENT); }
    __syncthreads();
    if (*sh == 63) {
        if (tid == 0) { __builtin_amdgcn_fence(__ATOMIC_ACQUIRE, "agent"); asm volatile("s_waitcnt vmcnt(0)" ::: "memory"); }
        __syncthreads();
        ln_rows(lnidx, final_, MT, T, tid >> 6, 8, tid & 63);
    }
}
#ifndef STOP_L
#define STOP_L 1
#endif
#ifndef STOP_J
#define STOP_J 1
#endif
#ifndef STOP_MIX
#define STOP_MIX 0
#endif
__global__ void __launch_bounds__(512, 2) fwd_kernel(Args a_unused) {
    extern __shared__ __attribute__((aligned(16))) unsigned char lds[];
    cg::grid_group grid = cg::this_grid();
    LAS unsigned char* ldsl = (LAS unsigned char*)lds;
    volatile LAS unsigned* MISC = (volatile LAS unsigned*)(ldsl + 147456 - 512);
    if (threadIdx.x < 64) MISC[threadIdx.x] = 0u;
    __syncthreads();
    (void)xcd_barrier_post((unsigned*)(argp()->ws + WS_CTL), MISC);
#define SYNC() xcd_barrier((unsigned*)(argp()->ws + WS_CTL), (volatile LAS unsigned*)(ldsl + 147456 - 512))
#define TIDV opq_v((int)threadIdx.x)
#define BLK opq_s((int)blockIdx.x)
#define GRD opq_s((int)gridDim.x)
#define WSP (argp()->ws)
#define GEMM(EPI, Aptr, Bptr, Mv, Nv, Kv, Eobj) do { pg8::Gemm g_{Aptr, Bptr, MT, Nv, Kv}; pg8::StaticOrder S_; S_.init(MT, Nv, GRD, BLK); pg8::gemm_phase<EPI, pg8::StaticOrder, true, true>(ldsl, g_, S_, Eobj); \
        {   \
          const int rb_ = GRD - 1 - BLK, nt_ = __is_same(EPI, pg8::EpiSwiglu) ? 128 : GRD; \
          tail_gemm<EPI, __is_same(EPI, pg8::EpiSwiglu)>(Aptr, Bptr, Kv, __is_same(EPI, pg8::EpiSwiglu) ? (Nv) / 2 : (Nv), Eobj, lds, rb_ < nt_ ? rb_ : (1 << 28), nt_); } } while (0)

#define GEMM_LN(Aoff, Boff, Kv, sval, lnidx_, final__) do { const Args a_ = *argp(); unsigned char* ws = a_.ws; const int li_ = (lnidx_); \
        pg8::PanelStats st_{(unsigned*)(ws + WS_XB), (unsigned*)(ws + WS_CTL + 65536 + (size_t)li_ * 8192), LN_EPS}; \
        pg8::EpiLn E_{(float*)(ws + WS_H), (bf16_t*)(ws + WS_HB), a_.ln_g + (size_t)li_ * D, a_.ln_b + (size_t)li_ * D, (sval), st_, (final__) ? a_.out : nullptr}; \
        pg8::Gemm g_{(const bf16_t*)(ws + (Aoff)), (const bf16_t*)(ws + (Boff)), MT, D, (Kv)}; pg8::StaticOrder S_; S_.init(MT, D, GRD, BLK); \
        pg8::gemm_phase<pg8::EpiLn, pg8::StaticOrder, false, true>(ldsl, g_, S_, E_); \
        pg8::EpiResid Et_{(const float*)(ws + WS_H), (float*)(ws + WS_PRE), (sval)}; const int rb_ = GRD - 1 - BLK; \
        tail_gemm<pg8::EpiResid, false>((const bf16_t*)(ws + (Aoff)), (const bf16_t*)(ws + (Boff)), (Kv), D, Et_, lds, rb_, GRD); \
        tail_ln(li_, (final__), (unsigned*)(ws + WS_CTL + 20480 + 256 * li_), lds, rb_); } while (0)

    { const int tid = TIDV; prologue(lds, BLK * 8 + (tid >> 6), GRD * 8, tid & 63); }
    asm volatile("s_waitcnt vmcnt(0)" ::: "memory");
    grid.sync();
    for (int l = 0; l < 2; ++l) {
        for (int j = 0; j < 2; ++j) {
            if (j == 1) {
                { unsigned char* ws = WSP; pg8::EpiInproj E{(float*)(ws + WS_ZP), (float*)(ws + WS_ZH), (bf16_t*)(ws + WS_QA), (bf16_t*)(ws + WS_KA), (bf16_t*)(ws + WS_VA), (bf16_t*)(ws + WS_G)};
                  GEMM(pg8::EpiInproj, (const bf16_t*)(ws + WS_HB), (const bf16_t*)(ws + WS_WIN + (size_t)l * SZ_WIN), MP, INCOLS, D, E); }
                SYNC();
                if constexpr (DBG_STAGE == 1) { const int tid = TIDV; dbg_out<1>(BLK * 8 + (tid >> 6), GRD * 8, tid & 63); return; }
                { const int blk = BLK, G = GRD; pool_phase(l, lds, blk, G); hgrn_pre(l, lds, blk, G); }
                SYNC();
                attn_phase(l, lds, ldsl, (unsigned*)(argp()->ws + WS_CTL + 16384 + 256 * l), 24);
                SYNC();
                { const int tid = TIDV; finalize_phase(l, BLK * 8 + (tid >> 6), GRD * 8, tid & 63); }
                SYNC();
                if constexpr (DBG_STAGE == 2) { const int tid = TIDV; dbg_out<2>(BLK * 8 + (tid >> 6), GRD * 8, tid & 63); return; }
                { unsigned char* ws = WSP;
                  pg8::EpiBranch E0{(const bf16_t*)(ws + WS_G), 0, (float*)(ws + WS_MF), (bf16_t*)(ws + WS_MB), 0};
                  GEMM(pg8::EpiBranch, (const bf16_t*)(ws + WS_YP), (const bf16_t*)(ws + WS_WBP + (size_t)l * D * PW * 2), MP, D, PW, E0); }
                { unsigned char* ws = WSP;
                  pg8::EpiBranch E1{(const bf16_t*)(ws + WS_G), 2048, (float*)(ws + WS_MF), (bf16_t*)(ws + WS_MB), 1};
                  GEMM(pg8::EpiBranch, (const bf16_t*)(ws + WS_YH), (const bf16_t*)(ws + WS_WBH + (size_t)l * D * HW * 2), MP, D, HW, E1); }
                { unsigned char* ws = WSP;
                  pg8::EpiBranch E2{(const bf16_t*)(ws + WS_G), 4096, (float*)(ws + WS_MF), (bf16_t*)(ws + WS_MB), 2};
                  GEMM(pg8::EpiBranch, (const bf16_t*)(ws + WS_YD), (const bf16_t*)(ws + WS_WBD + (size_t)l * D * DW * 2), MP, D, DW, E2); }
                SYNC();
                if constexpr (DBG_STAGE == 3) { const int tid = TIDV; dbg_out<3>(BLK * 8 + (tid >> 6), GRD * 8, tid & 63); return; }
                GEMM_LN(WS_MB, WS_WO + (size_t)l * D * D * 2, D, 1.0f, l * 3 + 1, false);
                SYNC();
            }
            { unsigned char* ws = WSP; pg8::EpiSwiglu E{(bf16_t*)(ws + WS_ACT)};
              GEMM(pg8::EpiSwiglu, (const bf16_t*)(ws + WS_HB), (const bf16_t*)(ws + WS_WUP + (size_t)(l * 2 + j) * SZ_WUP), MP, 2 * DFF, D, E); }
            SYNC();
            GEMM_LN(WS_ACT, WS_WDN + (size_t)(l * 2 + j) * SZ_WDN, DFF, 0.5f, l * 3 + 2 * j, (l == 1 && j == 1));
            if (l == 1 && j == 1) return;
            SYNC();
        }
    }
#undef GEMM
}

extern "C" void kernel_launch(void* const* d_in, const int* in_sizes, int n_in, void* d_out, int out_size, void* d_ws, size_t ws_size, hipStream_t stream) {
    static int grid = 0;
    if (grid == 0) {
        int dev = 0, cus = 0, per_cu = 0;
        (void)hipGetDevice(&dev);
        (void)hipDeviceGetAttribute(&cus, hipDeviceAttributeMultiprocessorCount, dev);
        (void)hipFuncSetAttribute((const void*)fwd_kernel, hipFuncAttributeMaxDynamicSharedMemorySize, LDS_BYTES);
        (void)hipOccupancyMaxActiveBlocksPerMultiprocessor(&per_cu, (const void*)fwd_kernel, 512, LDS_BYTES);
        if (per_cu < 1) per_cu = 1;
        grid = cus * per_cu;
        if (ws_size < WS_END3 || cus * per_cu != 256) { fprintf(stderr, "kernel_launch: workspace too small: %zu < %zu\n", ws_size, (size_t)WS_END); grid = -1; }
    }
    if (grid < 0) return;
    Args a{};
    a.x = (const float*)d_in[0]; a.meta = (const float*)d_in[1]; a.ln_g = (const float*)d_in[2]; a.ln_b = (const float*)d_in[3];
    a.ffn_w_in = (const float*)d_in[4]; a.ffn_w_out = (const float*)d_in[5]; a.w_in = (const float*)d_in[6]; a.pool_w = (const float*)d_in[7];
    a.pool_scale = (const float*)d_in[8]; a.hgrn_lb = (const float*)d_in[9]; a.hgrn_ng = (const float*)d_in[10]; a.diff_lambda = (const float*)d_in[11];
    a.diff_ng = (const float*)d_in[12]; a.w_bp = (const float*)d_in[13]; a.w_bh = (const float*)d_in[14]; a.w_bd = (const float*)d_in[15]; a.w_out = (const float*)d_in[16];
    a.out = (float*)d_out; a.ws = (unsigned char*)d_ws;
    (void)hipMemsetAsync((char*)d_ws + WS_CTL, 0, 131072, stream);
    void* args[] = {&a};
    hipError_t e = hipLaunchCooperativeKernel((const void*)fwd_kernel, dim3(grid), dim3(512), args, LDS_BYTES, stream);
    if (e != hipSuccess) fprintf(stderr, "cooperative launch failed: %s (grid %d)\n", hipGetErrorString(e), grid);
}
```
